# Optimizing an MI355X kernel written in HIP

```python
import jax, jax.numpy as jnp
from jax import lax
import numpy as np

D_MODEL = 4096
BATCH = 4
SEQ = 4096
DEPTH = 1

H_A = 16
DH_A = 128
H_B = 32
HKV_B = 4
G_B = H_B // HKV_B
DH_B = 64
WINDOW = 128
NUM_BUCKETS = 32
MAX_DISTANCE = 128
BLOCK = 128
D_FF = ((8 * D_MODEL // 3 + 255) // 256) * 256
EPS = 1e-6

W_QA = H_A * DH_A
W_KA = H_A * DH_A
W_VA = H_A * DH_A
W_FA = H_A
W_QB = H_B * DH_B
W_KB = HKV_B * DH_B
W_VB = HKV_B * DH_B
W_GA = D_MODEL
W_GB = D_MODEL
W_IN = W_QA + W_KA + W_VA + W_FA + W_QB + W_KB + W_VB + W_GA + W_GB

kernel_name = "fox_swa_sink_gated_hybrid_block"


def rms_norm(x, g):
    xf = x.astype(jnp.float32)
    y = xf * lax.rsqrt(jnp.mean(xf * xf, axis=-1, keepdims=True) + EPS)
    return (y * g.astype(jnp.float32)).astype(x.dtype)


def t5_bucket(dist):
    max_exact = NUM_BUCKETS // 2
    small = dist < max_exact
    large = max_exact + (np.log(np.maximum(dist, 1) / max_exact) / np.log(MAX_DISTANCE / max_exact)
                         * (NUM_BUCKETS - max_exact)).astype(np.int64)
    large = np.minimum(large, NUM_BUCKETS - 1)
    return np.where(small, dist, large)


def band_geometry(n_blocks):
    ql = np.arange(BLOCK)[:, None]
    kl = np.arange(2 * BLOCK)[None, :]
    dist = ql + BLOCK - kl
    in_window = (dist >= 0) & (dist < WINDOW)
    key_global = np.arange(n_blocks)[:, None, None] * BLOCK - BLOCK + kl[None]
    mask = in_window[None] & (key_global >= 0)
    bucket = t5_bucket(np.clip(dist, 0, None))
    return jnp.asarray(mask), jnp.asarray(bucket.astype(np.int32))


def forgetting_attention(q, k, v, f_logit):
    B, S, H, D = q.shape
    n_blocks = S // BLOCK
    log_f = jax.nn.log_sigmoid(f_logit.astype(jnp.float32))
    c = lax.cumsum(log_f, axis=1).transpose(0, 2, 1)
    key_pos = jnp.arange(S)
    scale = D ** -0.5

    def one_block(i):
        start = i * BLOCK
        q_blk = lax.dynamic_slice_in_dim(q, start, BLOCK, axis=1)
        c_q = lax.dynamic_slice_in_dim(c, start, BLOCK, axis=2)
        s = jnp.einsum('bqhd,bkhd->bhqk', q_blk, k, preferred_element_type=jnp.float32) * scale
        s = s + c_q[..., None] - c[:, :, None, :]
        q_pos = start + jnp.arange(BLOCK)
        causal = key_pos[None, :] <= q_pos[:, None]
        p = jax.nn.softmax(jnp.where(causal, s, -jnp.inf), axis=-1)
        return jnp.einsum('bhqk,bkhd->bqhd', p.astype(v.dtype), v)

    out = lax.map(one_block, jnp.arange(n_blocks))
    return out.transpose(1, 0, 2, 3, 4).reshape(B, S, H * D)


def sliding_window_sink_attention(q, k, v, sinks, rel_bias):
    B, S = q.shape[:2]
    n_blocks = S // BLOCK
    mask, bucket = band_geometry(n_blocks)
    bias = rel_bias.astype(jnp.float32)[bucket].transpose(2, 0, 1).reshape(HKV_B, G_B, BLOCK, 2 * BLOCK)
    qb = q.reshape(B, n_blocks, BLOCK, HKV_B, G_B, DH_B)

    def band(t):
        tp = jnp.pad(t, ((0, 0), (BLOCK, 0), (0, 0), (0, 0))).reshape(B, n_blocks + 1, BLOCK, HKV_B, DH_B)
        return jnp.concatenate([tp[:, :-1], tp[:, 1:]], axis=2)

    kb, vb = band(k), band(v)
    s = jnp.einsum('bnqhgd,bnkhd->bnhgqk', qb, kb, preferred_element_type=jnp.float32) * (DH_B ** -0.5)
    s = jnp.where(mask[None, :, None, None], s + bias, -jnp.inf)
    sink = sinks.astype(jnp.float32).reshape(1, 1, HKV_B, G_B, 1, 1)
    m = jnp.maximum(jnp.max(s, axis=-1, keepdims=True), sink)
    p = jnp.exp(s - m)
    p = p / (jnp.sum(p, axis=-1, keepdims=True) + jnp.exp(sink - m))
    o = jnp.einsum('bnhgqk,bnkhd->bnqhgd', p.astype(v.dtype), vb)
    return o.reshape(B, S, H_B * DH_B)


def setup_inputs(seed: int = 0) -> dict:
    key = jax.random.key(seed)
    ks = jax.random.split(key, 16)
    f32 = jnp.float32

    def w(k, shape, fan_in):
        return jax.random.normal(k, shape, f32) * (fan_in ** -0.5)

    return {
        "x": jax.random.normal(ks[0], (BATCH, SEQ, D_MODEL), f32),
        "norm1_g": 1.0 + 0.02 * jax.random.normal(ks[1], (DEPTH, D_MODEL), f32),
        "w_in": w(ks[2], (DEPTH, D_MODEL, W_IN), D_MODEL),
        "b_forget": 0.1 * jax.random.normal(ks[3], (DEPTH, H_A), f32),
        "attn_sinks": 0.5 * jax.random.normal(ks[4], (DEPTH, H_B), f32),
        "rel_bias": 0.1 * jax.random.normal(ks[5], (NUM_BUCKETS, H_B), f32),
        "w_branch_a": w(ks[6], (DEPTH, H_A * DH_A, D_MODEL), H_A * DH_A),
        "w_branch_b": w(ks[7], (DEPTH, H_B * DH_B, D_MODEL), H_B * DH_B),
        "w_out": w(ks[8], (DEPTH, D_MODEL, D_MODEL), D_MODEL),
        "norm2_g": 1.0 + 0.02 * jax.random.normal(ks[9], (DEPTH, D_MODEL), f32),
        "w_ffn_gate": w(ks[10], (DEPTH, D_MODEL, D_FF), D_MODEL),
        "w_ffn_up": w(ks[11], (DEPTH, D_MODEL, D_FF), D_MODEL),
        "w_ffn_down": w(ks[12], (DEPTH, D_FF, D_MODEL), D_FF),
        "final_g": 1.0 + 0.02 * jax.random.normal(ks[13], (D_MODEL,), f32),
    }


def reference(x, norm1_g, w_in, b_forget, attn_sinks, rel_bias, w_branch_a, w_branch_b,
              w_out, norm2_g, w_ffn_gate, w_ffn_up, w_ffn_down, final_g):
    B, S, _ = x.shape
    split_at = list(np.cumsum([W_QA, W_KA, W_VA, W_FA, W_QB, W_KB, W_VB, W_GA])[:])
    for l in range(DEPTH):
        h = rms_norm(x, norm1_g[l])
        proj = jnp.einsum('bsd,dn->bsn', h, w_in[l])
        qa, ka, va, fa, qb, kb, vb, ga, gb = jnp.split(proj, split_at, axis=-1)
        qa = qa.reshape(B, S, H_A, DH_A)
        ka = ka.reshape(B, S, H_A, DH_A)
        va = va.reshape(B, S, H_A, DH_A)
        fa = fa + b_forget[l]
        qb = qb.reshape(B, S, HKV_B, G_B, DH_B)
        kb = kb.reshape(B, S, HKV_B, DH_B)
        vb = vb.reshape(B, S, HKV_B, DH_B)

        ya = jnp.einsum('bsc,cd->bsd', forgetting_attention(qa, ka, va, fa), w_branch_a[l])
        yb = jnp.einsum('bsc,cd->bsd', sliding_window_sink_attention(qb, kb, vb, attn_sinks[l], rel_bias),
                        w_branch_b[l])
        mixed = jax.nn.sigmoid(ga) * ya + jax.nn.sigmoid(gb) * yb
        x = x + jnp.einsum('bsd,de->bse', mixed, w_out[l])

        h = rms_norm(x, norm2_g[l])
        hidden = jax.nn.silu(jnp.einsum('bsd,df->bsf', h, w_ffn_gate[l])) * jnp.einsum('bsd,df->bsf', h, w_ffn_up[l])
        x = x + jnp.einsum('bsf,fd->bsd', hidden, w_ffn_down[l])
    return rms_norm(x, final_g)
```

```cpp
#define SQ_ORDER StaticOrder
#define SQ_DUAL DualOrder
#include <hip/hip_runtime.h>
#include <cstdio>
#include <cstdint>

namespace pg8 {
#define PG8_LAS __attribute__((address_space(3)))
typedef unsigned short bf16_t;
typedef short bf16x8 __attribute__((ext_vector_type(8)));
typedef float f32x4 __attribute__((ext_vector_type(4)));
typedef unsigned u32x4 __attribute__((ext_vector_type(4)));
typedef int i32x4 __attribute__((ext_vector_type(4)));
constexpr int BM = 256, BK = 64, HALF = 128, HTB = HALF * BK * 2  , STAGE_BYTES = 8 * HTB, NXCD = 8, WGM = 8;

__host__ __device__ __forceinline__ int lds_byte(int r, int c) { const int st = (r >> 4) * 2 + (c >> 5), rr = r & 15, cc = c & 31, ob = rr * 64 + cc * 2; return st * 1024 + (ob ^ (((ob >> 9) & 1) << 5)); }
__host__ __device__ __forceinline__ void stage_rc(int b, int& R, int& C) { const int st = b / 1024, sb = b % 1024, swz = sb ^ (((sb >> 9) & 1) << 5); R = (st >> 1) * 16 + swz / 64; C = (st & 1) * 32 + (swz % 64) / 2; }
__host__ __device__ __forceinline__ int perm32(int rho) { const int n = rho >> 4, i = rho & 15; return 8 * (i >> 2) + 4 * n + (i & 3); }

struct Unit { int pm, pn, src; };
struct Gemm { const bf16_t* A; const bf16_t* Bt; int M, N, K; const bf16_t* A2; const bf16_t* Bt2; };

struct StaticOrder {
    int nM, nN, nwg, G, c;
    __host__ __device__ void init(int M, int N, int G_, int c_) { nM = M / BM; nN = N / BM; nwg = nM * nN; G = G_; c = c_; }
    __host__ __device__ bool next(int i, Unit& u) const {
        const long L = (long)i * G + c; if (L >= nwg) return false;
        int wgid = (int)L; { const int q = nwg / NXCD, r = nwg % NXCD, xcd = wgid % NXCD, off = wgid / NXCD; wgid = (xcd < r ? xcd * (q + 1) : r * (q + 1) + (xcd - r) * q) + off; }
        const int nig = WGM * nN, gid = wgid / nig, fm = gid * WGM, gsz = (nM - fm) < WGM ? (nM - fm) : WGM;
        u.pm = fm + ((wgid % nig) % gsz); u.pn = (wgid % nig) / gsz; u.src = 0; return true;
    }
    __device__ __forceinline__ void a_ready(const Unit&) const {}
    __device__ __forceinline__ void done(const Unit&) const {}
};
struct TailOrder : StaticOrder {
    int nfull, c0;
    __host__ __device__ bool next(int i, Unit& u) const {
        long L;
        if (i < nfull) L = (long)i * G + c; else { if (c < c0) return false; L = (long)nfull * G + (long)(i - nfull) * (G - c0) + (c - c0); }
        if (L >= nwg) return false;
        int wgid = (int)L; { const int q = nwg / NXCD, r = nwg % NXCD, xcd = wgid % NXCD, off = wgid / NXCD; wgid = (xcd < r ? xcd * (q + 1) : r * (q + 1) + (xcd - r) * q) + off; }
        const int nig = WGM * nN, gid = wgid / nig, fm = gid * WGM, gsz = (nM - fm) < WGM ? (nM - fm) : WGM;
        u.pm = fm + ((wgid % nig) % gsz); u.pn = (wgid % nig) / gsz; u.src = 0; return true;
    }
};
struct SquareOrder : StaticOrder {
    __host__ __device__ bool next(int i, Unit& u) const {
        if (G != 256 || nM != 64 || nN != 16) return StaticOrder::next(i, u);
        if (i >= 4) return false;
        const int k = c & 7, s = c >> 3; u.pm = 16 * i + 8 * (k & 1) + (s & 7); u.pn = 4 * (k >> 1) + (s >> 3); u.src = 0; return true;
    }
};
#ifndef SQ_ORDER
#define SQ_ORDER SquareOrder
#define SQ_DUAL DualSquare
#endif
struct DualSquare : SquareOrder {
    __host__ __device__ bool next(int i, Unit& u) const { const bool ok = SquareOrder::next(i >> 1, u); u.src = i & 1; return ok; }
};
struct DualOrder : StaticOrder {
    __host__ __device__ bool next(int i, Unit& u) const { const bool ok = StaticOrder::next(i >> 1, u); u.src = i & 1; return ok; }
};

struct HotOrder : StaticOrder {
    __host__ __device__ bool next(int i, Unit& u) const { const bool ok = StaticOrder::next(i, u); u.pm = c & 7; u.pn = 0; return ok; }
};
__device__ __forceinline__ f32x4 mma16(bf16x8 a, bf16x8 b, f32x4 c) { return __builtin_amdgcn_mfma_f32_16x16x32_bf16(a, b, c, 0, 0, 0); }
__device__ __forceinline__ i32x4 mma16(bf16x8 a, bf16x8 b, i32x4 c) { return __builtin_amdgcn_mfma_i32_16x16x64_i8(__builtin_bit_cast(i32x4, a), __builtin_bit_cast(i32x4, b), c, 0, 0, 0); }
typedef float f32x2_t __attribute__((ext_vector_type(2)));
typedef __bf16 bf16x2_t __attribute__((ext_vector_type(2)));
__device__ __forceinline__ unsigned cvt_pk_bf16(float lo, float hi) { const f32x2_t v = {lo, hi}; const bf16x2_t b = __builtin_convertvector(v, bf16x2_t); return __builtin_bit_cast(unsigned, b); }
__device__ __forceinline__ float bf_lo(unsigned w) { return __builtin_bit_cast(float, w << 16); }
__device__ __forceinline__ float bf_hi(unsigned w) { return __builtin_bit_cast(float, w & 0xffff0000u); }
__device__ __forceinline__ float sigmoid_f(float x) { return __builtin_amdgcn_rcpf(1.f + __builtin_amdgcn_exp2f(-1.4426950408889634f * x)); }
__device__ __forceinline__ u32x4 pack8(f32x4 v0, f32x4 v1) { u32x4 w; w.x = cvt_pk_bf16(v0[0], v0[1]); w.y = cvt_pk_bf16(v0[2], v0[3]); w.z = cvt_pk_bf16(v1[0], v1[1]); w.w = cvt_pk_bf16(v1[2], v1[3]); return w; }

constexpr int IN_TILES = 25;
constexpr int INQ_TILES = 42;
struct EpiInProj {
    static constexpr bool PERM = true, AFTER_DRAIN = false, DUAL = false, I8 = false; typedef f32x4 acc_t;
    const float* rstd; bf16_t* q4;   float* lf; const float* bfor; unsigned* nrm;
    __device__ __forceinline__ void operator()(const f32x4 (&acc)[2][2][4][2], const Unit& u, int wr, int wc, int fr, int fq) const {
        const int row0 = u.pm * BM + wr * 64 + fr; const int pn = u.pn;
        float rs[2][4];
        if (pn == 24) {
            if (wc == 0 && fq < 2) {
#pragma unroll
                for (int ai = 0; ai < 2; ++ai)
#pragma unroll
                    for (int m = 0; m < 4; ++m) rs[ai][m] = rstd[row0 + ai * HALF + m * 16];
                const f32x4 b0 = *(const f32x4*)(bfor + 8 * fq), b1 = *(const f32x4*)(bfor + 8 * fq + 4);
#pragma unroll
                for (int ai = 0; ai < 2; ++ai)
#pragma unroll
                    for (int m = 0; m < 4; ++m) { const int row = row0 + ai * HALF + m * 16;
#pragma unroll
                        for (int n = 0; n < 2; ++n) { const f32x4 v = acc[ai][0][m][n] * rs[ai][m]; const f32x4 b = n ? b1 : b0; f32x4 o;
#pragma unroll
                            for (int j = 0; j < 4; ++j) { const float z = v[j] + b[j]; o[j] = fminf(z, 0.f) - log1pf(expf(-fabsf(z))); }
                            *(f32x4*)(lf + (size_t)row * 16 + 8 * fq + 4 * n) = o; } }
            }
            return;
        }
#pragma unroll
        for (int ai = 0; ai < 2; ++ai)
#pragma unroll
            for (int m = 0; m < 4; ++m) rs[ai][m] = rstd[row0 + ai * HALF + m * 16];
        bf16_t* base = q4 + (size_t)(pn >> 3) * ((size_t)16384 * 2048);
        const int col0 = (pn & 7) * BM + wc * 32 + 8 * fq;
        float mxh[2] = {0.f, 0.f};
#pragma unroll
        for (int ai = 0; ai < 2; ++ai)
#pragma unroll
            for (int m = 0; m < 4; ++m) { const int row = row0 + ai * HALF + m * 16; const float r = rs[ai][m]; bf16_t* rowp = base + (size_t)row * 2048 + col0;
#pragma unroll
                for (int bj = 0; bj < 2; ++bj) { const f32x4 v0 = acc[ai][bj][m][0] * r, v1 = acc[ai][bj][m][1] * r; *(u32x4*)(rowp + bj * HALF) = pack8(v0, v1);
                    if (pn < 16) { float ss = (v0[0] * v0[0] + v0[1] * v0[1]) + (v0[2] * v0[2] + v0[3] * v0[3]) + (v1[0] * v1[0] + v1[1] * v1[1]) + (v1[2] * v1[2] + v1[3] * v1[3]);
                        ss += __shfl_xor(ss, 16); ss += __shfl_xor(ss, 32); mxh[bj] = fmaxf(mxh[bj], ss); } } }
        if (pn < 16) {
#pragma unroll
            for (int bj = 0; bj < 2; ++bj) { float v = mxh[bj]; v = fmaxf(v, __shfl_xor(v, 1)); v = fmaxf(v, __shfl_xor(v, 2)); v = fmaxf(v, __shfl_xor(v, 4)); v = fmaxf(v, __shfl_xor(v, 8));
                if (fr == 0 && fq == 0) (void)__hip_atomic_fetch_max(nrm + (((pn >> 3) * 64 + (u.pm >> 4) * 16 + 2 * (pn & 7) + bj) * 4 + wc), __builtin_bit_cast(unsigned, v), __ATOMIC_RELAXED, __HIP_MEMORY_SCOPE_AGENT); }
        }
    }
};
template <size_t OQB, size_t OKB, size_t OVB>
struct EpiGates8 {
    static constexpr bool PERM = true, AFTER_DRAIN = false, DUAL = false, I8 = true; typedef i32x4 acc_t;
    const float* sx; const unsigned* cmax; unsigned char* wsb; bf16_t* gr; bf16_t* gs;
    __device__ __forceinline__ void operator()(const i32x4 (&acc)[2][2][4][2], const Unit& u, int wr, int wc, int fr, int fq) const {
        const int row0 = u.pm * BM + wr * 64 + fr, cl = wc * 32 + 8 * fq; const int pn = u.pn;
        float rs[2][4];
#pragma unroll
        for (int ai = 0; ai < 2; ++ai)
#pragma unroll
            for (int m = 0; m < 4; ++m) rs[ai][m] = sx[row0 + ai * HALF + m * 16];
        f32x4 sc[2][2];
#pragma unroll
        for (int bj = 0; bj < 2; ++bj) { const f32x4* c = (const f32x4*)(cmax + pn * BM + bj * HALF + cl); sc[bj][0] = c[0] * (1.f / 127.f); sc[bj][1] = c[1] * (1.f / 127.f); }
        if (pn >= 10) {
            const int col0 = (pn - 10) * HALF + cl; const float T = 9.094947017729282e-13f;
#pragma unroll
            for (int ai = 0; ai < 2; ++ai)
#pragma unroll
                for (int m = 0; m < 4; ++m) { const size_t off = (size_t)(row0 + ai * HALF + m * 16) * 4096 + col0; const float r = rs[ai][m]; f32x4 r0, r1, s0, s1;
#pragma unroll
                    for (int j = 0; j < 4; ++j) {
                        const float a0 = sigmoid_f((float)acc[ai][0][m][0][j] * (r * sc[0][0][j])), a1 = sigmoid_f((float)acc[ai][0][m][1][j] * (r * sc[0][1][j]));
                        s0[j] = fmaxf(sigmoid_f((float)acc[ai][1][m][0][j] * (r * sc[1][0][j])), T); s1[j] = fmaxf(sigmoid_f((float)acc[ai][1][m][1][j] * (r * sc[1][1][j])), T);
                        r0[j] = a0 * __builtin_amdgcn_rcpf(s0[j]); r1[j] = a1 * __builtin_amdgcn_rcpf(s1[j]); }
                    *(u32x4*)(gr + off) = pack8(r0, r1); *(u32x4*)(gs + off) = pack8(s0, s1);
                    __builtin_amdgcn_sched_barrier(0); }
            return;
        }
        size_t boff = OQB; int ldc = 2048, colt = pn * BM;
        if (pn == 8) boff = OKB; if (pn == 9) boff = OVB; if (pn >= 8) { ldc = 256; colt = 0; }
        bf16_t* base = (bf16_t*)(wsb + boff);
        const int col0 = colt + cl;
#pragma unroll
        for (int ai = 0; ai < 2; ++ai)
#pragma unroll
            for (int m = 0; m < 4; ++m) { const int row = row0 + ai * HALF + m * 16; const float r = rs[ai][m]; bf16_t* rowp = base + (size_t)row * ldc + col0;
#pragma unroll
                for (int bj = 0; bj < 2; ++bj) { f32x4 v0, v1;
#pragma unroll
                    for (int j = 0; j < 4; ++j) { v0[j] = (float)acc[ai][bj][m][0][j] * (r * sc[bj][0][j]); v1[j] = (float)acc[ai][bj][m][1][j] * (r * sc[bj][1][j]); }
                    *(u32x4*)(rowp + bj * HALF) = pack8(v0, v1); } }
    }
};
struct EpiMix {
    static constexpr bool PERM = true, AFTER_DRAIN = false, DUAL = true, I8 = false; typedef f32x4 acc_t;
    const bf16_t* gr; const bf16_t* gs; bf16_t* mixed;
    template <bool FINAL> __device__ __forceinline__ void run(f32x4 (&acc)[2][2][4][2], const Unit& u, int wr, int wc, int fr, int fq) const {
        const int row0 = u.pm * BM + wr * 64 + fr, col0 = u.pn * BM + wc * 32 + 8 * fq; const bf16_t* g = FINAL ? gs : gr;
        u32x4 b[2], bn[2];
        { const size_t off = (size_t)row0 * 4096 + col0; b[0] = *(const u32x4*)(g + off); b[1] = *(const u32x4*)(g + off + HALF); }
#pragma unroll
        for (int it = 0; it < 8; ++it) { const int ai = it >> 2, m = it & 3; const size_t off = (size_t)(row0 + ai * HALF + m * 16) * 4096 + col0;
            if (it + 1 < 8) { const size_t offn = (size_t)(row0 + ((it + 1) >> 2) * HALF + ((it + 1) & 3) * 16) * 4096 + col0; bn[0] = *(const u32x4*)(g + offn); bn[1] = *(const u32x4*)(g + offn + HALF); }
#pragma unroll
            for (int bj = 0; bj < 2; ++bj) { const u32x4 y = b[bj]; f32x4 v0 = acc[ai][bj][m][0], v1 = acc[ai][bj][m][1];
                v0[0] *= bf_lo(y.x); v0[1] *= bf_hi(y.x); v0[2] *= bf_lo(y.y); v0[3] *= bf_hi(y.y); v1[0] *= bf_lo(y.z); v1[1] *= bf_hi(y.z); v1[2] *= bf_lo(y.w); v1[3] *= bf_hi(y.w);
                if (FINAL) *(u32x4*)(mixed + off + bj * HALF) = pack8(v0, v1); else { acc[ai][bj][m][0] = v0; acc[ai][bj][m][1] = v1; } }
            b[0] = bn[0]; b[1] = bn[1]; }
    }
    __device__ __forceinline__ void mid(f32x4 (&acc)[2][2][4][2], const Unit& u, int wr, int wc, int fr, int fq) const { run<false>(acc, u, wr, wc, fr, fq); }
    __device__ __forceinline__ void operator()(f32x4 (&acc)[2][2][4][2], const Unit& u, int wr, int wc, int fr, int fq) const { run<true>(acc, u, wr, wc, fr, fq); }
};
struct EpiOutX1 {
    static constexpr bool PERM = true, AFTER_DRAIN = false, DUAL = false, I8 = false; typedef f32x4 acc_t;
    const bf16_t* res; bf16_t* cp;
    __device__ __forceinline__ void operator()(const f32x4 (&acc)[2][2][4][2], const Unit& u, int wr, int wc, int fr, int fq) const {
        const int row0 = u.pm * BM + wr * 64 + fr, col0 = u.pn * BM + wc * 32 + 8 * fq;
        u32x4 p[2], pn[2];
        { const size_t off = (size_t)row0 * 4096 + col0; p[0] = *(const u32x4*)(res + off); p[1] = *(const u32x4*)(res + off + HALF); }
#pragma unroll
        for (int it = 0; it < 8; ++it) { const int ai = it >> 2, m = it & 3; const size_t off = (size_t)(row0 + ai * HALF + m * 16) * 4096 + col0;
            if (it + 1 < 8) { const size_t offn = (size_t)(row0 + ((it + 1) >> 2) * HALF + ((it + 1) & 3) * 16) * 4096 + col0; pn[0] = *(const u32x4*)(res + offn); pn[1] = *(const u32x4*)(res + offn + HALF); }
#pragma unroll
            for (int bj = 0; bj < 2; ++bj) { const u32x4 q = p[bj]; f32x4 v0 = acc[ai][bj][m][0], v1 = acc[ai][bj][m][1];
                v0[0] += bf_lo(q.x); v0[1] += bf_hi(q.x); v0[2] += bf_lo(q.y); v0[3] += bf_hi(q.y); v1[0] += bf_lo(q.z); v1[1] += bf_hi(q.z); v1[2] += bf_lo(q.w); v1[3] += bf_hi(q.w);
                *(u32x4*)(cp + off + bj * HALF) = pack8(v0, v1); }
            p[0] = pn[0]; p[1] = pn[1]; }
    }
};
struct EpiDownX2 {
    static constexpr bool PERM = true, AFTER_DRAIN = false, DUAL = false, I8 = false; typedef f32x4 acc_t;
    const bf16_t* xb; bf16_t* xo;
    __device__ __forceinline__ void operator()(const f32x4 (&acc)[2][2][4][2], const Unit& u, int wr, int wc, int fr, int fq) const {
        const int row0 = u.pm * BM + wr * 64 + fr, col0 = u.pn * BM + wc * 32 + 8 * fq;
        u32x4 p[2], pn[2];
        { const size_t off = (size_t)row0 * 4096 + col0; p[0] = *(const u32x4*)(xb + off); p[1] = *(const u32x4*)(xb + off + HALF); }
#pragma unroll
        for (int it = 0; it < 8; ++it) { const int ai = it >> 2, m = it & 3; const size_t off = (size_t)(row0 + ai * HALF + m * 16) * 4096 + col0;
            if (it + 1 < 8) { const size_t offn = (size_t)(row0 + ((it + 1) >> 2) * HALF + ((it + 1) & 3) * 16) * 4096 + col0; pn[0] = *(const u32x4*)(xb + offn); pn[1] = *(const u32x4*)(xb + offn + HALF); }
#pragma unroll
            for (int bj = 0; bj < 2; ++bj) { const u32x4 q = p[bj]; f32x4 v0 = acc[ai][bj][m][0], v1 = acc[ai][bj][m][1];
                v0[0] += bf_lo(q.x); v0[1] += bf_hi(q.x); v0[2] += bf_lo(q.y); v0[3] += bf_hi(q.y); v1[0] += bf_lo(q.z); v1[1] += bf_hi(q.z); v1[2] += bf_lo(q.w); v1[3] += bf_hi(q.w);
                *(u32x4*)(xo + off + bj * HALF) = pack8(v0, v1); }
            p[0] = pn[0]; p[1] = pn[1]; }
    }
};
struct EpiSwiGLU {
    static constexpr bool PERM = true, AFTER_DRAIN = false, DUAL = false, I8 = false; typedef f32x4 acc_t;
    const float* rstd; bf16_t* hid; int pn0;
    __device__ __forceinline__ void operator()(const f32x4 (&acc)[2][2][4][2], const Unit& u, int wr, int wc, int fr, int fq) const {
        const int row0 = u.pm * BM + wr * 64 + fr, col0 = (u.pn + pn0) * HALF + wc * 32 + 8 * fq;
        float rs[2][4];
#pragma unroll
        for (int ai = 0; ai < 2; ++ai)
#pragma unroll
            for (int m = 0; m < 4; ++m) rs[ai][m] = rstd[row0 + ai * HALF + m * 16];
#pragma unroll
        for (int ai = 0; ai < 2; ++ai)
#pragma unroll
            for (int m = 0; m < 4; ++m) { const int row = row0 + ai * HALF + m * 16; const float r = rs[ai][m];
                f32x4 h0, h1;
#pragma unroll
                for (int j = 0; j < 4; ++j) { const float g0 = acc[ai][0][m][0][j] * r, g1 = acc[ai][0][m][1][j] * r;
                    h0[j] = g0 * sigmoid_f(g0) * (acc[ai][1][m][0][j] * r); h1[j] = g1 * sigmoid_f(g1) * (acc[ai][1][m][1][j] * r); }
                *(u32x4*)(hid + (size_t)row * 11008 + col0) = pack8(h0, h1); }
    }
};

struct EpiSwiGLU8 {
    static constexpr bool PERM = true, AFTER_DRAIN = false, DUAL = false, I8 = true; typedef i32x4 acc_t;
    const float* sa; const unsigned* cmax; bf16_t* hid;
    __device__ __forceinline__ void operator()(const i32x4 (&acc)[2][2][4][2], const Unit& u, int wr, int wc, int fr, int fq) const {
        const int row0 = u.pm * BM + wr * 64 + fr, cl = wc * 32 + 8 * fq, col0 = u.pn * HALF + cl;
        float rs[2][4];
#pragma unroll
        for (int ai = 0; ai < 2; ++ai)
#pragma unroll
            for (int m = 0; m < 4; ++m) rs[ai][m] = sa[row0 + ai * HALF + m * 16];
        const f32x4* cg = (const f32x4*)(cmax + u.pn * BM + cl); const f32x4* cu = (const f32x4*)(cmax + u.pn * BM + HALF + cl);
        const f32x4 sg0 = cg[0] * (1.f / 127.f), sg1 = cg[1] * (1.f / 127.f), su0 = cu[0] * (1.f / 127.f), su1 = cu[1] * (1.f / 127.f);
#pragma unroll
        for (int ai = 0; ai < 2; ++ai)
#pragma unroll
            for (int m = 0; m < 4; ++m) { const int row = row0 + ai * HALF + m * 16; const float r = rs[ai][m];
                f32x4 h0, h1;
#pragma unroll
                for (int j = 0; j < 4; ++j) { const float g0 = (float)acc[ai][0][m][0][j] * (r * sg0[j]), g1 = (float)acc[ai][0][m][1][j] * (r * sg1[j]);
                    h0[j] = g0 * sigmoid_f(g0) * ((float)acc[ai][1][m][0][j] * (r * su0[j])); h1[j] = g1 * sigmoid_f(g1) * ((float)acc[ai][1][m][1][j] * (r * su1[j])); }
                *(u32x4*)(hid + (size_t)row * 11008 + col0) = pack8(h0, h1); }
    }
};

struct EpiNull8 {
    static constexpr bool PERM = true, AFTER_DRAIN = false, DUAL = false, I8 = true; typedef i32x4 acc_t;
    bf16_t* sink;
    __device__ __forceinline__ void operator()(const i32x4 (&acc)[2][2][4][2], const Unit& u, int wr, int wc, int fr, int fq) const {
        if (sink == nullptr) {
#pragma unroll
            for (int ai = 0; ai < 2; ++ai)
#pragma unroll
                for (int m = 0; m < 4; ++m)
#pragma unroll
                    for (int bj = 0; bj < 2; ++bj) *(i32x4*)((int*)nullptr + (size_t)(ai * 4 + m) * 4096 + bj * HALF + fr * 8 + fq * 1024 + u.pm) = acc[ai][bj][m][0] + acc[ai][bj][m][1]; }
    }
};

struct EpiNull {
    static constexpr bool PERM = true, AFTER_DRAIN = false, DUAL = false, I8 = false; typedef f32x4 acc_t;
    bf16_t* sink;
    __device__ __forceinline__ void operator()(const f32x4 (&acc)[2][2][4][2], const Unit& u, int wr, int wc, int fr, int fq) const {
        if (sink == nullptr) {
#pragma unroll
            for (int ai = 0; ai < 2; ++ai)
#pragma unroll
                for (int m = 0; m < 4; ++m)
#pragma unroll
                    for (int bj = 0; bj < 2; ++bj) *(u32x4*)((bf16_t*)nullptr + (size_t)(ai * 4 + m) * 4096 + bj * HALF + fr * 8 + fq * 1024 + u.pm) = pack8(acc[ai][bj][m][0], acc[ai][bj][m][1]); }
    }
};


template <class Epi, class Sched, bool ALIGN_EPI = false, bool SP2 = false>
__device__ __forceinline__ void gemm_phase(PG8_LAS unsigned char* lds, const Gemm g, const Sched& S, const Epi& E) {
    const int tid = threadIdx.x, wid = __builtin_amdgcn_readfirstlane(tid >> 6), lane = tid & 63, wr = wid >> 2, wc = wid & 3, fr = lane & 15, fq = lane >> 4;
    constexpr bool I8 = Epi::I8;
    typedef typename Epi::acc_t acc_t;
    const int pitchB = g.K * (I8 ? 1 : 2), nt = pitchB / (BK * 2);
    unsigned voffA[2], voffB[2];
#pragma unroll
    for (int i = 0; i < 2; ++i) { int R, C; stage_rc(tid * 16 + i * 8192, R, C); const int Rb = Epi::PERM ? ((R & ~31) + perm32(R & 31)) : R;
        voffA[i] = (unsigned)(R * pitchB + C * 2); voffB[i] = (unsigned)(Rb * pitchB + C * 2); }
    const size_t kstep = (size_t)(BK * 2);
    const size_t hstep = (size_t)HALF * pitchB;
    const size_t tstep = 2 * hstep;
    const unsigned ldsw = (unsigned)wid * 1024u;
    const int aoff = lds_byte(wr * 64 + fr, fq * 8), boff = lds_byte(wc * 32 + fr, fq * 8);
#define PG8_SA(b, h) (((b) * 2 + (h)) * HTB)
#define PG8_SB(b, h) ((4 + (b) * 2 + (h)) * HTB)
#define PG8_STAGE(bufoff, gbase, voff) do { _Pragma("unroll") for (int _i = 0; _i < 2; ++_i) \
        __builtin_amdgcn_global_load_lds((const unsigned*)((const char*)(gbase) + (voff)[_i]), (PG8_LAS unsigned*)(lds + (bufoff) + ldsw + _i * 8192), 16, 0, 0); } while (0)
#define PG8_LDA(dst, b, h) do { _Pragma("unroll") for (int m = 0; m < 4; ++m) _Pragma("unroll") for (int k = 0; k < 2; ++k) dst[m][k] = *(const PG8_LAS bf16x8*)(lds + PG8_SA(b, h) + aoff + m * 2048 + k * 1024); } while (0)
#define PG8_LDB(dst, b, h) do { _Pragma("unroll") for (int n = 0; n < 2; ++n) _Pragma("unroll") for (int k = 0; k < 2; ++k) dst[n][k] = *(const PG8_LAS bf16x8*)(lds + PG8_SB(b, h) + boff + n * 2048 + k * 1024); } while (0)
#define PG8_MMA(ai, bj, At, Bt) do { __builtin_amdgcn_s_setprio(1); _Pragma("unroll") for (int m = 0; m < 4; ++m) _Pragma("unroll") for (int n = 0; n < 2; ++n) _Pragma("unroll") for (int k = 0; k < 2; ++k) \
        acc[ai][bj][m][n] = mma16(Bt[n][k], At[m][k], acc[ai][bj][m][n]); __builtin_amdgcn_s_setprio(0); } while (0)
#define PG8_WAIT_V(n) asm volatile("s_waitcnt vmcnt(" #n ")" ::: "memory")
#define PG8_WAIT_L(n) asm volatile("s_waitcnt lgkmcnt(" #n ")" ::: "memory")
#define PG8_BAR __builtin_amdgcn_s_barrier()
#define PG8_SCHED __builtin_amdgcn_sched_barrier(0)
    Unit cur, nxt; int ui = 0;
    if (!S.next(0, cur)) return;
    acc_t acc[2][2][4][2];
#pragma unroll
    for (int a = 0; a < 2; ++a)
#pragma unroll
        for (int b = 0; b < 2; ++b)
#pragma unroll
            for (int m = 0; m < 4; ++m)
#pragma unroll
                for (int n = 0; n < 2; ++n) acc[a][b][m][n] = acc_t{};
    bf16x8 At[4][2], B0[2][2], B1[2][2];
    const char* cA = (const char*)(cur.src ? g.A2 : g.A) + (size_t)cur.pm * tstep; const char* cB = (const char*)(cur.src ? g.Bt2 : g.Bt) + (size_t)cur.pn * tstep;
    S.a_ready(cur);
    if constexpr (SP2) {
        PG8_STAGE(PG8_SB(0, 0), cB, voffB); PG8_STAGE(PG8_SB(0, 1), cB + hstep, voffB); PG8_STAGE(PG8_SA(0, 0), cA, voffA); PG8_STAGE(PG8_SA(0, 1), cA + hstep, voffA);
        if (wr == 1) PG8_BAR;
        PG8_WAIT_V(2); PG8_BAR;
        PG8_STAGE(PG8_SB(1, 0), cB + kstep, voffB); PG8_STAGE(PG8_SA(1, 0), cA + kstep, voffA); PG8_STAGE(PG8_SB(1, 1), cB + hstep + kstep, voffB);
        PG8_WAIT_V(6); PG8_BAR;
    } else {
        PG8_STAGE(PG8_SB(0, 0), cB, voffB); PG8_STAGE(PG8_SA(0, 0), cA, voffA); PG8_STAGE(PG8_SB(0, 1), cB + hstep, voffB); PG8_STAGE(PG8_SA(0, 1), cA + hstep, voffA);
        if (wr == 1) PG8_BAR;
        PG8_WAIT_V(4); PG8_BAR;
        PG8_STAGE(PG8_SB(1, 0), cB + kstep, voffB); PG8_STAGE(PG8_SA(1, 0), cA + kstep, voffA); PG8_STAGE(PG8_SB(1, 1), cB + hstep + kstep, voffB);
        PG8_WAIT_V(6); PG8_BAR;
    }
    for (;;) {
        const bool has_next = S.next(ui + 1, nxt);
        const char* nA = has_next ? (const char*)(nxt.src ? g.A2 : g.A) + (size_t)nxt.pm * tstep : cA; const char* nB = has_next ? (const char*)(nxt.src ? g.Bt2 : g.Bt) + (size_t)nxt.pn * tstep : cB;
        for (int t = 0; t < nt; t += 2) {
            const bool last = (t == nt - 2);
            const char* a1 = cA + (size_t)(t + 1) * kstep;
            const char* a2 = last ? nA : cA + (size_t)(t + 2) * kstep; const char* b2 = last ? nB : cB + (size_t)(t + 2) * kstep;
            const char* a3 = a2 + kstep; const char* b3 = b2 + kstep;
            if (last && has_next) S.a_ready(nxt);
            if constexpr (SP2) {
            PG8_LDB(B0, 0, 0); PG8_LDB(B1, 0, 1); PG8_SCHED; PG8_LDA(At, 0, 0); PG8_STAGE(PG8_SA(1, 1), a1 + hstep, voffA);
            PG8_WAIT_V(8); PG8_WAIT_L(0); PG8_BAR; PG8_MMA(0, 0, At, B0); PG8_MMA(0, 1, At, B1); PG8_BAR; PG8_SCHED;
            PG8_LDA(At, 0, 1); PG8_STAGE(PG8_SB(0, 0), b2, voffB); PG8_STAGE(PG8_SB(0, 1), b2 + hstep, voffB); PG8_STAGE(PG8_SA(0, 0), a2, voffA);
            PG8_WAIT_V(8); PG8_WAIT_L(0); PG8_BAR; PG8_MMA(1, 0, At, B0); PG8_MMA(1, 1, At, B1); PG8_BAR; PG8_SCHED;
            PG8_LDB(B0, 1, 0); PG8_LDB(B1, 1, 1); PG8_SCHED; PG8_LDA(At, 1, 0); PG8_STAGE(PG8_SA(0, 1), a2 + hstep, voffA);
            PG8_WAIT_V(8); PG8_WAIT_L(0); PG8_BAR; PG8_MMA(0, 0, At, B0); PG8_MMA(0, 1, At, B1); PG8_BAR; PG8_SCHED;
            PG8_LDA(At, 1, 1); PG8_STAGE(PG8_SB(1, 0), b3, voffB); PG8_STAGE(PG8_SB(1, 1), b3 + hstep, voffB); PG8_STAGE(PG8_SA(1, 0), a3, voffA);
            PG8_WAIT_V(8); PG8_WAIT_L(0); PG8_BAR; PG8_MMA(1, 0, At, B0); PG8_MMA(1, 1, At, B1); PG8_BAR; PG8_SCHED;
            } else {
            PG8_LDB(B0, 0, 0); PG8_SCHED; PG8_LDA(At, 0, 0); PG8_STAGE(PG8_SA(1, 1), a1 + hstep, voffA);
            PG8_WAIT_L(8); PG8_BAR; PG8_WAIT_L(0); PG8_MMA(0, 0, At, B0); PG8_BAR; PG8_SCHED;
            PG8_LDB(B1, 0, 1); PG8_STAGE(PG8_SB(0, 0), b2, voffB);
            PG8_BAR; PG8_WAIT_L(0); PG8_MMA(0, 1, At, B1); PG8_BAR;
            PG8_LDA(At, 0, 1); PG8_STAGE(PG8_SA(0, 0), a2, voffA);
            PG8_BAR; PG8_WAIT_L(0); PG8_MMA(1, 0, At, B0); PG8_BAR; PG8_SCHED;
            PG8_STAGE(PG8_SB(0, 1), b2 + hstep, voffB);
            PG8_WAIT_V(6); PG8_BAR; PG8_MMA(1, 1, At, B1); PG8_BAR;
            PG8_LDB(B0, 1, 0); PG8_SCHED; PG8_LDA(At, 1, 0); PG8_STAGE(PG8_SA(0, 1), a2 + hstep, voffA);
            PG8_WAIT_L(8); PG8_BAR; PG8_WAIT_L(0); PG8_MMA(0, 0, At, B0); PG8_BAR; PG8_SCHED;
            PG8_LDB(B1, 1, 1); PG8_STAGE(PG8_SB(1, 0), b3, voffB);
            PG8_BAR; PG8_WAIT_L(0); PG8_MMA(0, 1, At, B1); PG8_BAR;
            PG8_LDA(At, 1, 1); PG8_STAGE(PG8_SA(1, 0), a3, voffA);
            PG8_BAR; PG8_WAIT_L(0); PG8_MMA(1, 0, At, B0); PG8_BAR; PG8_SCHED;
            PG8_STAGE(PG8_SB(1, 1), b3 + hstep, voffB);
            PG8_WAIT_V(6); PG8_BAR; PG8_MMA(1, 1, At, B1); PG8_BAR;
            }
        }
        if constexpr (ALIGN_EPI) { if (wr == 0) PG8_BAR; }
        bool keep_acc = false;
        if constexpr (Epi::DUAL) { if (cur.src == 0) { E.mid(acc, cur, wr, wc, fr, fq); keep_acc = true; } }
        if (!keep_acc) { E(acc, cur, wr, wc, fr, fq); S.done(cur); }
        if (!has_next) break;
        if (!keep_acc) {
#pragma unroll
        for (int a = 0; a < 2; ++a)
#pragma unroll
            for (int b = 0; b < 2; ++b)
#pragma unroll
                for (int m = 0; m < 4; ++m)
#pragma unroll
                    for (int n = 0; n < 2; ++n) acc[a][b][m][n] = acc_t{};
        }
        cur = nxt; cA = nA; cB = nB; ++ui;
        if constexpr (ALIGN_EPI) { if (wr == 1) PG8_BAR; }
    }
    PG8_WAIT_V(0);
    if constexpr (!ALIGN_EPI) { if (wr == 0) PG8_BAR; }
    PG8_BAR;
#undef PG8_SA
#undef PG8_SB
#undef PG8_STAGE
#undef PG8_LDA
#undef PG8_LDB
#undef PG8_MMA
#undef PG8_WAIT_V
#undef PG8_WAIT_L
#undef PG8_BAR
#undef PG8_SCHED
}
}
namespace fox {
using bf16 = unsigned short;
typedef short bf16x8 __attribute__((ext_vector_type(8)));
typedef short s16x4 __attribute__((ext_vector_type(4)));
typedef float f32x16 __attribute__((ext_vector_type(16)));
typedef float f32x4 __attribute__((ext_vector_type(4)));
typedef unsigned u32x4 __attribute__((ext_vector_type(4)));
template <class A, class Bt> struct same_t { static constexpr bool v = false; };
template <class A> struct same_t<A, A> { static constexpr bool v = true; };
constexpr int D = 128, PITCH = 2048;
constexpr float SCALE = 0.08838834764831845f;
constexpr float THR = 8.f;
constexpr bool WSKIP = false;
constexpr int NW = 8, QBLK = 32, KVBLK = 64, QB = NW * QBLK;
constexpr int SHM_V = KVBLK * D * 2, SHM_K = KVBLK * D * 2;
constexpr int LDS_BIAS = 2 * SHM_V + 2 * SHM_K + NW * 64 * 4;
constexpr int LDS_BYTES = LDS_BIAS + 2 * 4096 * 4;
#define KSWZ(row, colB) ((row) * 256 + ((colB) ^ (((row) & 7) << 4)))
#define SBAR() __builtin_amdgcn_sched_barrier(0)
__device__ __forceinline__ int v_st(int k, int c) { const int kk = (k & ~0xC) | ((k & 4) << 1) | ((k & 8) >> 1); return ((kk >> 3) * 4 + (c >> 5)) * 512 + ((kk & 7) * 32 + (c & 31)) * 2; }
__device__ __forceinline__ int v_rd_base(int lane) { return ((lane & 3) << 3) | (((lane >> 2) & 3) << 6) | (((lane >> 4) & 1) << 5) | (((lane >> 5) & 1) << 8); }
constexpr int v_rd_off(int d0, int ks, int half) { return d0 * 512 + ks * 4096 + half * 2048; }
__device__ __forceinline__ int crow(int r, int hi) { return (r & 3) + 8 * (r >> 2) + 4 * hi; }
__device__ __forceinline__ unsigned cvtpk(float lo, float hi) { return pg8::cvt_pk_bf16(lo, hi); }
__device__ __forceinline__ bf16x8 pack8(f32x4 a, f32x4 b) {
    u32x4 w = {cvtpk(a[0], a[1]), cvtpk(a[2], a[3]), cvtpk(b[0], b[1]), cvtpk(b[2], b[3])};
    return *reinterpret_cast<bf16x8*>(&w);
}
template <class T> __device__ __forceinline__ bf16x8 load8(const T* p) {
    if constexpr (same_t<T, float>::v) { return pack8(*(const f32x4*)p, *(const f32x4*)(p + 4)); }
    else { return *reinterpret_cast<const bf16x8*>(p); }
}
__device__ __forceinline__ void mask_tile(f32x16& p0, f32x16& p1, int dq, unsigned W) {
    const float NEG = -__builtin_inff();
#pragma unroll
    for (int r = 0; r < 16; ++r) {
        const int c = (r & 3) + 8 * (r >> 2);
        if ((unsigned)(dq - c) >= W) p0[r] = NEG;
        if ((unsigned)(dq - c - 32) >= W) p1[r] = NEG;
    }
}
__device__ __forceinline__ void partialSM(f32x16& p0, f32x16& p1, float& m_reg, float& mn, float& alpha) {
    float pmax = p0[0]; for (int r = 1; r < 16; ++r) pmax = fmaxf(pmax, p0[r]); for (int r = 0; r < 16; ++r) pmax = fmaxf(pmax, p1[r]);
    { auto rr = __builtin_amdgcn_permlane32_swap(__float_as_uint(pmax), __float_as_uint(pmax), false, false);
      pmax = fmaxf(__uint_as_float(rr[0]), __uint_as_float(rr[1])); }
    constexpr float C2 = 1.4426950408889634f * SCALE;
    if (__builtin_expect(__all((pmax - m_reg) * SCALE <= THR), 1)) { mn = m_reg; alpha = 1.f; }
    else { mn = fmaxf(m_reg, pmax); alpha = __builtin_amdgcn_exp2f((m_reg - mn) * C2); m_reg = mn; }
    const float mnL = -mn * C2;
    for (int r = 0; r < 16; ++r) p0[r] = fmaf(p0[r], C2, mnL); for (int r = 0; r < 16; ++r) p1[r] = fmaf(p1[r], C2, mnL);
    for (int r = 0; r < 16; ++r) p0[r] = __builtin_amdgcn_exp2f(p0[r]);
}
__device__ __forceinline__ void finishSM(f32x16& p0, f32x16& p1, float alpha, float& l_reg, bf16x8& pa0, bf16x8& pa1, bf16x8& pa2, bf16x8& pa3) {
    for (int r = 0; r < 16; ++r) p1[r] = __builtin_amdgcn_exp2f(p1[r]);
    float ps = 0; for (int r = 0; r < 16; ++r) ps += p0[r]; for (int r = 0; r < 16; ++r) ps += p1[r];
    { auto rr = __builtin_amdgcn_permlane32_swap(__float_as_uint(ps), __float_as_uint(ps), false, false);
      ps = __uint_as_float(rr[0]) + __uint_as_float(rr[1]); }
    l_reg = l_reg * alpha + ps;
#define PK4(P, B_, OUT) do { unsigned a0 = cvtpk(P[B_+0], P[B_+1]), a1 = cvtpk(P[B_+2], P[B_+3]);                          \
        unsigned b0 = cvtpk(P[B_+4], P[B_+5]), b1 = cvtpk(P[B_+6], P[B_+7]);                                             \
        auto r0 = __builtin_amdgcn_permlane32_swap(a0, b0, false, false); auto r1 = __builtin_amdgcn_permlane32_swap(a1, b1, false, false); \
        u32x4 w = {r0[0], r1[0], r0[1], r1[1]}; OUT = *reinterpret_cast<bf16x8*>(&w); } while (0)
    PK4(p0, 0, pa0); PK4(p0, 8, pa1); PK4(p1, 0, pa2); PK4(p1, 8, pa3);
#undef PK4
}
template <int KB, bool SK>
__device__ __forceinline__ void qkt(f32x16& p0, f32x16& p1, const char* K_lds, int r32, int hi, const bf16x8* qr, bool act, const char* bias_t) {
    if (SK && !act) { const float NEG = -__builtin_inff();
#pragma unroll
        for (int r = 0; r < 16; ++r) { p0[r] = NEG; p1[r] = NEG; } return; }
#ifdef FOX_NOBIAS
    p0 = f32x16{}; p1 = f32x16{};
#else
#pragma unroll
    for (int g = 0; g < 4; ++g) { const f32x4 b0 = *reinterpret_cast<const f32x4*>(bias_t + g * 32), b1 = *reinterpret_cast<const f32x4*>(bias_t + 128 + g * 32);
        p0[4 * g] = b0[0]; p0[4 * g + 1] = b0[1]; p0[4 * g + 2] = b0[2]; p0[4 * g + 3] = b0[3]; p1[4 * g] = b1[0]; p1[4 * g + 1] = b1[1]; p1[4 * g + 2] = b1[2]; p1[4 * g + 3] = b1[3]; }
#endif
    const char* kb[4];
#pragma unroll
    for (int dd = 0; dd < 4; ++dd) kb[dd] = K_lds + KB * SHM_K + KSWZ(r32, (dd * 16 + hi * 8) * 2);
#pragma unroll
    for (int d0 = 0; d0 < 8; ++d0) { const char* a = kb[d0 & 3] + (d0 >> 2) * 128;
        bf16x8 b0 = *reinterpret_cast<const bf16x8*>(a);
        bf16x8 b1 = *reinterpret_cast<const bf16x8*>(a + 32 * 256);
        p0 = __builtin_amdgcn_mfma_f32_32x32x16_bf16(b0, qr[d0], p0, 0, 0, 0);
        p1 = __builtin_amdgcn_mfma_f32_32x32x16_bf16(b1, qr[d0], p1, 0, 0, 0); }
}
template <int VB, bool SK>
__device__ __forceinline__ void pv_tile(f32x16* o, int vb0, bf16x8 pa0, bf16x8 pa1, bf16x8 pa2, bf16x8 pa3, bool act) {
    if (SK && !act) return;
#define TRRD(dst, off) asm volatile("ds_read_b64_tr_b16 %0, %1 offset:%2" : "=&v"(dst) : "v"(vb0), "i"(off) : "memory")
#define PV_D0(d0) do { s16x4 l0, l1, l2, l3, h0, h1, h2, h3; constexpr int b_ = VB * SHM_V + v_rd_off(d0, 0, 0);     \
        TRRD(l0, b_); TRRD(h0, b_ + 2048); TRRD(l1, b_ + 4096); TRRD(h1, b_ + 6144); TRRD(l2, b_ + 8192); TRRD(h2, b_ + 10240); TRRD(l3, b_ + 12288); TRRD(h3, b_ + 14336); \
        asm volatile("s_waitcnt lgkmcnt(0)" ::: "memory"); SBAR();                 \
        o[d0] = __builtin_amdgcn_mfma_f32_32x32x16_bf16(pa0, (bf16x8){l0[0], l0[1], l0[2], l0[3], h0[0], h0[1], h0[2], h0[3]}, o[d0], 0, 0, 0);   \
        o[d0] = __builtin_amdgcn_mfma_f32_32x32x16_bf16(pa1, (bf16x8){l1[0], l1[1], l1[2], l1[3], h1[0], h1[1], h1[2], h1[3]}, o[d0], 0, 0, 0);   \
        o[d0] = __builtin_amdgcn_mfma_f32_32x32x16_bf16(pa2, (bf16x8){l2[0], l2[1], l2[2], l2[3], h2[0], h2[1], h2[2], h2[3]}, o[d0], 0, 0, 0);   \
        o[d0] = __builtin_amdgcn_mfma_f32_32x32x16_bf16(pa3, (bf16x8){l3[0], l3[1], l3[2], l3[3], h3[0], h3[1], h3[2], h3[3]}, o[d0], 0, 0, 0); } while (0)
    PV_D0(0); PV_D0(1); PV_D0(2); PV_D0(3);
#undef PV_D0
#undef TRRD
}
template <class TIn, class TOut> struct BlockRef { const TIn* Q; const TIn* K; const TIn* V; TOut* O; int P0; int jlo; int boff; };
template <class TIn> struct Seam {
    bf16x8 qr[8];
    bf16x8 st_v0, st_v1, st_k0, st_k1; f32x4 sf0, sf1, sf2, sf3;
    f32x4 tq[16];
};
__device__ __forceinline__ int swa_jlo(int P0, int W) { const int lowk = P0 - W + 1; return lowk > 0 ? lowk / KVBLK : 0; }
#define ROW(p, k0, rr) ((p) + ((size_t)(k0) + ((rr) - sr)) * PITCH + soff)
#define VMW() asm volatile("s_waitcnt vmcnt(0)" ::: "memory")
#define VMWN(n) asm volatile("s_waitcnt vmcnt(%0)" :: "i"(n) : "memory")
#define SLOAD_H(Kp, Vp, k0) do { S.st_v0 = load8<TIn>(ROW(Vp, k0, sr)); S.st_v1 = load8<TIn>(ROW(Vp, k0, 32 + sr));              \
                         S.st_k0 = load8<TIn>(ROW(Kp, k0, sr)); S.st_k1 = load8<TIn>(ROW(Kp, k0, 32 + sr)); } while (0)
#define SWRITE_HK(bf) do { *(bf16x8*)(K_lds + (bf) * SHM_K + kws) = S.st_k0; *(bf16x8*)(K_lds + (bf) * SHM_K + kws + 32 * 256) = S.st_k1; } while (0)
#define SWRITE_HV(bf) do { *(bf16x8*)(V_lds + (bf) * SHM_V + vst0) = S.st_v0; *(bf16x8*)(V_lds + (bf) * SHM_V + vst1) = S.st_v1; } while (0)
#define SWRITE_H(bf) do { SWRITE_HV(bf); SWRITE_HK(bf); } while (0)
#define SLOAD_F(p, k0) do { S.sf0 = *(const f32x4*)ROW(p, k0, sr); S.sf1 = *(const f32x4*)(ROW(p, k0, sr) + 4);                \
                            S.sf2 = *(const f32x4*)ROW(p, k0, 32 + sr); S.sf3 = *(const f32x4*)(ROW(p, k0, 32 + sr) + 4); } while (0)
#define SWRITE_KF(bf) do { *(bf16x8*)(K_lds + (bf) * SHM_K + kws) = pack8(S.sf0, S.sf1); *(bf16x8*)(K_lds + (bf) * SHM_K + kws + 32 * 256) = pack8(S.sf2, S.sf3); } while (0)
#define SWRITE_VF(bf) do { *(bf16x8*)(V_lds + (bf) * SHM_V + vst0) = pack8(S.sf0, S.sf1); *(bf16x8*)(V_lds + (bf) * SHM_V + vst1) = pack8(S.sf2, S.sf3); } while (0)
template <class TIn, class TOut>
__device__ __forceinline__ void causal_swa_prime(const BlockRef<TIn, TOut>& cur, int W, char* lds, Seam<TIn>& S) {
    constexpr bool F32 = same_t<TIn, float>::v;
    const int tid = threadIdx.x, wid = __builtin_amdgcn_readfirstlane(tid >> 6), lane = tid & 63, r32 = lane & 31, hi = lane >> 5;
    const int sr = tid >> 4, sc = (tid & 15) * 8, kws = KSWZ(sr, sc * 2); char* K_lds = lds + 2 * SHM_V; const unsigned soff = (unsigned)(sr * PITCH + sc), qoff = (unsigned)(r32 * PITCH + hi * 8);
    const int kb0 = cur.jlo * KVBLK;
    for (int d0 = 0; d0 < 8; ++d0) S.qr[d0] = load8<TIn>(cur.Q + (size_t)(wid * QBLK) * PITCH + qoff + d0 * 16);
    if constexpr (F32) { SLOAD_F((const float*)cur.K, kb0); VMW(); SWRITE_KF(0); SBAR(); SLOAD_F((const float*)cur.V, kb0); }
    else { SLOAD_H(cur.K, cur.V, kb0); VMW(); SWRITE_HK(0); }
    __syncthreads();
}
template <class TIn, class TOut>
__device__ __forceinline__ void causal_swa_block(const BlockRef<TIn, TOut>& cur, const BlockRef<TIn, TOut>& nxt, int skv, int W, char* lds, Seam<TIn>& S) {
    constexpr bool F32 = same_t<TIn, float>::v;
    const int tid = threadIdx.x, wid = __builtin_amdgcn_readfirstlane(tid >> 6), lane = tid & 63, r32 = lane & 31, hi = lane >> 5;
    const int j_lo = cur.jlo;
    int j_hi = (cur.P0 + QB - 1) / KVBLK + 1; if (j_hi > skv / KVBLK) j_hi = skv / KVBLK;
    const int NT = j_hi - j_lo;
    const int kbn = nxt.jlo * KVBLK;
    const int qlo = cur.P0 + wid * QBLK, qm = qlo + r32 - 4 * hi;
    char* V_lds = lds; char* K_lds = lds + 2 * SHM_V; const char* bias_h = lds + cur.boff + hi * 16;
    float* ws = (float*)(lds + 2 * SHM_V + 2 * SHM_K) + wid * 64; float* li_l = ws, * al_l = ws + 32;
    float m_reg = -1e30f, l_reg = 0; f32x16 o[4] = {};
    const int sr = tid >> 4, sc = (tid & 15) * 8, vst0 = v_st(sr, sc), vst1 = v_st(32 + sr, sc), kws = KSWZ(sr, sc * 2); const unsigned soff = (unsigned)(sr * PITCH + sc), qoff = (unsigned)(r32 * PITCH + hi * 8), ooff = (unsigned)(4 * hi * PITCH + r32);
    const int vb0 = (int)(uintptr_t)V_lds + v_rd_base(lane);
    const TIn* Kh = cur.K; const TIn* Vh = cur.V;
#define RESC(a) do { if (__any((a) < 1.f)) { if (hi == 0) al_l[r32] = (a); asm volatile("s_waitcnt lgkmcnt(0)" ::: "memory");              \
                     for (int d_ = 0; d_ < 4; ++d_) for (int r = 0; r < 16; ++r) o[d_][r] *= al_l[crow(r, hi)]; } } while (0)
#define KBASE(t) ((j_lo + (t)) * KVBLK)
#define BIAS_T(t) (bias_h + KBASE(t) * 4)
#define ACT(t) (KBASE(t) <= qlo + QBLK - 1 && KBASE(t) + KVBLK - 1 >= qlo - W + 1)
#define MASKT(P0_, P1_, t) do { const int kb_ = KBASE(t); if ((!SK || ACT(t)) && (kb_ + KVBLK - 1 > qlo || kb_ <= qlo + QBLK - 1 - W)) mask_tile(P0_, P1_, qm - kb_, (unsigned)W); } while (0)
    constexpr int NQL = F32 ? 16 : 8;
    constexpr bool SK = WSKIP && !F32;
#define SEAM_K0() do { VMWN(NQL); if constexpr (F32) { SWRITE_KF(0); SBAR(); SLOAD_F((const float*)nxt.V, kbn); } else { SWRITE_HK(0); } SBAR(); } while (0)
    f32x16 pA0, pA1, pB0, pB1; float mnA, mnB, alA, alB; bf16x8 pa0, pa1, pa2, pa3;
    if constexpr (F32) { VMW(); SWRITE_VF(0); SBAR(); } else { SWRITE_HV(0); SBAR(); }
    if (NT > 1) { if constexpr (F32) SLOAD_F((const float*)Kh, KBASE(1)); else SLOAD_H(Kh, Vh, KBASE(1)); }
    SBAR(); qkt<0, SK>(pA0, pA1, K_lds, r32, hi, S.qr, ACT(0), BIAS_T(0));
    if constexpr (F32) { if (NT > 1) { VMW(); SWRITE_KF(1); SBAR(); SLOAD_F((const float*)Vh, KBASE(1)); } }
    MASKT(pA0, pA1, 0); partialSM(pA0, pA1, m_reg, mnA, alA);
    if (NT > 1) { VMW(); if constexpr (F32) { SWRITE_VF(1); SBAR(); if (NT > 2) SLOAD_F((const float*)Kh, KBASE(2)); } else SWRITE_H(1); }
    __syncthreads();
#define HALF_STEP(PX0, PX1, mnX, alX, PY0, PY1, alY, t, KB, VB, SB) do {                                                      \
        SBAR(); qkt<KB, SK>(PX0, PX1, K_lds, r32, hi, S.qr, ACT(t), BIAS_T(t));                                             \
        finishSM(PY0, PY1, alY, l_reg, pa0, pa1, pa2, pa3); SBAR();                                                           \
        if ((t) + 1 < NT) { if constexpr (F32) { VMW(); SWRITE_KF(SB); SBAR(); SLOAD_F((const float*)Vh, KBASE((t) + 1)); }  \
                            else { SLOAD_H(Kh, Vh, KBASE((t) + 1)); } SBAR(); }                                               \
        pv_tile<VB, SK>(o, vb0, pa0, pa1, pa2, pa3, ACT((t) - 1)); MASKT(PX0, PX1, (t)); partialSM(PX0, PX1, m_reg, mnX, alX);                                        \
        __syncthreads();                                                                                                      \
        if ((t) + 1 < NT) { VMW(); if constexpr (F32) { SWRITE_VF(SB); SBAR(); if ((t) + 2 < NT) SLOAD_F((const float*)Kh, KBASE((t) + 2)); } \
                            else { SWRITE_H(SB); } }                                                                          \
        RESC(alX); __syncthreads(); } while (0)
    for (int t = 1; t + 1 < NT; t += 2) {
        HALF_STEP(pB0, pB1, mnB, alB, pA0, pA1, alA, t, 1, 0, 0);
        HALF_STEP(pA0, pA1, mnA, alA, pB0, pB1, alB, t + 1, 0, 1, 1);
    }
    const bool even = (NT & 1) == 0;
    if (even) { SBAR(); qkt<1, SK>(pB0, pB1, K_lds, r32, hi, S.qr, ACT(NT - 1), BIAS_T(NT - 1)); SBAR(); }
#define QROW(e) (nxt.Q + (size_t)(wid * QBLK) * PITCH + qoff + ((e) >> 1) * 16 + ((e) & 1) * 4)
    if constexpr (F32) { SLOAD_F((const float*)nxt.K, kbn); SBAR();
#pragma unroll
        for (int e = 0; e < 8; ++e) S.tq[e] = *(const f32x4*)QROW(e); }
    else { SLOAD_H(nxt.K, nxt.V, kbn); SBAR();
#pragma unroll
        for (int d0 = 0; d0 < 8; ++d0) S.qr[d0] = load8<TIn>(nxt.Q + (size_t)(wid * QBLK) * PITCH + qoff + d0 * 16); }
    SBAR();
    finishSM(pA0, pA1, alA, l_reg, pa0, pa1, pa2, pa3); SBAR();
    if constexpr (F32) {
#pragma unroll
        for (int e = 8; e < 16; ++e) S.tq[e] = *(const f32x4*)QROW(e); SBAR(); }
#undef QROW
    pv_tile<0, SK>(o, vb0, pa0, pa1, pa2, pa3, ACT(even ? NT - 2 : NT - 1));
    if (even) { MASKT(pB0, pB1, NT - 1); partialSM(pB0, pB1, m_reg, mnB, alB); __syncthreads(); RESC(alB);
        finishSM(pB0, pB1, alB, l_reg, pa0, pa1, pa2, pa3); SBAR(); pv_tile<1, SK>(o, vb0, pa0, pa1, pa2, pa3, ACT(NT - 1)); }
    SBAR(); SEAM_K0();
    if (hi == 0) li_l[r32] = l_reg; asm volatile("s_waitcnt lgkmcnt(0)" ::: "memory");
    float rli[16];
#pragma unroll
    for (int r = 0; r < 16; ++r) rli[r] = __builtin_amdgcn_rcpf(li_l[crow(r, hi)]);
    TOut* Ow = cur.O + (size_t)(wid * QBLK) * PITCH;
#pragma unroll
    for (int r = 0; r < 16; ++r) { const int orow = (r & 3) + 8 * (r >> 2);
#pragma unroll
        for (int d0 = 0; d0 < 4; ++d0) { const float v = o[d0][r] * rli[r];
            if constexpr (same_t<TOut, float>::v) { Ow[(size_t)orow * PITCH + d0 * 32 + ooff] = v; }
            else { const float vn = __shfl_xor(v, 1);
                   if ((r32 & 1) == 0) *(unsigned*)(Ow + (size_t)orow * PITCH + d0 * 32 + ooff) = cvtpk(v, vn); } } }
    if constexpr (F32) {
#pragma unroll
        for (int d0 = 0; d0 < 8; ++d0) S.qr[d0] = pack8(S.tq[2 * d0], S.tq[2 * d0 + 1]); }
    __syncthreads();
#undef RESC
#undef KBASE
#undef BIAS_T
#undef ACT
#undef MASKT
#undef SEAM_K0
#undef HALF_STEP
}
#undef ROW
#undef VMW
#undef VMWN
#undef SLOAD_H
#undef SWRITE_HK
#undef SWRITE_HV
#undef SWRITE_H
#undef SLOAD_F
#undef SWRITE_KF
#undef SWRITE_VF

}
namespace swa {
using bf16 = unsigned short;
typedef short bf16x8 __attribute__((ext_vector_type(8)));
typedef short s16x4 __attribute__((ext_vector_type(4)));
typedef float f32x16 __attribute__((ext_vector_type(16)));
typedef unsigned u32x4 __attribute__((ext_vector_type(4)));
constexpr int KP = 144, VP = 520;
constexpr int LDS_K = 0, LDS_V = 256 * KP, LDS_TBL = LDS_V + 64 * VP, LDS_BYTES = LDS_TBL + 8 * 192 * 4;
constexpr float LOG2E = 1.4426950408889634f;
struct Tensors { const bf16* Q; const bf16* K; const bf16* V; bf16* O; const float* sinks; const float* relb; };
__device__ __forceinline__ int t5_bucket(int d) {
    if (d < 16) return d;
    return 16 + (d >= 19) + (d >= 21) + (d >= 24) + (d >= 27) + (d >= 31) + (d >= 35) + (d >= 40) + (d >= 46) + (d >= 52) + (d >= 59) + (d >= 67) + (d >= 77) + (d >= 87) + (d >= 99) + (d >= 113);
}
__device__ __forceinline__ unsigned cvtpk(float lo, float hi) { return pg8::cvt_pk_bf16(lo, hi); }

__device__ __forceinline__ void swa_unit(char* lds, const Tensors& T, int b, int kvh, int blk) {
    const int tid = threadIdx.x, wid = __builtin_amdgcn_readfirstlane(tid >> 6), lane = tid & 63, c32 = lane & 31, hi = lane >> 5;
    const int hq = kvh * 8 + wid;
    const float NEG = -__builtin_inff();
    const long tok0 = (long)b * 4096 + 128 * (blk - 1);
#pragma unroll
    for (int i = 0; i < 4; ++i) {
        const int id = tid + 512 * i, key = id >> 3, ch = id & 7;
        bf16x8 kv = {0, 0, 0, 0, 0, 0, 0, 0}, vv = {0, 0, 0, 0, 0, 0, 0, 0};
        if (blk > 0 || key >= 128) { const size_t off = (size_t)(tok0 + key) * 256 + kvh * 64 + ch * 8; kv = *(const bf16x8*)(T.K + off); vv = *(const bf16x8*)(T.V + off); }
        *(bf16x8*)(lds + LDS_K + key * KP + ch * 16) = kv;
#pragma unroll
        for (int j = 0; j < 8; ++j) *(short*)(lds + LDS_V + (ch * 8 + j) * VP + key * 2) = vv[j];
    }
    float* tbl = (float*)(lds + LDS_TBL) + wid * 192;
    for (int j = lane; j < 192; j += 64) { const int dist = j - 32; float v = NEG; if (dist >= 0 && dist < 128) v = T.relb[t5_bucket(dist) * 32 + hq] * LOG2E; tbl[j] = v; }
    const float sink2 = T.sinks[hq] * LOG2E;
    __syncthreads();
    const float* tb = tbl + (c32 - 4 * hi + 160);
    for (int a = 0; a < 4; ++a) {
        const size_t qrow = (size_t)b * 4096 + blk * 128 + a * 32 + c32;
        bf16x8 qf[4];
#pragma unroll
        for (int ks = 0; ks < 4; ++ks) qf[ks] = *(const bf16x8*)(T.Q + qrow * 2048 + hq * 64 + ks * 16 + hi * 8);
        f32x16 S[5];
#pragma unroll
        for (int t = 0; t < 5; ++t) {
            S[t] = f32x16{};
            const char* kp = lds + LDS_K + (32 * (a + t) + c32) * KP + hi * 16;
#pragma unroll
            for (int ks = 0; ks < 4; ++ks) { const bf16x8 kf = *(const bf16x8*)(kp + ks * 32); S[t] = __builtin_amdgcn_mfma_f32_32x32x16_bf16(kf, qf[ks], S[t], 0, 0, 0); }
        }
        float mx = sink2;
#pragma unroll
        for (int t = 0; t < 5; ++t) {
            const bool dead = (blk == 0) && (a + t < 4);
#pragma unroll
            for (int r = 0; r < 16; ++r) {
                float s = fmaf(S[t][r], 0.125f * LOG2E, tb[-((r & 3) + 8 * (r >> 2)) - 32 * t]);
                if (dead) s = NEG;
                S[t][r] = s; mx = fmaxf(mx, s);
            }
        }
        mx = fmaxf(mx, __shfl_xor(mx, 32));
        float sum = 0.f;
#pragma unroll
        for (int t = 0; t < 5; ++t)
#pragma unroll
            for (int r = 0; r < 16; ++r) { const float p = __builtin_amdgcn_exp2f(S[t][r] - mx); S[t][r] = p; sum += p; }
        sum += __shfl_xor(sum, 32);
        const float inv = 1.f / (sum + __builtin_amdgcn_exp2f(sink2 - mx));
        f32x16 O0 = f32x16{}, O1 = f32x16{};
#pragma unroll
        for (int t = 0; t < 5; ++t)
#pragma unroll
            for (int s = 0; s < 2; ++s) {
                u32x4 aw; aw.x = cvtpk(S[t][8 * s] * inv, S[t][8 * s + 1] * inv); aw.y = cvtpk(S[t][8 * s + 2] * inv, S[t][8 * s + 3] * inv);
                aw.z = cvtpk(S[t][8 * s + 4] * inv, S[t][8 * s + 5] * inv); aw.w = cvtpk(S[t][8 * s + 6] * inv, S[t][8 * s + 7] * inv);
                const bf16x8 af = __builtin_bit_cast(bf16x8, aw);
                const char* vp = lds + LDS_V + c32 * VP + (32 * (a + t) + 16 * s + 4 * hi) * 2;
                const s16x4 l0 = *(const s16x4*)(vp), h0 = *(const s16x4*)(vp + 16), l1 = *(const s16x4*)(vp + 32 * VP), h1 = *(const s16x4*)(vp + 32 * VP + 16);
                O0 = __builtin_amdgcn_mfma_f32_32x32x16_bf16(af, (bf16x8){l0[0], l0[1], l0[2], l0[3], h0[0], h0[1], h0[2], h0[3]}, O0, 0, 0, 0);
                O1 = __builtin_amdgcn_mfma_f32_32x32x16_bf16(af, (bf16x8){l1[0], l1[1], l1[2], l1[3], h1[0], h1[1], h1[2], h1[3]}, O1, 0, 0, 0);
            }
        bf16* Ob = T.O + ((size_t)b * 4096 + blk * 128 + a * 32) * 2048 + hq * 64;
#pragma unroll
        for (int r = 0; r < 16; ++r) { const int q = (r & 3) + 8 * (r >> 2) + 4 * hi;
            const float v0 = O0[r], v1 = O1[r]; const float n0 = __shfl_xor(v0, 1), n1 = __shfl_xor(v1, 1);
            if ((c32 & 1) == 0) { *(unsigned*)(Ob + (size_t)q * 2048 + c32) = cvtpk(v0, n0); *(unsigned*)(Ob + (size_t)q * 2048 + 32 + c32) = cvtpk(v1, n1); } }
    }
    __syncthreads();
}
}

constexpr int NWAVES = 8;
#ifndef FFN_I8
#define FFN_I8 1
#endif
#ifndef PG_ALIGN
#define PG_ALIGN true
#endif
#ifndef PG_SP2
#define PG_SP2 true
#endif
#ifndef PROBE8_SKIP_BF16
#define PROBE8_SKIP_BF16 0
#endif
#ifndef FFN_I8_TILES
#define FFN_I8_TILES 78
#endif
#ifndef MK_N_LAUNCHES
#define MK_N_LAUNCHES 1
#endif
constexpr int PER_PHASE = 11;
constexpr int N_LAUNCHES = MK_N_LAUNCHES;
static_assert(N_LAUNCHES == 1 || N_LAUNCHES == PER_PHASE, "MK_N_LAUNCHES is 1 or 11");

constexpr int BATCH = 4, SEQ = 4096, DM = 4096, M = BATCH * SEQ;
constexpr int H_A = 16, H_B = 32, HKV_B = 4;
constexpr int W_IN = 16912, D_FF = 11008;
constexpr int N_IN = pg8::IN_TILES * 256;
constexpr int N_INQ = pg8::INQ_TILES * 256;
constexpr int N_WIN = N_IN + N_INQ;
constexpr float EPS = 1e-6f;

constexpr size_t MiB = 1u << 20;
constexpr size_t WS_CTL = 0, CTL_ZERO_BYTES = 512 * 1024;
constexpr size_t WS_RSTD1 = 1 * MiB;
constexpr size_t WS_SX = 1 * MiB + 256 * 1024;
constexpr size_t WS_SA = 1 * MiB + 512 * 1024;
constexpr size_t WS_WIN = 2 * MiB;
constexpr size_t WS_WA = 136 * MiB, WS_WB = 152 * MiB, WS_WO = 168 * MiB;
constexpr size_t WS_Q4 = 200 * MiB;
constexpr size_t WS_KB = 456 * MiB, WS_VB = 464 * MiB;
constexpr size_t WS_LF = 472 * MiB, WS_CC = 473 * MiB;
constexpr size_t WS_SGA = 474 * MiB, WS_SGB = 602 * MiB;
constexpr size_t WS_WGU = 730 * MiB;
constexpr size_t WS_WD = 902 * MiB;
constexpr size_t WS_WGQ = 988 * MiB;
constexpr size_t WS_END = 1074 * MiB;
constexpr size_t WS_MIXED = WS_WIN;
constexpr size_t WS_X1B = WS_Q4;
constexpr size_t WS_HID = WS_Q4 + 128 * MiB;
static_assert(WS_WIN + (size_t)N_WIN * DM * 2 <= WS_WA && WS_HID + (size_t)M * D_FF * 2 <= WS_WGU && WS_WGU + (size_t)2 * D_FF * DM * 2 <= WS_WD && WS_WD + (size_t)DM * D_FF * 2 <= WS_WGQ && WS_WGQ + (size_t)2 * D_FF * DM <= WS_END, "d_ws map");
constexpr size_t DO_XB = 0, DO_OA = 128 * MiB, DO_OB = 192 * MiB;
constexpr size_t DO_XQ = 128 * MiB, DO_WINQ = 192 * MiB;
constexpr size_t DO_X1Q = 128 * MiB;
constexpr int CW_BAR = 4096;
constexpr int CW_RSQ2 = 16384, CW_RSQ3 = 32768;
constexpr int CW_NORM = 49152;
constexpr int CW_CMAX = 65536;
constexpr int CW_AMAX = 98304;
constexpr int CW_CMAXG = 114688;
static_assert(CW_CMAX + 2 * D_FF <= CW_AMAX && CW_AMAX + M <= CW_CMAXG && (CW_CMAXG + N_INQ) * 4 <= (int)CTL_ZERO_BYTES, "CTL words inside the memset region");

constexpr int RING_OFF = 0, RING_BYTES = 133120;
constexpr int MISC_OFF = 135168;
constexpr int LDS_BYTES = 147456;
static_assert(MISC_OFF + 128 <= LDS_BYTES && fox::LDS_BYTES <= RING_BYTES && swa::LDS_BYTES <= RING_BYTES && pg8::STAGE_BYTES <= RING_BYTES, "LDS map");

#define GAS __attribute__((address_space(1)))
#define LAS __attribute__((address_space(3)))
typedef unsigned short bf16;
typedef unsigned v4u __attribute__((ext_vector_type(4)));
typedef float f32x4 __attribute__((ext_vector_type(4)));
typedef GAS unsigned gu32;
#define RLX_AGENT __ATOMIC_RELAXED, __HIP_MEMORY_SCOPE_AGENT
#define LDS_WAIT() asm volatile("s_waitcnt lgkmcnt(0)" ::: "memory")
#define VM_WAIT() asm volatile("s_waitcnt vmcnt(0)" ::: "memory")

#define XB_TMO      128
#define XB_XCNT(j)  (256  + 64 * (j))
#define XB_XSUB(j)  (1280 + 64 * (j))
#define XB_XGEN(j)  (2304 + 64 * (j))
#define XB_TOP      3328
#define XB_TOPGEN   3392
#define XCD_BAR_WORDS 3456
#define XB_SPIN_CAP (1u << 18)

__device__ __forceinline__ unsigned xb_ld(unsigned* p)              { return __hip_atomic_load(p, __ATOMIC_RELAXED, __HIP_MEMORY_SCOPE_AGENT); }
__device__ __forceinline__ unsigned xb_add(unsigned* p, unsigned v) { return __hip_atomic_fetch_add(p, v, __ATOMIC_RELAXED, __HIP_MEMORY_SCOPE_AGENT); }
__device__ __forceinline__ unsigned xb_xcc_id() { return (unsigned)__builtin_amdgcn_s_getreg((3 << 11) | 20) & 0xFu; }
#define XB_SPIN(cond, bar) do { unsigned _sp = 0; while (cond) { __builtin_amdgcn_s_sleep(1); \
    if ((++_sp & 255u) == 0u) { if (xb_ld(&(bar)[XB_TMO])) break; if (_sp > XB_SPIN_CAP) { atomicAdd(&(bar)[XB_TMO], 1u); break; } } } } while (0)

struct XcdBarrier {
    unsigned* bar; unsigned x;
    volatile LAS unsigned* st;
};
__device__ __forceinline__ XcdBarrier xcd_barrier_post(unsigned* bar, volatile LAS unsigned* st) {
    XcdBarrier b; b.bar = bar; b.x = xb_xcc_id(); b.st = st;
    if (threadIdx.x == 0) (void)xb_add(&bar[XB_XCNT(b.x)], 1u);
    return b;
}
__device__ __forceinline__ void xcd_barrier_complete(unsigned* bar, unsigned x, unsigned& nloc, unsigned& nx) {
    const unsigned G = gridDim.x * gridDim.y * gridDim.z;
    unsigned sum, cnt, mine, sp = 0u;
    for (;;) {
        sum = 0u; cnt = 0u; mine = 0u;
#pragma unroll
        for (unsigned j = 0; j < 16; ++j) { const unsigned c = xb_ld(&bar[XB_XCNT(j)]); sum += c; cnt += (c > 0u) ? 1u : 0u; mine = (j == x) ? c : mine; }
        if (sum == G) break;
        __builtin_amdgcn_s_sleep(1);
        if ((++sp & 255u) == 0u) { if (xb_ld(&bar[XB_TMO])) break; if (sp > XB_SPIN_CAP) { atomicAdd(&bar[XB_TMO], 1u); break; } }
    }
    nloc = mine > 0u ? mine : 1u; nx = cnt > 0u ? cnt : 1u;
}
__device__ __forceinline__ void xcd_barrier(const XcdBarrier& b) {
    asm volatile("s_waitcnt vmcnt(0)" ::: "memory");
    __syncthreads();
    if (threadIdx.x == 0) {
        unsigned* bar = b.bar;
        __builtin_amdgcn_s_waitcnt(0);
        unsigned nloc = b.st[0], nx = b.st[1];
        if (nloc == 0u) { xcd_barrier_complete(bar, b.x, nloc, nx); b.st[0] = nloc; b.st[1] = nx; }
        const unsigned old = xb_add(&bar[XB_XSUB(b.x)], 1u);
        const unsigned gen = old / nloc;
        if (old + 1u == (gen + 1u) * nloc) {
            __builtin_amdgcn_fence(__ATOMIC_RELEASE, "agent");
            asm volatile("s_waitcnt vmcnt(0)" ::: "memory");
            const unsigned og = xb_add(&bar[XB_TOP], 1u);
            const unsigned tg = og / nx;
            if (og + 1u == (tg + 1u) * nx) xb_add(&bar[XB_TOPGEN], 1u);
            else XB_SPIN(xb_ld(&bar[XB_TOPGEN]) == tg, bar);
            __builtin_amdgcn_fence(__ATOMIC_ACQUIRE, "agent");
            xb_add(&bar[XB_XGEN(b.x)], 1u);
            asm volatile("s_waitcnt vmcnt(0)" ::: "memory");
        } else {
            XB_SPIN(xb_ld(&bar[XB_XGEN(b.x)]) == gen, bar);
            __builtin_amdgcn_fence(__ATOMIC_ACQUIRE, "agent");
            asm volatile("s_waitcnt vmcnt(0)" ::: "memory");
        }
    }
    __syncthreads();
}

__device__ __forceinline__ unsigned f2bf(float f) { unsigned u = __builtin_bit_cast(unsigned, f); return (u + 0x7fffu + ((u >> 16) & 1u)) >> 16; }
__device__ __forceinline__ unsigned pk2(float lo, float hi) { return f2bf(lo) | (f2bf(hi) << 16); }
__device__ __forceinline__ float wave_sum(float v) {
#pragma unroll
    for (int o = 1; o < 64; o <<= 1) v += __shfl_xor(v, o);
    return v;
}
__device__ __forceinline__ void p0_item(const float* W, int ldw, int srccol, int nvalid, const float* g, bf16* WT, int K, int dstrow, int k0, LAS float* scr, int lane, unsigned* cmax = nullptr, int wr0 = -1, int wc0 = 0) {
    const int rk = lane >> 4, c4 = (lane & 15) * 4;
    f32x4 v[16];
    if (wr0 >= 0) {
#pragma unroll
        for (int i = 0; i < 16; ++i) v[i] = *(const GAS f32x4*)(W + (size_t)(wr0 + i) * ldw + wc0 + 4 * lane);
    } else if (c4 < nvalid) {
#pragma unroll
        for (int i = 0; i < 16; ++i) v[i] = *(const GAS f32x4*)(W + (size_t)(k0 + 4 * i + rk) * ldw + srccol + c4);
    } else {
#pragma unroll
        for (int i = 0; i < 16; ++i) v[i] = (f32x4){0.f, 0.f, 0.f, 0.f};
    }
    if (g) {
#pragma unroll
        for (int i = 0; i < 16; ++i) v[i] = v[i] * g[k0 + 4 * i + rk];
    }
    if (cmax) {
        f32x4 mx = {0.f, 0.f, 0.f, 0.f};
#pragma unroll
        for (int i = 0; i < 16; ++i) { mx[0] = fmaxf(mx[0], fabsf(v[i][0])); mx[1] = fmaxf(mx[1], fabsf(v[i][1])); mx[2] = fmaxf(mx[2], fabsf(v[i][2])); mx[3] = fmaxf(mx[3], fabsf(v[i][3])); }
#pragma unroll
        for (int e = 0; e < 4; ++e) { mx[e] = fmaxf(mx[e], __shfl_xor(mx[e], 16)); mx[e] = fmaxf(mx[e], __shfl_xor(mx[e], 32)); }
        if (lane < 16) {
#pragma unroll
            for (int e = 0; e < 4; ++e) (void)__hip_atomic_fetch_max(cmax + dstrow + c4 + e, __builtin_bit_cast(unsigned, mx[e]), __ATOMIC_RELAXED, __HIP_MEMORY_SCOPE_AGENT); }
    }
#pragma unroll
    for (int i = 0; i < 16; ++i) { LAS float* s = scr + (4 * i + rk) * 65 + c4; s[0] = v[i][0]; s[1] = v[i][1]; s[2] = v[i][2]; s[3] = v[i][3]; }
    LDS_WAIT(); asm volatile("" ::: "memory");
    const int nl = lane & 7, kc = lane >> 3;
#pragma unroll
    for (int j = 0; j < 8; ++j) { const int n = nl + 8 * j; const LAS float* s = scr + (8 * kc) * 65 + n;
        v4u o; o.x = pk2(s[0 * 65], s[1 * 65]); o.y = pk2(s[2 * 65], s[3 * 65]); o.z = pk2(s[4 * 65], s[5 * 65]); o.w = pk2(s[6 * 65], s[7 * 65]);
#ifdef PROBE_NOWR
        if (wr0 != -2 || (o.x == 0x12345678u && j == 7))
#endif
        *(GAS v4u*)(WT + (size_t)(dstrow + n) * K + k0 + 8 * kc) = o; }
    LDS_WAIT(); asm volatile("" ::: "memory");
}

__device__ __forceinline__ unsigned q4(float a, float b, float c, float d, float sc) {
    const int ia = (int)fminf(fmaxf(__builtin_rintf(a * sc), -127.f), 127.f), ib = (int)fminf(fmaxf(__builtin_rintf(b * sc), -127.f), 127.f);
    const int ic = (int)fminf(fmaxf(__builtin_rintf(c * sc), -127.f), 127.f), id = (int)fminf(fmaxf(__builtin_rintf(d * sc), -127.f), 127.f);
    return (unsigned)(ia & 255) | ((unsigned)(ib & 255) << 8) | ((unsigned)(ic & 255) << 16) | ((unsigned)(id & 255) << 24);
}
__device__ __forceinline__ v4u q16(v4u p0, v4u p1, float sc) {
    v4u o; o.x = q4(pg8::bf_lo(p0.x), pg8::bf_hi(p0.x), pg8::bf_lo(p0.y), pg8::bf_hi(p0.y), sc); o.y = q4(pg8::bf_lo(p0.z), pg8::bf_hi(p0.z), pg8::bf_lo(p0.w), pg8::bf_hi(p0.w), sc);
    o.z = q4(pg8::bf_lo(p1.x), pg8::bf_hi(p1.x), pg8::bf_lo(p1.y), pg8::bf_hi(p1.y), sc); o.w = q4(pg8::bf_lo(p1.z), pg8::bf_hi(p1.z), pg8::bf_lo(p1.w), pg8::bf_hi(p1.w), sc); return o;
}
struct Args { const float* in[14]; float* out; unsigned char* ws; int ph_lo, ph_hi, li, pad; };

__global__ void __launch_bounds__(NWAVES * 64, 2) hybrid_fwd(Args args) {
    extern __shared__ __attribute__((aligned(16))) unsigned char lds[];
    LAS unsigned char* const L = (LAS unsigned char*)lds;
    volatile LAS unsigned* const MISC = (volatile LAS unsigned*)(L + MISC_OFF);
    const int tid = threadIdx.x, lane = tid & 63, wave = __builtin_amdgcn_readfirstlane(tid >> 6);
    const int G = gridDim.x; const int bx = blockIdx.x; const int vcu = (G % 8 == 0) ? (bx % 8) * (G / 8) + bx / 8 : bx;
    unsigned char* const ws = args.ws;
    gu32* const ctl = (gu32*)(ws + WS_CTL);
    for (int u = tid; u < (LDS_BYTES - MISC_OFF) / 4; u += NWAVES * 64) ((LAS unsigned*)(L + MISC_OFF))[u] = 0u;
    __syncthreads();
    XcdBarrier bar; bar.bar = (unsigned*)(ctl + CW_BAR); bar.x = 0; bar.st = nullptr;
    if (N_LAUNCHES != PER_PHASE) bar = xcd_barrier_post((unsigned*)(ctl + CW_BAR), MISC + 8);
#define GRID_BAR() do { if (N_LAUNCHES != PER_PHASE) xcd_barrier(bar); } while (0)
    const int lo = args.ph_lo, hi = args.ph_hi;
#ifndef PH_MASK
#define PH_MASK 0x7ff
#endif
#define IN(k) ((((PH_MASK) >> (k)) & 1) && lo <= (k) && (k) < hi)
#define BOTH(k) (IN(k) && IN((k) + 1))
    const int gw = vcu * NWAVES + wave, NGW = G * NWAVES;

    const float* x = args.in[0]; float* out = args.out;
#ifdef PROBE_DUP
    const bool dummy = args.pad != 0;
#else
    constexpr bool dummy = false;
#endif
    float* rstd1 = (float*)(ws + WS_RSTD1);
    float* rsq2 = (float*)(ws + WS_CTL) + CW_RSQ2; float* rsq3 = (float*)(ws + WS_CTL) + CW_RSQ3;
    bf16* WIN = (bf16*)(ws + WS_WIN); bf16* WA = (bf16*)(ws + WS_WA); bf16* WB = (bf16*)(ws + WS_WB); bf16* WO = (bf16*)(ws + WS_WO);
    bf16* WGU = (bf16*)(ws + WS_WGU); bf16* WD = (bf16*)(ws + WS_WD);
    bf16* Q4 = (bf16*)(ws + WS_Q4); bf16* KBt = (bf16*)(ws + WS_KB); bf16* VBt = (bf16*)(ws + WS_VB);
    float* LF = (float*)(ws + WS_LF); float* CC = (float*)(ws + WS_CC);
    bf16* SGA = (bf16*)(ws + WS_SGA); bf16* SGB = (bf16*)(ws + WS_SGB);
    bf16* MIXED = (bf16*)(ws + WS_MIXED); bf16* X1B = (bf16*)(ws + WS_X1B); bf16* HID = (bf16*)(ws + WS_HID);
    signed char* WGQ = (signed char*)(ws + WS_WGQ); signed char* XQ = (signed char*)out + DO_XQ; signed char* WINQ = (signed char*)out + DO_WINQ; float* SX = (float*)(ws + WS_SX); float* RSTD2 = (float*)(ws + WS_SX + 65536); signed char* X1Q = (signed char*)out + DO_X1Q; float* SA = (float*)(ws + WS_SA);
    bf16* XB = (bf16*)((unsigned char*)out + DO_XB); bf16* OA = (bf16*)((unsigned char*)out + DO_OA); bf16* OB = (bf16*)((unsigned char*)out + DO_OB);

    if (IN(0)) {
        LAS float* scr = (LAS float*)(L + RING_OFF + wave * 16640);
        const float* g1 = args.in[1]; const float* g2 = args.in[9];
        constexpr int I_IN = 64 * 96, I_FA = 64 * 4, I_GT = 64 * 168, I_A = 32 * 64, I_O = 64 * 64, I_G = 64 * 172, I_D = 172 * 64;
        constexpr int NITEMS = I_IN + I_FA + I_GT + 2 * I_A + I_O + 2 * I_G + I_D;
#ifdef PROBE_P0
#define PCM(x) (args.pad ? nullptr : (x))
#define PWT(x) (args.pad ? HID : (x))
#else
#define PCM(x) (x)
#define PWT(x) (x)
#endif
#ifdef PROBE_WIDE
#define WIDE_ARGS(NB, C0) , (args.pad ? 16 * (r / ((NB) / 4)) : -1), (C0) + 256 * (r % ((NB) / 4))
#elif defined(PROBE_NOWR)
#define WIDE_ARGS(NB, C0) , (args.pad ? -2 : -1), 0
#else
#define WIDE_ARGS(NB, C0)
#endif
        for (int it = gw; it < NITEMS; it += NGW) {
            int r = it;
            if (r < I_IN) { const int kb = r / 96, nb = r % 96, n0 = 64 * nb; p0_item(args.in[2], W_IN, n0, 64, g1, PWT(WIN), DM, n0, 64 * kb, scr, lane, nullptr WIDE_ARGS(96, 0)); continue; } r -= I_IN;
            if (r < I_FA) { const int kb = r / 4, nb = r % 4; p0_item(args.in[2], W_IN, 6144, nb == 0 ? 16 : 0, g1, PWT(WIN), DM, 6144 + 64 * nb, 64 * kb, scr, lane); continue; } r -= I_FA;
            if (r < I_GT) { const int kb = r / 168, nb = r % 168, n0 = 64 * nb;
                int d0 = n0; if (n0 >= 2560) { const int c = n0 - 2560, isb = c >= 4096, cc = c - 4096 * isb; d0 = 2560 + 256 * (cc >> 7) + 128 * isb + (cc & 127); }
                p0_item(args.in[2], W_IN, 6160 + n0, 64, g1, PWT(WIN), DM, N_IN + d0, 64 * kb, scr, lane, PCM((unsigned*)(ctl + CW_CMAXG) - N_IN) WIDE_ARGS(168, 6160)); continue; } r -= I_GT;
            if (r < I_A) { const int kb = r / 64, nb = r % 64; p0_item(args.in[6], DM, 64 * nb, 64, nullptr, PWT(WA), 2048, 64 * nb, 64 * kb, scr, lane, nullptr WIDE_ARGS(64, 0)); continue; } r -= I_A;
            if (r < I_A) { const int kb = r / 64, nb = r % 64; p0_item(args.in[7], DM, 64 * nb, 64, nullptr, PWT(WB), 2048, 64 * nb, 64 * kb, scr, lane, nullptr WIDE_ARGS(64, 0)); continue; } r -= I_A;
            if (r < I_O) { const int kb = r / 64, nb = r % 64; p0_item(args.in[8], DM, 64 * nb, 64, nullptr, PWT(WO), DM, 64 * nb, 64 * kb, scr, lane, nullptr WIDE_ARGS(64, 0)); continue; } r -= I_O;
            if (r < I_G) { const int kb = r / 172, nb = r % 172, n0 = 64 * nb; p0_item(args.in[10], D_FF, n0, 64, g2, PWT(WGU), DM, 256 * (n0 >> 7) + (n0 & 127), 64 * kb, scr, lane, PCM((unsigned*)(ctl + CW_CMAX)) WIDE_ARGS(172, 0)); continue; } r -= I_G;
            if (r < I_G) { const int kb = r / 172, nb = r % 172, n0 = 64 * nb; p0_item(args.in[11], D_FF, n0, 64, g2, PWT(WGU), DM, 256 * (n0 >> 7) + 128 + (n0 & 127), 64 * kb, scr, lane, PCM((unsigned*)(ctl + CW_CMAX)) WIDE_ARGS(172, 0)); continue; } r -= I_G;
            { const int kb = r / 64, nb = r % 64; p0_item(args.in[12], DM, 64 * nb, 64, nullptr, PWT(WD), D_FF, 64 * nb, 64 * kb, scr, lane, nullptr WIDE_ARGS(64, 0)); }
        }
        for (int m = gw; m < M; m += NGW) {
            const GAS f32x4* xr = (const GAS f32x4*)(x + (size_t)m * DM) + lane;
            f32x4 v[16]; float s = 0.f;
#pragma unroll
            for (int j = 0; j < 16; ++j) { v[j] = xr[64 * j]; s += (v[j].x * v[j].x + v[j].y * v[j].y) + (v[j].z * v[j].z + v[j].w * v[j].w); }
            s = wave_sum(s);
            float amx = 0.f;
#pragma unroll
            for (int j = 0; j < 16; ++j) amx = fmaxf(amx, fmaxf(fmaxf(fabsf(v[j].x), fabsf(v[j].y)), fmaxf(fabsf(v[j].z), fabsf(v[j].w))));
#pragma unroll
            for (int o = 1; o < 64; o <<= 1) amx = fmaxf(amx, __shfl_xor(amx, o));
            const float rs1 = 1.f / sqrtf(s * (1.f / DM) + EPS), qs = amx > 0.f ? 127.f / amx : 0.f;
            if (lane == 0) { rstd1[m] = rs1; SX[m] = rs1 * amx * (1.f / 127.f); }
            GAS unsigned* q4p = (GAS unsigned*)(XQ + (size_t)m * DM) + lane;
#pragma unroll
            for (int j = 0; j < 16; ++j) q4p[64 * j] = q4(v[j].x, v[j].y, v[j].z, v[j].w, qs);
            GAS unsigned long long* o8 = (GAS unsigned long long*)(XB + (size_t)m * DM) + lane;
#pragma unroll
            for (int j = 0; j < 16; ++j) o8[64 * j] = (unsigned long long)pk2(v[j].x, v[j].y) | ((unsigned long long)pk2(v[j].z, v[j].w) << 32);
        }
        if (BOTH(0)) GRID_BAR();
    }

    if (IN(1)) {
        {   const unsigned* cm = (const unsigned*)(ctl + CW_CMAXG);
            v4u p[8];
            if (gw < N_INQ) { const GAS v4u* src = (const GAS v4u*)(WIN + (size_t)(N_IN + gw) * DM) + 2 * lane;
#pragma unroll
                for (int j = 0; j < 4; ++j) { p[2 * j] = src[128 * j]; p[2 * j + 1] = src[128 * j + 1]; } }
            for (int n = gw; n < N_INQ; n += NGW) {
                v4u pn[8];
                if (n + NGW < N_INQ) { const GAS v4u* src = (const GAS v4u*)(WIN + (size_t)(N_IN + n + NGW) * DM) + 2 * lane;
#pragma unroll
                    for (int j = 0; j < 4; ++j) { pn[2 * j] = src[128 * j]; pn[2 * j + 1] = src[128 * j + 1]; } }
                const float mxv = __builtin_bit_cast(float, __hip_atomic_load(cm + n, RLX_AGENT)); const float sc = mxv > 0.f ? 127.f / mxv : 0.f;
                GAS v4u* dst = (GAS v4u*)(WINQ + (size_t)n * DM) + lane;
#pragma unroll
                for (int j = 0; j < 4; ++j) dst[64 * j] = q16(p[2 * j], p[2 * j + 1], sc);
#pragma unroll
                for (int j = 0; j < 8; ++j) p[j] = pn[j];
            }
        }
        if (BOTH(1)) GRID_BAR();
    }

    if (IN(2)) {
        { pg8::Gemm g{XB, WIN, M, N_IN, DM, nullptr, nullptr}; pg8::StaticOrder S; S.init(M, N_IN, G, bx);
          pg8::EpiInProj E{rstd1, Q4, LF, args.in[3], (unsigned*)(ctl + CW_NORM)};
          pg8::gemm_phase<pg8::EpiInProj, pg8::StaticOrder, PG_ALIGN, PG_SP2>(L + RING_OFF, g, S, E); }
        VM_WAIT(); __syncthreads();
        { pg8::Gemm g{(const bf16*)XQ, (const bf16*)WINQ, M, N_INQ, DM, nullptr, nullptr};
          pg8::TailOrder S; S.init(M, N_INQ, G, bx); S.nfull = (G == 256) ? 9 : (1 << 30); S.c0 = 64;
          typedef pg8::EpiGates8<WS_Q4 + (size_t)3 * M * 2048 * 2, WS_KB, WS_VB> EpiG;
          EpiG E{SX, (const unsigned*)(ctl + CW_CMAXG), ws, SGA, SGB};
          pg8::gemm_phase<EpiG, pg8::TailOrder, PG_ALIGN, PG_SP2>(L + RING_OFF, g, S, E); }
        if (BOTH(2)) GRID_BAR();
    }


    if (IN(4)) {
#ifndef NO_FOX
        {
            using namespace fox;
            constexpr int NX = 8, TOTAL = NX * BATCH * H_A;
            char* fl = (char*)lds + RING_OFF;
            const bf16* Qa = Q4; const bf16* Ka = Q4 + (size_t)M * 2048; const bf16* Va = Q4 + (size_t)2 * M * 2048;
            int Lc = vcu;
            if (Lc < TOTAL) {
                const int W = 1 << 20;
                constexpr float RS = 11.313708498984761f;
                float* wtot = (float*)(fl + 2 * SHM_V + 2 * SHM_K);
#define FOX_TABLE(slot_, L_) do { if ((L_) < TOTAL) { int tq_ = tid; asm volatile("" : "+v"(tq_));     \
                    const int bh_ = (L_) / NX, x_ = (L_) % NX, nk_ = (16 - x_) * QB, s0_ = 8 * tq_; float* tb_ = (float*)(fl + LDS_BIAS + (slot_) * 16384); \
                    float v_[8]; const float* lp_ = LF + ((size_t)(bh_ >> 4) * SEQ + s0_) * 16 + (bh_ & 15); \
                    _Pragma("unroll") for (int i_ = 0; i_ < 8; ++i_) v_[i_] = (s0_ < nk_) ? lp_[(size_t)i_ * 16] : 0.f; \
                    _Pragma("unroll") for (int i_ = 1; i_ < 8; ++i_) v_[i_] += v_[i_ - 1]; \
                    float incl_ = v_[7]; _Pragma("unroll") for (int o_ = 1; o_ < 64; o_ <<= 1) { const float t_ = __shfl_up(incl_, o_); if (lane >= o_) incl_ += t_; } \
                    if (lane == 63) wtot[wave] = incl_; __syncthreads(); \
                    float off_ = incl_ - v_[7]; for (int w_ = 0; w_ < wave; ++w_) off_ += wtot[w_]; \
                    if (s0_ < nk_) { _Pragma("unroll") for (int i_ = 0; i_ < 8; ++i_) tb_[s0_ + i_] = off_ + v_[i_]; } __syncthreads(); \
                    const float cref_ = tb_[x_ * QB]; __syncthreads(); \
                    if (s0_ < nk_) { _Pragma("unroll") for (int i_ = 0; i_ < 8; ++i_) tb_[s0_ + i_] = (cref_ - tb_[s0_ + i_]) * RS; } __syncthreads(); } } while (0)
#define FOX_NSUM(t_, bh_) (__builtin_bit_cast(float, __hip_atomic_load((unsigned*)(ctl + CW_NORM) + ((t_) * 64 + (bh_)) * 4 + 0, RLX_AGENT)) + __builtin_bit_cast(float, __hip_atomic_load((unsigned*)(ctl + CW_NORM) + ((t_) * 64 + (bh_)) * 4 + 1, RLX_AGENT)) + \
                           __builtin_bit_cast(float, __hip_atomic_load((unsigned*)(ctl + CW_NORM) + ((t_) * 64 + (bh_)) * 4 + 2, RLX_AGENT)) + __builtin_bit_cast(float, __hip_atomic_load((unsigned*)(ctl + CW_NORM) + ((t_) * 64 + (bh_)) * 4 + 3, RLX_AGENT)))
#define FOX_U2(bh_) (2.02f * SCALE * sqrtf(FOX_NSUM(0, bh_) * FOX_NSUM(1, bh_)))
#define FOX_JLO(slot_, qb_, u2_) ([&]() { const float* tb_ = (const float*)(fl + LDS_BIAS + (slot_) * 16384); const int p0_ = (qb_) * QB, nd_ = p0_ / KVBLK; const float bq_ = tb_[p0_]; bool keep_ = true; \
                if (lane < nd_) keep_ = ((tb_[KVBLK * lane + KVBLK - 1] - bq_) * (1.f / RS) + (u2_) > -104.f); return (int)__builtin_amdgcn_readfirstlane((int)__builtin_ctzll(__ballot(keep_))); }())
#define FOX_REF(bh_, qb_, slot_) BlockRef<bf16, bf16>{ Qa + ((size_t)((bh_) >> 4) * SEQ + (size_t)(qb_) * QB) * PITCH + ((bh_) & 15) * D, Ka + ((size_t)((bh_) >> 4) * SEQ) * PITCH + ((bh_) & 15) * D, \
                                               Va + ((size_t)((bh_) >> 4) * SEQ) * PITCH + ((bh_) & 15) * D, OA + ((size_t)((bh_) >> 4) * SEQ + (size_t)(qb_) * QB) * PITCH + ((bh_) & 15) * D, (qb_) * QB, \
                                               FOX_JLO(slot_, qb_, FOX_U2(bh_)), LDS_BIAS + (slot_) * 16384 }
                int bh = Lc / NX, xx = Lc % NX, pass = 0, slot = 0;
                FOX_TABLE(0, Lc); FOX_TABLE(1, Lc + G);
                BlockRef<bf16, bf16> cur = FOX_REF(bh, xx, 0);
                Seam<bf16> S;
                causal_swa_prime<bf16, bf16>(cur, W, fl, S);
                for (;;) {
                    const bool more_pass = pass == 0, more_item = Lc + G < TOTAL, last = !more_pass && !more_item;
                    int bhn = bh, xxn = xx, passn = pass + 1, Ln = Lc, slotn = slot;
                    if (!more_pass) { passn = 0; Ln = more_item ? Lc + G : Lc; bhn = Ln / NX; xxn = Ln % NX; slotn = slot ^ 1; }
                    const int qbn = passn ? 15 - xxn : xxn;
                    const BlockRef<bf16, bf16> nxt = last ? cur : FOX_REF(bhn, qbn, slotn);
                    causal_swa_block<bf16, bf16>(cur, nxt, SEQ, W, fl, S);
                    if (last) break;
                    if (passn == 0) FOX_TABLE(slot, Lc + 2 * G);
                    cur = nxt; bh = bhn; xx = xxn; pass = passn; Lc = Ln; slot = slotn;
                }
#undef FOX_REF
#undef FOX_TABLE
#undef FOX_NSUM
#undef FOX_JLO
#undef FOX_U2
            }
        }
#endif
        VM_WAIT(); __syncthreads();
#ifndef NO_SWA
        if (!dummy) {
            const swa::Tensors T{Q4 + (size_t)3 * M * 2048, KBt, VBt, OB, args.in[4], args.in[5]};
#ifdef PROBE_SWA_REP
#ifdef PROBE_SWA_MODE
            for (int u_ = vcu; u_ < BATCH * HKV_B * 32 * (PROBE_SWA_REP - 1); u_ += G) { const int u = u_ & 511; swa::swa_unit<PROBE_SWA_MODE>((char*)lds + RING_OFF, T, u >> 7, (u >> 5) & 3, u & 31); }
            for (int u = vcu; u < BATCH * HKV_B * 32; u += G) swa::swa_unit((char*)lds + RING_OFF, T, u >> 7, (u >> 5) & 3, u & 31);
#else
            for (int u_ = vcu; u_ < BATCH * HKV_B * 32 * PROBE_SWA_REP; u_ += G) { const int u = u_ & 511; swa::swa_unit((char*)lds + RING_OFF, T, u >> 7, (u >> 5) & 3, u & 31); }
#endif
#else
            for (int u = vcu; u < BATCH * HKV_B * 32; u += G) swa::swa_unit((char*)lds + RING_OFF, T, u >> 7, (u >> 5) & 3, u & 31);
#endif
        }
#endif
        if (BOTH(4)) GRID_BAR();
    }

    if (IN(5)) {
        pg8::Gemm g{OA, WA, M, DM, 2048, OB, WB}; pg8::SQ_DUAL S; S.init(M, DM, G, bx); pg8::EpiMix E{SGA, SGB, MIXED};
        pg8::gemm_phase<pg8::EpiMix, pg8::SQ_DUAL, PG_ALIGN, PG_SP2>(L + RING_OFF, g, S, E);
        if (BOTH(5)) GRID_BAR();
    }

    if (IN(6)) {
#if defined(PROBE_DUP) && defined(PROBE_P5_NULL)
        if (dummy) { pg8::Gemm g{MIXED, WO, M, DM, DM, nullptr, nullptr}; pg8::EpiNull E{HID};
#if defined(PROBE_P5_HOT)
            pg8::HotOrder S; S.init(M, DM, G, bx); pg8::gemm_phase<pg8::EpiNull, pg8::HotOrder, PG_ALIGN, PG_SP2>(L + RING_OFF, g, S, E);
#else
            pg8::StaticOrder S; S.init(M, DM, G, bx); pg8::gemm_phase<pg8::EpiNull, pg8::StaticOrder, PG_ALIGN, PG_SP2>(L + RING_OFF, g, S, E);
#endif
        } else {
#endif
        pg8::Gemm g{MIXED, WO, M, DM, DM, nullptr, nullptr}; pg8::SQ_ORDER S; S.init(M, DM, G, bx); pg8::EpiOutX1 E{XB, dummy ? HID : X1B};
        pg8::gemm_phase<pg8::EpiOutX1, pg8::SQ_ORDER, PG_ALIGN, PG_SP2>(L + RING_OFF, g, S, E);
#if defined(PROBE_DUP) && defined(PROBE_P5_NULL)
        }
#endif
        if (BOTH(6)) GRID_BAR();
    }

    if (IN(7)) {
#if defined(PROBE_DUP) && defined(PROBE_MFMA_CLOCK)
        if (dummy) {
            typedef short b8 __attribute__((ext_vector_type(8)));
            b8 a = {(short)(0x3f80 + lane), 0x3f80, 0x3f81, 0x3f82, 0x3f83, 0x3f84, 0x3f85, 0x3f86}, b = {0x3f80, (short)(0x3f80 + wave), 0x3f81, 0x3f82, 0x3f83, 0x3f84, 0x3f85, 0x3f86};
            f32x4 c[16];
#pragma unroll
            for (int i = 0; i < 16; ++i) c[i] = (f32x4){0.f, 0.f, 0.f, 0.f};
            for (int it = 0; it < PROBE_MFMA_CLOCK; ++it) {
#pragma unroll
                for (int i = 0; i < 16; ++i) c[i] = __builtin_amdgcn_mfma_f32_16x16x32_bf16(a, b, c[i], 0, 0, 0);
            }
            f32x4 s = c[0];
#pragma unroll
            for (int i = 1; i < 16; ++i) s = s + c[i];
            if (s[0] == 12345.678f) ((float*)HID)[tid] = s[1] + s[2] + s[3];
        } else
#endif
        {
            v4u p[8];
            if (gw < M) { const GAS v4u* src = (const GAS v4u*)(X1B + (size_t)gw * DM) + 2 * lane;
#pragma unroll
                for (int j = 0; j < 4; ++j) { p[2 * j] = src[128 * j]; p[2 * j + 1] = src[128 * j + 1]; } }
            for (int m = gw; m < M; m += NGW) {
                v4u pn[8];
                if (m + NGW < M) { const GAS v4u* src = (const GAS v4u*)(X1B + (size_t)(m + NGW) * DM) + 2 * lane;
#pragma unroll
                    for (int j = 0; j < 4; ++j) { pn[2 * j] = src[128 * j]; pn[2 * j + 1] = src[128 * j + 1]; } }
                float s = 0.f, amx = 0.f;
#pragma unroll
                for (int j = 0; j < 8; ++j) {
#pragma unroll
                    for (int e = 0; e < 4; ++e) { const float a = pg8::bf_lo(p[j][e]), b = pg8::bf_hi(p[j][e]); s += a * a + b * b; amx = fmaxf(amx, fmaxf(fabsf(a), fabsf(b))); } }
                s = wave_sum(s);
#pragma unroll
                for (int o = 1; o < 64; o <<= 1) amx = fmaxf(amx, __shfl_xor(amx, o));
                const float rs2 = 1.f / sqrtf(s * (1.f / DM) + EPS), sc = amx > 0.f ? 127.f / amx : 0.f;
                if (lane == 0) { RSTD2[m] = rs2; SA[m] = rs2 * amx * (1.f / 127.f); }
                GAS v4u* dst = (GAS v4u*)(X1Q + (size_t)m * DM) + lane;
#pragma unroll
                for (int j = 0; j < 4; ++j) dst[64 * j] = q16(p[2 * j], p[2 * j + 1], sc);
#pragma unroll
                for (int j = 0; j < 8; ++j) p[j] = pn[j];
            }
        }
        {
            const unsigned* cm = (const unsigned*)(ctl + CW_CMAX);
            constexpr int NQ = FFN_I8 ? FFN_I8_TILES * 256 : 0;
            v4u p[8];
            if (gw < NQ) { const GAS v4u* src = (const GAS v4u*)(WGU + (size_t)gw * DM) + 2 * lane;
#pragma unroll
                for (int j = 0; j < 4; ++j) { p[2 * j] = src[128 * j]; p[2 * j + 1] = src[128 * j + 1]; } }
            for (int n = gw; n < NQ; n += NGW) {
                v4u pn[8];
                if (n + NGW < NQ) { const GAS v4u* src = (const GAS v4u*)(WGU + (size_t)(n + NGW) * DM) + 2 * lane;
#pragma unroll
                    for (int j = 0; j < 4; ++j) { pn[2 * j] = src[128 * j]; pn[2 * j + 1] = src[128 * j + 1]; } }
                const float mxv = __builtin_bit_cast(float, __hip_atomic_load(cm + n, RLX_AGENT)); const float sc = mxv > 0.f ? 127.f / mxv : 0.f;
                GAS v4u* dst = (GAS v4u*)(WGQ + (size_t)n * DM) + lane;
#pragma unroll
                for (int j = 0; j < 4; ++j) dst[64 * j] = q16(p[2 * j], p[2 * j + 1], sc);
#pragma unroll
                for (int j = 0; j < 8; ++j) p[j] = pn[j];
            }
        }
        if (BOTH(7)) GRID_BAR();
    }

    if (IN(8)) {
#if FFN_I8
        {
            pg8::Gemm g8{(const bf16*)X1Q, (const bf16*)WGQ, M, FFN_I8_TILES * 256, DM, nullptr, nullptr}; pg8::StaticOrder S; S.init(M, FFN_I8_TILES * 256, G, bx);
#if defined(PROBE_DUP) && defined(PROBE_NULL8)
            if (dummy) { pg8::EpiNull8 E{HID}; pg8::gemm_phase<pg8::EpiNull8, pg8::StaticOrder, PG_ALIGN, PG_SP2>(L + RING_OFF, g8, S, E); } else
#endif
            { pg8::EpiSwiGLU8 E{SA, (const unsigned*)(ctl + CW_CMAX), HID};
            pg8::gemm_phase<pg8::EpiSwiGLU8, pg8::StaticOrder, PG_ALIGN, PG_SP2>(L + RING_OFF, g8, S, E); } }
        if (FFN_I8_TILES < 86 && !(PROBE8_SKIP_BF16 && dummy)) {
            VM_WAIT(); __syncthreads();
            pg8::Gemm g{X1B, WGU + (size_t)FFN_I8_TILES * 256 * DM, M, (86 - FFN_I8_TILES) * 256, DM, nullptr, nullptr}; pg8::StaticOrder S; S.init(M, (86 - FFN_I8_TILES) * 256, G, bx);
            pg8::EpiSwiGLU E{RSTD2, HID, FFN_I8_TILES};
            pg8::gemm_phase<pg8::EpiSwiGLU, pg8::StaticOrder, PG_ALIGN, PG_SP2>(L + RING_OFF, g, S, E); }
#else
        { pg8::Gemm g{X1B, WGU, M, 2 * D_FF, DM, nullptr, nullptr}; pg8::StaticOrder S; S.init(M, 2 * D_FF, G, bx); pg8::EpiSwiGLU E{RSTD2, HID, 0};
          pg8::gemm_phase<pg8::EpiSwiGLU, pg8::StaticOrder, PG_ALIGN, PG_SP2>(L + RING_OFF, g, S, E); }
#endif
        if (BOTH(8)) GRID_BAR();
    }

    if (IN(9)) {
#if defined(PROBE_DUP) && defined(PROBE_P8_HOT)
        if (dummy) { pg8::Gemm g{HID, WD, M, DM, D_FF, nullptr, nullptr}; pg8::HotOrder S; S.init(M, DM, G, bx); pg8::EpiDownX2 E{X1B, MIXED};
            pg8::gemm_phase<pg8::EpiDownX2, pg8::HotOrder, PG_ALIGN, PG_SP2>(L + RING_OFF, g, S, E); } else
#endif
        { pg8::Gemm g{HID, WD, M, DM, D_FF, nullptr, nullptr}; pg8::SQ_ORDER S; S.init(M, DM, G, bx); pg8::EpiDownX2 E{X1B, dummy ? MIXED : X1B};
        pg8::gemm_phase<pg8::EpiDownX2, pg8::SQ_ORDER, PG_ALIGN, PG_SP2>(L + RING_OFF, g, S, E); }
        if (BOTH(9)) GRID_BAR();
    }

    if (IN(10)) {
        const float* fg = args.in[13];
        for (int m = gw; m < M; m += 2 * NGW) {
            const GAS v4u* xr0 = (const GAS v4u*)(X1B + (size_t)m * DM) + lane; const GAS v4u* xr1 = xr0 + (size_t)NGW * (DM / 8);
            float* ob = dummy ? (float*)HID : out;
            GAS f32x4* or0 = (GAS f32x4*)(ob + (size_t)m * DM) + 2 * lane; GAS f32x4* or1 = or0 + (size_t)NGW * (DM / 4); const GAS f32x4* gr = (const GAS f32x4*)fg + 2 * lane;
            v4u p[8], q[8]; float s0 = 0.f, s1 = 0.f;
#pragma unroll
            for (int j = 0; j < 8; ++j) { p[j] = xr0[64 * j]; q[j] = xr1[64 * j]; }
#pragma unroll
            for (int j = 0; j < 8; ++j) {
#pragma unroll
                for (int e = 0; e < 4; ++e) { const float a = pg8::bf_lo(p[j][e]), b = pg8::bf_hi(p[j][e]), c = pg8::bf_lo(q[j][e]), d = pg8::bf_hi(q[j][e]); s0 += a * a + b * b; s1 += c * c + d * d; } }
            s0 = wave_sum(s0); s1 = wave_sum(s1);
            const float rs0 = 1.f / sqrtf(s0 * (1.f / DM) + EPS), rs1 = 1.f / sqrtf(s1 * (1.f / DM) + EPS);
#pragma unroll
            for (int j = 0; j < 8; ++j) { const f32x4 g0 = gr[128 * j], g1 = gr[128 * j + 1];
                const f32x4 a0 = {pg8::bf_lo(p[j].x), pg8::bf_hi(p[j].x), pg8::bf_lo(p[j].y), pg8::bf_hi(p[j].y)}, a1 = {pg8::bf_lo(p[j].z), pg8::bf_hi(p[j].z), pg8::bf_lo(p[j].w), pg8::bf_hi(p[j].w)};
                const f32x4 b0 = {pg8::bf_lo(q[j].x), pg8::bf_hi(q[j].x), pg8::bf_lo(q[j].y), pg8::bf_hi(q[j].y)}, b1 = {pg8::bf_lo(q[j].z), pg8::bf_hi(q[j].z), pg8::bf_lo(q[j].w), pg8::bf_hi(q[j].w)};
                or0[128 * j] = a0 * rs0 * g0; or0[128 * j + 1] = a1 * rs0 * g1; or1[128 * j] = b0 * rs1 * g0; or1[128 * j + 1] = b1 * rs1 * g1; }
        }
    }
#undef IN
#undef BOTH
#undef GRID_BAR
}

extern "C" void kernel_launch(void* const* d_in, const int* in_sizes, int n_in, void* d_out, int out_size, void* d_ws, size_t ws_size, hipStream_t stream) {
    static int grid = 0;
    if (grid == 0) {
        if (n_in != 14 || in_sizes[0] != M * DM || out_size != M * DM || ws_size < WS_END) {
            fprintf(stderr, "kernel_launch: built for 14 inputs, x/out of %d floats, >= %zu bytes of workspace; got n_in %d, in0 %d, out %d, ws %zu; nothing launched\n", M * DM, (size_t)WS_END, n_in, n_in > 0 ? in_sizes[0] : -1, out_size, ws_size);
            grid = -1; return; }
        int dev = 0, cus = 0, per_cu = 0;
        if (hipGetDevice(&dev) != hipSuccess || hipDeviceGetAttribute(&cus, hipDeviceAttributeMultiprocessorCount, dev) != hipSuccess) { fprintf(stderr, "kernel_launch: device query failed\n"); grid = -1; return; }
        if (hipFuncSetAttribute((const void*)hybrid_fwd, hipFuncAttributeMaxDynamicSharedMemorySize, LDS_BYTES) != hipSuccess) { fprintf(stderr, "kernel_launch: hipFuncSetAttribute failed\n"); grid = -1; return; }
        if (hipOccupancyMaxActiveBlocksPerMultiprocessor(&per_cu, (const void*)hybrid_fwd, NWAVES * 64, LDS_BYTES) != hipSuccess || per_cu < 1)
            fprintf(stderr, "kernel_launch: note: occupancy query reports %d workgroups per CU\n", per_cu);
        (void)hipGetLastError();
        grid = cus;
    }
    if (grid < 0) return;
    if (hipMemsetAsync((char*)d_ws + WS_CTL, 0, CTL_ZERO_BYTES, stream) != hipSuccess) { fprintf(stderr, "kernel_launch: hipMemsetAsync failed\n"); return; }
    Args a{};
    for (int i = 0; i < 14; ++i) a.in[i] = (const float*)d_in[i];
    a.out = (float*)d_out; a.ws = (unsigned char*)d_ws;
    for (int li = 0; li < N_LAUNCHES; ++li) {
        a.ph_lo = (N_LAUNCHES == PER_PHASE) ? li : 0; a.ph_hi = (N_LAUNCHES == PER_PHASE) ? li + 1 : PER_PHASE; a.li = li; a.pad = 0;
#ifdef PROBE_DUP
        if (N_LAUNCHES == PER_PHASE && ((PROBE_DUP >> li) & 1)) { a.pad = 1; hipLaunchKernelGGL(hybrid_fwd, dim3(grid), dim3(NWAVES * 64), LDS_BYTES, stream, a); a.pad = 0; }
#endif
        hipLaunchKernelGGL(hybrid_fwd, dim3(grid), dim3(NWAVES * 64), LDS_BYTES, stream, a);
        const hipError_t le = hipPeekAtLastError();
        if (le != hipSuccess) { fprintf(stderr, "kernel_launch: launch %d failed: %s\n", li, hipGetErrorName(le)); break; }
    }
}
```

```cpp
#include <hip/hip_runtime.h>
#include <cstdio>
#include <cstdint>

namespace pg8 {
#define PG8_LAS __attribute__((address_space(3)))
typedef unsigned short bf16_t;
typedef short bf16x8 __attribute__((ext_vector_type(8)));
typedef float f32x4 __attribute__((ext_vector_type(4)));
typedef unsigned u32x4 __attribute__((ext_vector_type(4)));
typedef int i32x4 __attribute__((ext_vector_type(4)));
constexpr int BM = 256, BK = 64, HALF = 128, HTB = HALF * BK * 2  , STAGE_BYTES = 8 * HTB, NXCD = 8, WGM = 8;

__host__ __device__ __forceinline__ int lds_byte(int r, int c) { const int st = (r >> 4) * 2 + (c >> 5), rr = r & 15, cc = c & 31, ob = rr * 64 + cc * 2; return st * 1024 + (ob ^ (((ob >> 9) & 1) << 5)); }
__host__ __device__ __forceinline__ void stage_rc(int b, int& R, int& C) { const int st = b / 1024, sb = b % 1024, swz = sb ^ (((sb >> 9) & 1) << 5); R = (st >> 1) * 16 + swz / 64; C = (st & 1) * 32 + (swz % 64) / 2; }
__host__ __device__ __forceinline__ int perm32(int rho) { const int n = rho >> 4, i = rho & 15; return 8 * (i >> 2) + 4 * n + (i & 3); }

struct Unit { int pm, pn, src; };
struct Gemm { const bf16_t* A; const bf16_t* Bt; int M, N, K; const bf16_t* A2; const bf16_t* Bt2; };

struct StaticOrder {
    int nM, nN, nwg, G, c;
    __host__ __device__ void init(int M, int N, int G_, int c_) { nM = M / BM; nN = N / BM; nwg = nM * nN; G = G_; c = c_; }
    __host__ __device__ bool next(int i, Unit& u) const {
        const long L = (long)i * G + c; if (L >= nwg) return false;
        int wgid = (int)L; { const int q = nwg / NXCD, r = nwg % NXCD, xcd = wgid % NXCD, off = wgid / NXCD; wgid = (xcd < r ? xcd * (q + 1) : r * (q + 1) + (xcd - r) * q) + off; }
        const int nig = WGM * nN, gid = wgid / nig, fm = gid * WGM, gsz = (nM - fm) < WGM ? (nM - fm) : WGM;
        u.pm = fm + ((wgid % nig) % gsz); u.pn = (wgid % nig) / gsz; u.src = 0; return true;
    }
    __device__ __forceinline__ void a_ready(const Unit&) const {}
    __device__ __forceinline__ void done(const Unit&) const {}
};
struct TailOrder : StaticOrder {
    int nfull, c0;
    __host__ __device__ bool next(int i, Unit& u) const {
        long L;
        if (i < nfull) L = (long)i * G + c; else { if (c < c0) return false; L = (long)nfull * G + (long)(i - nfull) * (G - c0) + (c - c0); }
        if (L >= nwg) return false;
        int wgid = (int)L; { const int q = nwg / NXCD, r = nwg % NXCD, xcd = wgid % NXCD, off = wgid / NXCD; wgid = (xcd < r ? xcd * (q + 1) : r * (q + 1) + (xcd - r) * q) + off; }
        const int nig = WGM * nN, gid = wgid / nig, fm = gid * WGM, gsz = (nM - fm) < WGM ? (nM - fm) : WGM;
        u.pm = fm + ((wgid % nig) % gsz); u.pn = (wgid % nig) / gsz; u.src = 0; return true;
    }
};
struct SquareOrder : StaticOrder {
    __host__ __device__ bool next(int i, Unit& u) const {
        if (G != 256 || nM != 64 || nN != 16) return StaticOrder::next(i, u);
        if (i >= 4) return false;
        const int k = c & 7, s = c >> 3; u.pm = 16 * i + 8 * (k & 1) + (s & 7); u.pn = 4 * (k >> 1) + (s >> 3); u.src = 0; return true;
    }
};
#ifndef SQ_ORDER
#define SQ_ORDER SquareOrder
#define SQ_DUAL DualSquare
#endif
struct DualSquare : SquareOrder {
    __host__ __device__ bool next(int i, Unit& u) const { const bool ok = SquareOrder::next(i >> 1, u); u.src = i & 1; return ok; }
};
struct DualOrder : StaticOrder {
    __host__ __device__ bool next(int i, Unit& u) const { const bool ok = StaticOrder::next(i >> 1, u); u.src = i & 1; return ok; }
};

struct HotOrder : StaticOrder {
    __host__ __device__ bool next(int i, Unit& u) const { const bool ok = StaticOrder::next(i, u); u.pm = c & 7; u.pn = 0; return ok; }
};
__device__ __forceinline__ f32x4 mma16(bf16x8 a, bf16x8 b, f32x4 c) { return __builtin_amdgcn_mfma_f32_16x16x32_bf16(a, b, c, 0, 0, 0); }
__device__ __forceinline__ i32x4 mma16(bf16x8 a, bf16x8 b, i32x4 c) { return __builtin_amdgcn_mfma_i32_16x16x64_i8(__builtin_bit_cast(i32x4, a), __builtin_bit_cast(i32x4, b), c, 0, 0, 0); }
typedef float f32x2_t __attribute__((ext_vector_type(2)));
typedef __bf16 bf16x2_t __attribute__((ext_vector_type(2)));
__device__ __forceinline__ unsigned cvt_pk_bf16(float lo, float hi) { const f32x2_t v = {lo, hi}; const bf16x2_t b = __builtin_convertvector(v, bf16x2_t); return __builtin_bit_cast(unsigned, b); }
__device__ __forceinline__ float bf_lo(unsigned w) { return __builtin_bit_cast(float, w << 16); }
__device__ __forceinline__ float bf_hi(unsigned w) { return __builtin_bit_cast(float, w & 0xffff0000u); }
__device__ __forceinline__ float sigmoid_f(float x) { return __builtin_amdgcn_rcpf(1.f + __builtin_amdgcn_exp2f(-1.4426950408889634f * x)); }
__device__ __forceinline__ u32x4 pack8(f32x4 v0, f32x4 v1) { u32x4 w; w.x = cvt_pk_bf16(v0[0], v0[1]); w.y = cvt_pk_bf16(v0[2], v0[3]); w.z = cvt_pk_bf16(v1[0], v1[1]); w.w = cvt_pk_bf16(v1[2], v1[3]); return w; }

constexpr int IN_TILES = 25;
constexpr int INQ_TILES = 42;
struct EpiInProj {
    static constexpr bool PERM = true, AFTER_DRAIN = false, DUAL = false, I8 = false; typedef f32x4 acc_t;
    const float* rstd; bf16_t* q4;   float* lf; const float* bfor; unsigned* nrm;
    __device__ __forceinline__ void operator()(const f32x4 (&acc)[2][2][4][2], const Unit& u, int wr, int wc, int fr, int fq) const {
        const int row0 = u.pm * BM + wr * 64 + fr; const int pn = u.pn;
        float rs[2][4];
        if (pn == 24) {
            if (wc == 0 && fq < 2) {
#pragma unroll
                for (int ai = 0; ai < 2; ++ai)
#pragma unroll
                    for (int m = 0; m < 4; ++m) rs[ai][m] = rstd[row0 + ai * HALF + m * 16];
                const f32x4 b0 = *(const f32x4*)(bfor + 8 * fq), b1 = *(const f32x4*)(bfor + 8 * fq + 4);
#pragma unroll
                for (int ai = 0; ai < 2; ++ai)
#pragma unroll
                    for (int m = 0; m < 4; ++m) { const int row = row0 + ai * HALF + m * 16;
#pragma unroll
                        for (int n = 0; n < 2; ++n) { const f32x4 v = acc[ai][0][m][n] * rs[ai][m]; const f32x4 b = n ? b1 : b0; f32x4 o;
#pragma unroll
                            for (int j = 0; j < 4; ++j) { const float z = v[j] + b[j]; o[j] = fminf(z, 0.f) - log1pf(expf(-fabsf(z))); }
                            *(f32x4*)(lf + (size_t)row * 16 + 8 * fq + 4 * n) = o; } }
            }
            return;
        }
#pragma unroll
        for (int ai = 0; ai < 2; ++ai)
#pragma unroll
            for (int m = 0; m < 4; ++m) rs[ai][m] = rstd[row0 + ai * HALF + m * 16];
        bf16_t* base = q4 + (size_t)(pn >> 3) * ((size_t)16384 * 2048);
        const int col0 = (pn & 7) * BM + wc * 32 + 8 * fq;
        float mxh[2] = {0.f, 0.f};
#pragma unroll
        for (int ai = 0; ai < 2; ++ai)
#pragma unroll
            for (int m = 0; m < 4; ++m) { const int row = row0 + ai * HALF + m * 16; const float r = rs[ai][m]; bf16_t* rowp = base + (size_t)row * 2048 + col0;
#pragma unroll
                for (int bj = 0; bj < 2; ++bj) { const f32x4 v0 = acc[ai][bj][m][0] * r, v1 = acc[ai][bj][m][1] * r; *(u32x4*)(rowp + bj * HALF) = pack8(v0, v1);
                    if (pn < 16) { float ss = (v0[0] * v0[0] + v0[1] * v0[1]) + (v0[2] * v0[2] + v0[3] * v0[3]) + (v1[0] * v1[0] + v1[1] * v1[1]) + (v1[2] * v1[2] + v1[3] * v1[3]);
                        ss += __shfl_xor(ss, 16); ss += __shfl_xor(ss, 32); mxh[bj] = fmaxf(mxh[bj], ss); } } }
        if (pn < 16) {
#pragma unroll
            for (int bj = 0; bj < 2; ++bj) { float v = mxh[bj]; v = fmaxf(v, __shfl_xor(v, 1)); v = fmaxf(v, __shfl_xor(v, 2)); v = fmaxf(v, __shfl_xor(v, 4)); v = fmaxf(v, __shfl_xor(v, 8));
                if (fr == 0 && fq == 0) (void)__hip_atomic_fetch_max(nrm + (((pn >> 3) * 64 + (u.pm >> 4) * 16 + 2 * (pn & 7) + bj) * 4 + wc), __builtin_bit_cast(unsigned, v), __ATOMIC_RELAXED, __HIP_MEMORY_SCOPE_AGENT); }
        }
    }
};
template <size_t OQB, size_t OKB, size_t OVB>
struct EpiGates8 {
    static constexpr bool PERM = true, AFTER_DRAIN = false, DUAL = false, I8 = true; typedef i32x4 acc_t;
    const float* sx; const unsigned* cmax; unsigned char* wsb; bf16_t* gr; bf16_t* gs;
    __device__ __forceinline__ void operator()(const i32x4 (&acc)[2][2][4][2], const Unit& u, int wr, int wc, int fr, int fq) const {
        const int row0 = u.pm * BM + wr * 64 + fr, cl = wc * 32 + 8 * fq; const int pn = u.pn;
        float rs[2][4];
#pragma unroll
        for (int ai = 0; ai < 2; ++ai)
#pragma unroll
            for (int m = 0; m < 4; ++m) rs[ai][m] = sx[row0 + ai * HALF + m * 16];
        f32x4 sc[2][2];
#pragma unroll
        for (int bj = 0; bj < 2; ++bj) { const f32x4* c = (const f32x4*)(cmax + pn * BM + bj * HALF + cl); sc[bj][0] = c[0] * (1.f / 127.f); sc[bj][1] = c[1] * (1.f / 127.f); }
        if (pn >= 10) {
            const int col0 = (pn - 10) * HALF + cl; const float T = 9.094947017729282e-13f;
#pragma unroll
            for (int ai = 0; ai < 2; ++ai)
#pragma unroll
                for (int m = 0; m < 4; ++m) { const size_t off = (size_t)(row0 + ai * HALF + m * 16) * 4096 + col0; const float r = rs[ai][m]; f32x4 r0, r1, s0, s1;
#pragma unroll
                    for (int j = 0; j < 4; ++j) {
                        const float a0 = sigmoid_f((float)acc[ai][0][m][0][j] * (r * sc[0][0][j])), a1 = sigmoid_f((float)acc[ai][0][m][1][j] * (r * sc[0][1][j]));
                        s0[j] = fmaxf(sigmoid_f((float)acc[ai][1][m][0][j] * (r * sc[1][0][j])), T); s1[j] = fmaxf(sigmoid_f((float)acc[ai][1][m][1][j] * (r * sc[1][1][j])), T);
                        r0[j] = a0 * __builtin_amdgcn_rcpf(s0[j]); r1[j] = a1 * __builtin_amdgcn_rcpf(s1[j]); }
                    *(u32x4*)(gr + off) = pack8(r0, r1); *(u32x4*)(gs + off) = pack8(s0, s1);
                    __builtin_amdgcn_sched_barrier(0); }
            return;
        }
        size_t boff = OQB; int ldc = 2048, colt = pn * BM;
        if (pn == 8) boff = OKB; if (pn == 9) boff = OVB; if (pn >= 8) { ldc = 256; colt = 0; }
        bf16_t* base = (bf16_t*)(wsb + boff);
        const int col0 = colt + cl;
#pragma unroll
        for (int ai = 0; ai < 2; ++ai)
#pragma unroll
            for (int m = 0; m < 4; ++m) { const int row = row0 + ai * HALF + m * 16; const float r = rs[ai][m]; bf16_t* rowp = base + (size_t)row * ldc + col0;
#pragma unroll
                for (int bj = 0; bj < 2; ++bj) { f32x4 v0, v1;
#pragma unroll
                    for (int j = 0; j < 4; ++j) { v0[j] = (float)acc[ai][bj][m][0][j] * (r * sc[bj][0][j]); v1[j] = (float)acc[ai][bj][m][1][j] * (r * sc[bj][1][j]); }
                    *(u32x4*)(rowp + bj * HALF) = pack8(v0, v1); } }
    }
};
struct EpiMix {
    static constexpr bool PERM = true, AFTER_DRAIN = false, DUAL = true, I8 = false; typedef f32x4 acc_t;
    const bf16_t* gr; const bf16_t* gs; bf16_t* mixed;
    template <bool FINAL> __device__ __forceinline__ void run(f32x4 (&acc)[2][2][4][2], const Unit& u, int wr, int wc, int fr, int fq) const {
        const int row0 = u.pm * BM + wr * 64 + fr, col0 = u.pn * BM + wc * 32 + 8 * fq; const bf16_t* g = FINAL ? gs : gr;
        u32x4 b[2], bn[2];
        { const size_t off = (size_t)row0 * 4096 + col0; b[0] = *(const u32x4*)(g + off); b[1] = *(const u32x4*)(g + off + HALF); }
#pragma unroll
        for (int it = 0; it < 8; ++it) { const int ai = it >> 2, m = it & 3; const size_t off = (size_t)(row0 + ai * HALF + m * 16) * 4096 + col0;
            if (it + 1 < 8) { const size_t offn = (size_t)(row0 + ((it + 1) >> 2) * HALF + ((it + 1) & 3) * 16) * 4096 + col0; bn[0] = *(const u32x4*)(g + offn); bn[1] = *(const u32x4*)(g + offn + HALF); }
#pragma unroll
            for (int bj = 0; bj < 2; ++bj) { const u32x4 y = b[bj]; f32x4 v0 = acc[ai][bj][m][0], v1 = acc[ai][bj][m][1];
                v0[0] *= bf_lo(y.x); v0[1] *= bf_hi(y.x); v0[2] *= bf_lo(y.y); v0[3] *= bf_hi(y.y); v1[0] *= bf_lo(y.z); v1[1] *= bf_hi(y.z); v1[2] *= bf_lo(y.w); v1[3] *= bf_hi(y.w);
                if (FINAL) *(u32x4*)(mixed + off + bj * HALF) = pack8(v0, v1); else { acc[ai][bj][m][0] = v0; acc[ai][bj][m][1] = v1; } }
            b[0] = bn[0]; b[1] = bn[1]; }
    }
    __device__ __forceinline__ void mid(f32x4 (&acc)[2][2][4][2], const Unit& u, int wr, int wc, int fr, int fq) const { run<false>(acc, u, wr, wc, fr, fq); }
    __device__ __forceinline__ void operator()(f32x4 (&acc)[2][2][4][2], const Unit& u, int wr, int wc, int fr, int fq) const { run<true>(acc, u, wr, wc, fr, fq); }
};
struct EpiOutX1 {
    static constexpr bool PERM = true, AFTER_DRAIN = false, DUAL = false, I8 = false; typedef f32x4 acc_t;
    const bf16_t* res; bf16_t* cp;
    __device__ __forceinline__ void operator()(const f32x4 (&acc)[2][2][4][2], const Unit& u, int wr, int wc, int fr, int fq) const {
        const int row0 = u.pm * BM + wr * 64 + fr, col0 = u.pn * BM + wc * 32 + 8 * fq;
        u32x4 p[2], pn[2];
        { const size_t off = (size_t)row0 * 4096 + col0; p[0] = *(const u32x4*)(res + off); p[1] = *(const u32x4*)(res + off + HALF); }
#pragma unroll
        for (int it = 0; it < 8; ++it) { const int ai = it >> 2, m = it & 3; const size_t off = (size_t)(row0 + ai * HALF + m * 16) * 4096 + col0;
            if (it + 1 < 8) { const size_t offn = (size_t)(row0 + ((it + 1) >> 2) * HALF + ((it + 1) & 3) * 16) * 4096 + col0; pn[0] = *(const u32x4*)(res + offn); pn[1] = *(const u32x4*)(res + offn + HALF); }
#pragma unroll
            for (int bj = 0; bj < 2; ++bj) { const u32x4 q = p[bj]; f32x4 v0 = acc[ai][bj][m][0], v1 = acc[ai][bj][m][1];
                v0[0] += bf_lo(q.x); v0[1] += bf_hi(q.x); v0[2] += bf_lo(q.y); v0[3] += bf_hi(q.y); v1[0] += bf_lo(q.z); v1[1] += bf_hi(q.z); v1[2] += bf_lo(q.w); v1[3] += bf_hi(q.w);
                *(u32x4*)(cp + off + bj * HALF) = pack8(v0, v1); }
            p[0] = pn[0]; p[1] = pn[1]; }
    }
};
struct EpiDownX2 {
    static constexpr bool PERM = true, AFTER_DRAIN = false, DUAL = false, I8 = false; typedef f32x4 acc_t;
    const bf16_t* xb; bf16_t* xo;
    __device__ __forceinline__ void operator()(const f32x4 (&acc)[2][2][4][2], const Unit& u, int wr, int wc, int fr, int fq) const {
        const int row0 = u.pm * BM + wr * 64 + fr, col0 = u.pn * BM + wc * 32 + 8 * fq;
        u32x4 p[2], pn[2];
        { const size_t off = (size_t)row0 * 4096 + col0; p[0] = *(const u32x4*)(xb + off); p[1] = *(const u32x4*)(xb + off + HALF); }
#pragma unroll
        for (int it = 0; it < 8; ++it) { const int ai = it >> 2, m = it & 3; const size_t off = (size_t)(row0 + ai * HALF + m * 16) * 4096 + col0;
            if (it + 1 < 8) { const size_t offn = (size_t)(row0 + ((it + 1) >> 2) * HALF + ((it + 1) & 3) * 16) * 4096 + col0; pn[0] = *(const u32x4*)(xb + offn); pn[1] = *(const u32x4*)(xb + offn + HALF); }
#pragma unroll
            for (int bj = 0; bj < 2; ++bj) { const u32x4 q = p[bj]; f32x4 v0 = acc[ai][bj][m][0], v1 = acc[ai][bj][m][1];
                v0[0] += bf_lo(q.x); v0[1] += bf_hi(q.x); v0[2] += bf_lo(q.y); v0[3] += bf_hi(q.y); v1[0] += bf_lo(q.z); v1[1] += bf_hi(q.z); v1[2] += bf_lo(q.w); v1[3] += bf_hi(q.w);
                *(u32x4*)(xo + off + bj * HALF) = pack8(v0, v1); }
            p[0] = pn[0]; p[1] = pn[1]; }
    }
};
struct EpiSwiGLU {
    static constexpr bool PERM = true, AFTER_DRAIN = false, DUAL = false, I8 = false; typedef f32x4 acc_t;
    const float* rstd; bf16_t* hid; int pn0;
    __device__ __forceinline__ void operator()(const f32x4 (&acc)[2][2][4][2], const Unit& u, int wr, int wc, int fr, int fq) const {
        const int row0 = u.pm * BM + wr * 64 + fr, col0 = (u.pn + pn0) * HALF + wc * 32 + 8 * fq;
        float rs[2][4];
#pragma unroll
        for (int ai = 0; ai < 2; ++ai)
#pragma unroll
            for (int m = 0; m < 4; ++m) rs[ai][m] = rstd[row0 + ai * HALF + m * 16];
#pragma unroll
        for (int ai = 0; ai < 2; ++ai)
#pragma unroll
            for (int m = 0; m < 4; ++m) { const int row = row0 + ai * HALF + m * 16; const float r = rs[ai][m];
                f32x4 h0, h1;
#pragma unroll
                for (int j = 0; j < 4; ++j) { const float g0 = acc[ai][0][m][0][j] * r, g1 = acc[ai][0][m][1][j] * r;
                    h0[j] = g0 * sigmoid_f(g0) * (acc[ai][1][m][0][j] * r); h1[j] = g1 * sigmoid_f(g1) * (acc[ai][1][m][1][j] * r); }
                *(u32x4*)(hid + (size_t)row * 11008 + col0) = pack8(h0, h1); }
    }
};

struct EpiSwiGLU8 {
    static constexpr bool PERM = true, AFTER_DRAIN = false, DUAL = false, I8 = true; typedef i32x4 acc_t;
    const float* sa; const unsigned* cmax; bf16_t* hid;
    __device__ __forceinline__ void operator()(const i32x4 (&acc)[2][2][4][2], const Unit& u, int wr, int wc, int fr, int fq) const {
        const int row0 = u.pm * BM + wr * 64 + fr, cl = wc * 32 + 8 * fq, col0 = u.pn * HALF + cl;
        float rs[2][4];
#pragma unroll
        for (int ai = 0; ai < 2; ++ai)
#pragma unroll
            for (int m = 0; m < 4; ++m) rs[ai][m] = sa[row0 + ai * HALF + m * 16];
        const f32x4* cg = (const f32x4*)(cmax + u.pn * BM + cl); const f32x4* cu = (const f32x4*)(cmax + u.pn * BM + HALF + cl);
        const f32x4 sg0 = cg[0] * (1.f / 127.f), sg1 = cg[1] * (1.f / 127.f), su0 = cu[0] * (1.f / 127.f), su1 = cu[1] * (1.f / 127.f);
#pragma unroll
        for (int ai = 0; ai < 2; ++ai)
#pragma unroll
            for (int m = 0; m < 4; ++m) { const int row = row0 + ai * HALF + m * 16; const float r = rs[ai][m];
                f32x4 h0, h1;
#pragma unroll
                for (int j = 0; j < 4; ++j) { const float g0 = (float)acc[ai][0][m][0][j] * (r * sg0[j]), g1 = (float)acc[ai][0][m][1][j] * (r * sg1[j]);
                    h0[j] = g0 * sigmoid_f(g0) * ((float)acc[ai][1][m][0][j] * (r * su0[j])); h1[j] = g1 * sigmoid_f(g1) * ((float)acc[ai][1][m][1][j] * (r * su1[j])); }
                *(u32x4*)(hid + (size_t)row * 11008 + col0) = pack8(h0, h1); }
    }
};

struct EpiNull8 {
    static constexpr bool PERM = true, AFTER_DRAIN = false, DUAL = false, I8 = true; typedef i32x4 acc_t;
    bf16_t* sink;
    __device__ __forceinline__ void operator()(const i32x4 (&acc)[2][2][4][2], const Unit& u, int wr, int wc, int fr, int fq) const {
        if (sink == nullptr) {
#pragma unroll
            for (int ai = 0; ai < 2; ++ai)
#pragma unroll
                for (int m = 0; m < 4; ++m)
#pragma unroll
                    for (int bj = 0; bj < 2; ++bj) *(i32x4*)((int*)nullptr + (size_t)(ai * 4 + m) * 4096 + bj * HALF + fr * 8 + fq * 1024 + u.pm) = acc[ai][bj][m][0] + acc[ai][bj][m][1]; }
    }
};

struct EpiNull {
    static constexpr bool PERM = true, AFTER_DRAIN = false, DUAL = false, I8 = false; typedef f32x4 acc_t;
    bf16_t* sink;
    __device__ __forceinline__ void operator()(const f32x4 (&acc)[2][2][4][2], const Unit& u, int wr, int wc, int fr, int fq) const {
        if (sink == nullptr) {
#pragma unroll
            for (int ai = 0; ai < 2; ++ai)
#pragma unroll
                for (int m = 0; m < 4; ++m)
#pragma unroll
                    for (int bj = 0; bj < 2; ++bj) *(u32x4*)((bf16_t*)nullptr + (size_t)(ai * 4 + m) * 4096 + bj * HALF + fr * 8 + fq * 1024 + u.pm) = pack8(acc[ai][bj][m][0], acc[ai][bj][m][1]); }
    }
};


template <class Epi, class Sched, bool ALIGN_EPI = false, bool SP2 = false>
__device__ __forceinline__ void gemm_phase(PG8_LAS unsigned char* lds, const Gemm g, const Sched& S, const Epi& E) {
    const int tid = threadIdx.x, wid = __builtin_amdgcn_readfirstlane(tid >> 6), lane = tid & 63, wr = wid >> 2, wc = wid & 3, fr = lane & 15, fq = lane >> 4;
    constexpr bool I8 = Epi::I8;
    typedef typename Epi::acc_t acc_t;
    const int pitchB = g.K * (I8 ? 1 : 2), nt = pitchB / (BK * 2);
    unsigned voffA[2], voffB[2];
#pragma unroll
    for (int i = 0; i < 2; ++i) { int R, C; stage_rc(tid * 16 + i * 8192, R, C); const int Rb = Epi::PERM ? ((R & ~31) + perm32(R & 31)) : R;
        voffA[i] = (unsigned)(R * pitchB + C * 2); voffB[i] = (unsigned)(Rb * pitchB + C * 2); }
    const size_t kstep = (size_t)(BK * 2);
    const size_t hstep = (size_t)HALF * pitchB;
    const size_t tstep = 2 * hstep;
    const unsigned ldsw = (unsigned)wid * 1024u;
    const int aoff = lds_byte(wr * 64 + fr, fq * 8), boff = lds_byte(wc * 32 + fr, fq * 8);
#define PG8_SA(b, h) (((b) * 2 + (h)) * HTB)
#define PG8_SB(b, h) ((4 + (b) * 2 + (h)) * HTB)
#define PG8_STAGE(bufoff, gbase, voff) do { _Pragma("unroll") for (int _i = 0; _i < 2; ++_i) \
        __builtin_amdgcn_global_load_lds((const unsigned*)((const char*)(gbase) + (voff)[_i]), (PG8_LAS unsigned*)(lds + (bufoff) + ldsw + _i * 8192), 16, 0, 0); } while (0)
#define PG8_LDA(dst, b, h) do { _Pragma("unroll") for (int m = 0; m < 4; ++m) _Pragma("unroll") for (int k = 0; k < 2; ++k) dst[m][k] = *(const PG8_LAS bf16x8*)(lds + PG8_SA(b, h) + aoff + m * 2048 + k * 1024); } while (0)
#define PG8_LDB(dst, b, h) do { _Pragma("unroll") for (int n = 0; n < 2; ++n) _Pragma("unroll") for (int k = 0; k < 2; ++k) dst[n][k] = *(const PG8_LAS bf16x8*)(lds + PG8_SB(b, h) + boff + n * 2048 + k * 1024); } while (0)
#define PG8_MMA(ai, bj, At, Bt) do { __builtin_amdgcn_s_setprio(1); _Pragma("unroll") for (int m = 0; m < 4; ++m) _Pragma("unroll") for (int n = 0; n < 2; ++n) _Pragma("unroll") for (int k = 0; k < 2; ++k) \
        acc[ai][bj][m][n] = mma16(Bt[n][k], At[m][k], acc[ai][bj][m][n]); __builtin_amdgcn_s_setprio(0); } while (0)
#define PG8_WAIT_V(n) asm volatile("s_waitcnt vmcnt(" #n ")" ::: "memory")
#define PG8_WAIT_L(n) asm volatile("s_waitcnt lgkmcnt(" #n ")" ::: "memory")
#define PG8_BAR __builtin_amdgcn_s_barrier()
#define PG8_SCHED __builtin_amdgcn_sched_barrier(0)
    Unit cur, nxt; int ui = 0;
    if (!S.next(0, cur)) return;
    acc_t acc[2][2][4][2];
#pragma unroll
    for (int a = 0; a < 2; ++a)
#pragma unroll
        for (int b = 0; b < 2; ++b)
#pragma unroll
            for (int m = 0; m < 4; ++m)
#pragma unroll
                for (int n = 0; n < 2; ++n) acc[a][b][m][n] = acc_t{};
    bf16x8 At[4][2], B0[2][2], B1[2][2];
    const char* cA = (const char*)(cur.src ? g.A2 : g.A) + (size_t)cur.pm * tstep; const char* cB = (const char*)(cur.src ? g.Bt2 : g.Bt) + (size_t)cur.pn * tstep;
    S.a_ready(cur);
    if constexpr (SP2) {
        PG8_STAGE(PG8_SB(0, 0), cB, voffB); PG8_STAGE(PG8_SB(0, 1), cB + hstep, voffB); PG8_STAGE(PG8_SA(0, 0), cA, voffA); PG8_STAGE(PG8_SA(0, 1), cA + hstep, voffA);
        if (wr == 1) PG8_BAR;
        PG8_WAIT_V(2); PG8_BAR;
        PG8_STAGE(PG8_SB(1, 0), cB + kstep, voffB); PG8_STAGE(PG8_SA(1, 0), cA + kstep, voffA); PG8_STAGE(PG8_SB(1, 1), cB + hstep + kstep, voffB);
        PG8_WAIT_V(6); PG8_BAR;
    } else {
        PG8_STAGE(PG8_SB(0, 0), cB, voffB); PG8_STAGE(PG8_SA(0, 0), cA, voffA); PG8_STAGE(PG8_SB(0, 1), cB + hstep, voffB); PG8_STAGE(PG8_SA(0, 1), cA + hstep, voffA);
        if (wr == 1) PG8_BAR;
        PG8_WAIT_V(4); PG8_BAR;
        PG8_STAGE(PG8_SB(1, 0), cB + kstep, voffB); PG8_STAGE(PG8_SA(1, 0), cA + kstep, voffA); PG8_STAGE(PG8_SB(1, 1), cB + hstep + kstep, voffB);
        PG8_WAIT_V(6); PG8_BAR;
    }
    for (;;) {
        const bool has_next = S.next(ui + 1, nxt);
        const char* nA = has_next ? (const char*)(nxt.src ? g.A2 : g.A) + (size_t)nxt.pm * tstep : cA; const char* nB = has_next ? (const char*)(nxt.src ? g.Bt2 : g.Bt) + (size_t)nxt.pn * tstep : cB;
        for (int t = 0; t < nt; t += 2) {
            const bool last = (t == nt - 2);
            const char* a1 = cA + (size_t)(t + 1) * kstep;
            const char* a2 = last ? nA : cA + (size_t)(t + 2) * kstep; const char* b2 = last ? nB : cB + (size_t)(t + 2) * kstep;
            const char* a3 = a2 + kstep; const char* b3 = b2 + kstep;
            if (last && has_next) S.a_ready(nxt);
            if constexpr (SP2) {
            PG8_LDB(B0, 0, 0); PG8_LDB(B1, 0, 1); PG8_SCHED; PG8_LDA(At, 0, 0); PG8_STAGE(PG8_SA(1, 1), a1 + hstep, voffA);
            PG8_WAIT_V(8); PG8_WAIT_L(0); PG8_BAR; PG8_MMA(0, 0, At, B0); PG8_MMA(0, 1, At, B1); PG8_BAR; PG8_SCHED;
            PG8_LDA(At, 0, 1); PG8_STAGE(PG8_SB(0, 0), b2, voffB); PG8_STAGE(PG8_SB(0, 1), b2 + hstep, voffB); PG8_STAGE(PG8_SA(0, 0), a2, voffA);
            PG8_WAIT_V(8); PG8_WAIT_L(0); PG8_BAR; PG8_MMA(1, 0, At, B0); PG8_MMA(1, 1, At, B1); PG8_BAR; PG8_SCHED;
            PG8_LDB(B0, 1, 0); PG8_LDB(B1, 1, 1); PG8_SCHED; PG8_LDA(At, 1, 0); PG8_STAGE(PG8_SA(0, 1), a2 + hstep, voffA);
            PG8_WAIT_V(8); PG8_WAIT_L(0); PG8_BAR; PG8_MMA(0, 0, At, B0); PG8_MMA(0, 1, At, B1); PG8_BAR; PG8_SCHED;
            PG8_LDA(At, 1, 1); PG8_STAGE(PG8_SB(1, 0), b3, voffB); PG8_STAGE(PG8_SB(1, 1), b3 + hstep, voffB); PG8_STAGE(PG8_SA(1, 0), a3, voffA);
            PG8_WAIT_V(8); PG8_WAIT_L(0); PG8_BAR; PG8_MMA(1, 0, At, B0); PG8_MMA(1, 1, At, B1); PG8_BAR; PG8_SCHED;
            } else {
            PG8_LDB(B0, 0, 0); PG8_SCHED; PG8_LDA(At, 0, 0); PG8_STAGE(PG8_SA(1, 1), a1 + hstep, voffA);
            PG8_WAIT_L(8); PG8_BAR; PG8_WAIT_L(0); PG8_MMA(0, 0, At, B0); PG8_BAR; PG8_SCHED;
            PG8_LDB(B1, 0, 1); PG8_STAGE(PG8_SB(0, 0), b2, voffB);
            PG8_BAR; PG8_WAIT_L(0); PG8_MMA(0, 1, At, B1); PG8_BAR;
            PG8_LDA(At, 0, 1); PG8_STAGE(PG8_SA(0, 0), a2, voffA);
            PG8_BAR; PG8_WAIT_L(0); PG8_MMA(1, 0, At, B0); PG8_BAR; PG8_SCHED;
            PG8_STAGE(PG8_SB(0, 1), b2 + hstep, voffB);
            PG8_WAIT_V(6); PG8_BAR; PG8_MMA(1, 1, At, B1); PG8_BAR;
            PG8_LDB(B0, 1, 0); PG8_SCHED; PG8_LDA(At, 1, 0); PG8_STAGE(PG8_SA(0, 1), a2 + hstep, voffA);
            PG8_WAIT_L(8); PG8_BAR; PG8_WAIT_L(0); PG8_MMA(0, 0, At, B0); PG8_BAR; PG8_SCHED;
            PG8_LDB(B1, 1, 1); PG8_STAGE(PG8_SB(1, 0), b3, voffB);
            PG8_BAR; PG8_WAIT_L(0); PG8_MMA(0, 1, At, B1); PG8_BAR;
            PG8_LDA(At, 1, 1); PG8_STAGE(PG8_SA(1, 0), a3, voffA);
            PG8_BAR; PG8_WAIT_L(0); PG8_MMA(1, 0, At, B0); PG8_BAR; PG8_SCHED;
            PG8_STAGE(PG8_SB(1, 1), b3 + hstep, voffB);
            PG8_WAIT_V(6); PG8_BAR; PG8_MMA(1, 1, At, B1); PG8_BAR;
            }
        }
        if constexpr (ALIGN_EPI) { if (wr == 0) PG8_BAR; }
        bool keep_acc = false;
        if constexpr (Epi::DUAL) { if (cur.src == 0) { E.mid(acc, cur, wr, wc, fr, fq); keep_acc = true; } }
        if (!keep_acc) { E(acc, cur, wr, wc, fr, fq); S.done(cur); }
        if (!has_next) break;
        if (!keep_acc) {
#pragma unroll
        for (int a = 0; a < 2; ++a)
#pragma unroll
            for (int b = 0; b < 2; ++b)
#pragma unroll
                for (int m = 0; m < 4; ++m)
#pragma unroll
                    for (int n = 0; n < 2; ++n) acc[a][b][m][n] = acc_t{};
        }
        cur = nxt; cA = nA; cB = nB; ++ui;
        if constexpr (ALIGN_EPI) { if (wr == 1) PG8_BAR; }
    }
    PG8_WAIT_V(0);
    if constexpr (!ALIGN_EPI) { if (wr == 0) PG8_BAR; }
    PG8_BAR;
#undef PG8_SA
#undef PG8_SB
#undef PG8_STAGE
#undef PG8_LDA
#undef PG8_LDB
#undef PG8_MMA
#undef PG8_WAIT_V
#undef PG8_WAIT_L
#undef PG8_BAR
#undef PG8_SCHED
}
}
namespace fox {
using bf16 = unsigned short;
typedef short bf16x8 __attribute__((ext_vector_type(8)));
typedef short s16x4 __attribute__((ext_vector_type(4)));
typedef float f32x16 __attribute__((ext_vector_type(16)));
typedef float f32x4 __attribute__((ext_vector_type(4)));
typedef unsigned u32x4 __attribute__((ext_vector_type(4)));
template <class A, class Bt> struct same_t { static constexpr bool v = false; };
template <class A> struct same_t<A, A> { static constexpr bool v = true; };
constexpr int D = 128, PITCH = 2048;
constexpr float SCALE = 0.08838834764831845f;
constexpr float THR = 8.f;
constexpr bool WSKIP = false;
constexpr int NW = 8, QBLK = 32, KVBLK = 64, QB = NW * QBLK;
constexpr int SHM_V = KVBLK * D * 2, SHM_K = KVBLK * D * 2;
constexpr int LDS_BIAS = 2 * SHM_V + 2 * SHM_K + NW * 64 * 4;
constexpr int LDS_BYTES = LDS_BIAS + 2 * 4096 * 4;
#define KSWZ(row, colB) ((row) * 256 + ((colB) ^ (((row) & 7) << 4)))
#define SBAR() __builtin_amdgcn_sched_barrier(0)
__device__ __forceinline__ int v_st(int k, int c) { const int kk = (k & ~0xC) | ((k & 4) << 1) | ((k & 8) >> 1); return ((kk >> 3) * 4 + (c >> 5)) * 512 + ((kk & 7) * 32 + (c & 31)) * 2; }
__device__ __forceinline__ int v_rd_base(int lane) { return ((lane & 3) << 3) | (((lane >> 2) & 3) << 6) | (((lane >> 4) & 1) << 5) | (((lane >> 5) & 1) << 8); }
constexpr int v_rd_off(int d0, int ks, int half) { return d0 * 512 + ks * 4096 + half * 2048; }
__device__ __forceinline__ int crow(int r, int hi) { return (r & 3) + 8 * (r >> 2) + 4 * hi; }
__device__ __forceinline__ unsigned cvtpk(float lo, float hi) { return pg8::cvt_pk_bf16(lo, hi); }
__device__ __forceinline__ bf16x8 pack8(f32x4 a, f32x4 b) {
    u32x4 w = {cvtpk(a[0], a[1]), cvtpk(a[2], a[3]), cvtpk(b[0], b[1]), cvtpk(b[2], b[3])};
    return *reinterpret_cast<bf16x8*>(&w);
}
template <class T> __device__ __forceinline__ bf16x8 load8(const T* p) {
    if constexpr (same_t<T, float>::v) { return pack8(*(const f32x4*)p, *(const f32x4*)(p + 4)); }
    else { return *reinterpret_cast<const bf16x8*>(p); }
}
__device__ __forceinline__ void mask_tile(f32x16& p0, f32x16& p1, int dq, unsigned W) {
    const float NEG = -__builtin_inff();
#pragma unroll
    for (int r = 0; r < 16; ++r) {
        const int c = (r & 3) + 8 * (r >> 2);
        if ((unsigned)(dq - c) >= W) p0[r] = NEG;
        if ((unsigned)(dq - c - 32) >= W) p1[r] = NEG;
    }
}
__device__ __forceinline__ void partialSM(f32x16& p0, f32x16& p1, float& m_reg, float& mn, float& alpha) {
    float pmax = p0[0]; for (int r = 1; r < 16; ++r) pmax = fmaxf(pmax, p0[r]); for (int r = 0; r < 16; ++r) pmax = fmaxf(pmax, p1[r]);
    { auto rr = __builtin_amdgcn_permlane32_swap(__float_as_uint(pmax), __float_as_uint(pmax), false, false);
      pmax = fmaxf(__uint_as_float(rr[0]), __uint_as_float(rr[1])); }
    constexpr float C2 = 1.4426950408889634f * SCALE;
    if (__builtin_expect(__all((pmax - m_reg) * SCALE <= THR), 1)) { mn = m_reg; alpha = 1.f; }
    else { mn = fmaxf(m_reg, pmax); alpha = __builtin_amdgcn_exp2f((m_reg - mn) * C2); m_reg = mn; }
    const float mnL = -mn * C2;
    for (int r = 0; r < 16; ++r) p0[r] = fmaf(p0[r], C2, mnL); for (int r = 0; r < 16; ++r) p1[r] = fmaf(p1[r], C2, mnL);
    for (int r = 0; r < 16; ++r) p0[r] = __builtin_amdgcn_exp2f(p0[r]);
}
__device__ __forceinline__ void finishSM(f32x16& p0, f32x16& p1, float alpha, float& l_reg, bf16x8& pa0, bf16x8& pa1, bf16x8& pa2, bf16x8& pa3) {
    for (int r = 0; r < 16; ++r) p1[r] = __builtin_amdgcn_exp2f(p1[r]);
    float ps = 0; for (int r = 0; r < 16; ++r) ps += p0[r]; for (int r = 0; r < 16; ++r) ps += p1[r];
    { auto rr = __builtin_amdgcn_permlane32_swap(__float_as_uint(ps), __float_as_uint(ps), false, false);
      ps = __uint_as_float(rr[0]) + __uint_as_float(rr[1]); }
    l_reg = l_reg * alpha + ps;
#define PK4(P, B_, OUT) do { unsigned a0 = cvtpk(P[B_+0], P[B_+1]), a1 = cvtpk(P[B_+2], P[B_+3]);                          \
        unsigned b0 = cvtpk(P[B_+4], P[B_+5]), b1 = cvtpk(P[B_+6], P[B_+7]);                                             \
        auto r0 = __builtin_amdgcn_permlane32_swap(a0, b0, false, false); auto r1 = __builtin_amdgcn_permlane32_swap(a1, b1, false, false); \
        u32x4 w = {r0[0], r1[0], r0[1], r1[1]}; OUT = *reinterpret_cast<bf16x8*>(&w); } while (0)
    PK4(p0, 0, pa0); PK4(p0, 8, pa1); PK4(p1, 0, pa2); PK4(p1, 8, pa3);
#undef PK4
}
template <int KB, bool SK>
__device__ __forceinline__ void qkt(f32x16& p0, f32x16& p1, const char* K_lds, int r32, int hi, const bf16x8* qr, bool act, const char* bias_t) {
    if (SK && !act) { const float NEG = -__builtin_inff();
#pragma unroll
        for (int r = 0; r < 16; ++r) { p0[r] = NEG; p1[r] = NEG; } return; }
#ifdef FOX_NOBIAS
    p0 = f32x16{}; p1 = f32x16{};
#else
#pragma unroll
    for (int g = 0; g < 4; ++g) { const f32x4 b0 = *reinterpret_cast<const f32x4*>(bias_t + g * 32), b1 = *reinterpret_cast<const f32x4*>(bias_t + 128 + g * 32);
        p0[4 * g] = b0[0]; p0[4 * g + 1] = b0[1]; p0[4 * g + 2] = b0[2]; p0[4 * g + 3] = b0[3]; p1[4 * g] = b1[0]; p1[4 * g + 1] = b1[1]; p1[4 * g + 2] = b1[2]; p1[4 * g + 3] = b1[3]; }
#endif
    const char* kb[4];
#pragma unroll
    for (int dd = 0; dd < 4; ++dd) kb[dd] = K_lds + KB * SHM_K + KSWZ(r32, (dd * 16 + hi * 8) * 2);
#pragma unroll
    for (int d0 = 0; d0 < 8; ++d0) { const char* a = kb[d0 & 3] + (d0 >> 2) * 128;
        bf16x8 b0 = *reinterpret_cast<const bf16x8*>(a);
        bf16x8 b1 = *reinterpret_cast<const bf16x8*>(a + 32 * 256);
        p0 = __builtin_amdgcn_mfma_f32_32x32x16_bf16(b0, qr[d0], p0, 0, 0, 0);
        p1 = __builtin_amdgcn_mfma_f32_32x32x16_bf16(b1, qr[d0], p1, 0, 0, 0); }
}
template <int VB, bool SK>
__device__ __forceinline__ void pv_tile(f32x16* o, int vb0, bf16x8 pa0, bf16x8 pa1, bf16x8 pa2, bf16x8 pa3, bool act) {
    if (SK && !act) return;
#define TRRD(dst, off) asm volatile("ds_read_b64_tr_b16 %0, %1 offset:%2" : "=&v"(dst) : "v"(vb0), "i"(off) : "memory")
#define PV_D0(d0) do { s16x4 l0, l1, l2, l3, h0, h1, h2, h3; constexpr int b_ = VB * SHM_V + v_rd_off(d0, 0, 0);     \
        TRRD(l0, b_); TRRD(h0, b_ + 2048); TRRD(l1, b_ + 4096); TRRD(h1, b_ + 6144); TRRD(l2, b_ + 8192); TRRD(h2, b_ + 10240); TRRD(l3, b_ + 12288); TRRD(h3, b_ + 14336); \
        asm volatile("s_waitcnt lgkmcnt(0)" ::: "memory"); SBAR();                 \
        o[d0] = __builtin_amdgcn_mfma_f32_32x32x16_bf16(pa0, (bf16x8){l0[0], l0[1], l0[2], l0[3], h0[0], h0[1], h0[2], h0[3]}, o[d0], 0, 0, 0);   \
        o[d0] = __builtin_amdgcn_mfma_f32_32x32x16_bf16(pa1, (bf16x8){l1[0], l1[1], l1[2], l1[3], h1[0], h1[1], h1[2], h1[3]}, o[d0], 0, 0, 0);   \
        o[d0] = __builtin_amdgcn_mfma_f32_32x32x16_bf16(pa2, (bf16x8){l2[0], l2[1], l2[2], l2[3], h2[0], h2[1], h2[2], h2[3]}, o[d0], 0, 0, 0);   \
        o[d0] = __builtin_amdgcn_mfma_f32_32x32x16_bf16(pa3, (bf16x8){l3[0], l3[1], l3[2], l3[3], h3[0], h3[1], h3[2], h3[3]}, o[d0], 0, 0, 0); } while (0)
    PV_D0(0); PV_D0(1); PV_D0(2); PV_D0(3);
#undef PV_D0
#undef TRRD
}
template <class TIn, class TOut> struct BlockRef { const TIn* Q; const TIn* K; const TIn* V; TOut* O; int P0; int jlo; int boff; };
template <class TIn> struct Seam {
    bf16x8 qr[8];
    bf16x8 st_v0, st_v1, st_k0, st_k1; f32x4 sf0, sf1, sf2, sf3;
    f32x4 tq[16];
};
__device__ __forceinline__ int swa_jlo(int P0, int W) { const int lowk = P0 - W + 1; return lowk > 0 ? lowk / KVBLK : 0; }
#define ROW(p, k0, rr) ((p) + ((size_t)(k0) + ((rr) - sr)) * PITCH + soff)
#define VMW() asm volatile("s_waitcnt vmcnt(0)" ::: "memory")
#define VMWN(n) asm volatile("s_waitcnt vmcnt(%0)" :: "i"(n) : "memory")
#define SLOAD_H(Kp, Vp, k0) do { S.st_v0 = load8<TIn>(ROW(Vp, k0, sr)); S.st_v1 = load8<TIn>(ROW(Vp, k0, 32 + sr));              \
                         S.st_k0 = load8<TIn>(ROW(Kp, k0, sr)); S.st_k1 = load8<TIn>(ROW(Kp, k0, 32 + sr)); } while (0)
#define SWRITE_HK(bf) do { *(bf16x8*)(K_lds + (bf) * SHM_K + kws) = S.st_k0; *(bf16x8*)(K_lds + (bf) * SHM_K + kws + 32 * 256) = S.st_k1; } while (0)
#define SWRITE_HV(bf) do { *(bf16x8*)(V_lds + (bf) * SHM_V + vst0) = S.st_v0; *(bf16x8*)(V_lds + (bf) * SHM_V + vst1) = S.st_v1; } while (0)
#define SWRITE_H(bf) do { SWRITE_HV(bf); SWRITE_HK(bf); } while (0)
#define SLOAD_F(p, k0) do { S.sf0 = *(const f32x4*)ROW(p, k0, sr); S.sf1 = *(const f32x4*)(ROW(p, k0, sr) + 4);                \
                            S.sf2 = *(const f32x4*)ROW(p, k0, 32 + sr); S.sf3 = *(const f32x4*)(ROW(p, k0, 32 + sr) + 4); } while (0)
#define SWRITE_KF(bf) do { *(bf16x8*)(K_lds + (bf) * SHM_K + kws) = pack8(S.sf0, S.sf1); *(bf16x8*)(K_lds + (bf) * SHM_K + kws + 32 * 256) = pack8(S.sf2, S.sf3); } while (0)
#define SWRITE_VF(bf) do { *(bf16x8*)(V_lds + (bf) * SHM_V + vst0) = pack8(S.sf0, S.sf1); *(bf16x8*)(V_lds + (bf) * SHM_V + vst1) = pack8(S.sf2, S.sf3); } while (0)
template <class TIn, class TOut>
__device__ __forceinline__ void causal_swa_prime(const BlockRef<TIn, TOut>& cur, int W, char* lds, Seam<TIn>& S) {
    constexpr bool F32 = same_t<TIn, float>::v;
    const int tid = threadIdx.x, wid = __builtin_amdgcn_readfirstlane(tid >> 6), lane = tid & 63, r32 = lane & 31, hi = lane >> 5;
    const int sr = tid >> 4, sc = (tid & 15) * 8, kws = KSWZ(sr, sc * 2); char* K_lds = lds + 2 * SHM_V; const unsigned soff = (unsigned)(sr * PITCH + sc), qoff = (unsigned)(r32 * PITCH + hi * 8);
    const int kb0 = cur.jlo * KVBLK;
    for (int d0 = 0; d0 < 8; ++d0) S.qr[d0] = load8<TIn>(cur.Q + (size_t)(wid * QBLK) * PITCH + qoff + d0 * 16);
    if constexpr (F32) { SLOAD_F((const float*)cur.K, kb0); VMW(); SWRITE_KF(0); SBAR(); SLOAD_F((const float*)cur.V, kb0); }
    else { SLOAD_H(cur.K, cur.V, kb0); VMW(); SWRITE_HK(0); }
    __syncthreads();
}
template <class TIn, class TOut>
__device__ __forceinline__ void causal_swa_block(const BlockRef<TIn, TOut>& cur, const BlockRef<TIn, TOut>& nxt, int skv, int W, char* lds, Seam<TIn>& S) {
    constexpr bool F32 = same_t<TIn, float>::v;
    const int tid = threadIdx.x, wid = __builtin_amdgcn_readfirstlane(tid >> 6), lane = tid & 63, r32 = lane & 31, hi = lane >> 5;
    const int j_lo = cur.jlo;
    int j_hi = (cur.P0 + QB - 1) / KVBLK + 1; if (j_hi > skv / KVBLK) j_hi = skv / KVBLK;
    const int NT = j_hi - j_lo;
    const int kbn = nxt.jlo * KVBLK;
    const int qlo = cur.P0 + wid * QBLK, qm = qlo + r32 - 4 * hi;
    char* V_lds = lds; char* K_lds = lds + 2 * SHM_V; const char* bias_h = lds + cur.boff + hi * 16;
    float* ws = (float*)(lds + 2 * SHM_V + 2 * SHM_K) + wid * 64; float* li_l = ws, * al_l = ws + 32;
    float m_reg = -1e30f, l_reg = 0; f32x16 o[4] = {};
    const int sr = tid >> 4, sc = (tid & 15) * 8, vst0 = v_st(sr, sc), vst1 = v_st(32 + sr, sc), kws = KSWZ(sr, sc * 2); const unsigned soff = (unsigned)(sr * PITCH + sc), qoff = (unsigned)(r32 * PITCH + hi * 8), ooff = (unsigned)(4 * hi * PITCH + r32);
    const int vb0 = (int)(uintptr_t)V_lds + v_rd_base(lane);
    const TIn* Kh = cur.K; const TIn* Vh = cur.V;
#define RESC(a) do { if (__any((a) < 1.f)) { if (hi == 0) al_l[r32] = (a); asm volatile("s_waitcnt lgkmcnt(0)" ::: "memory");              \
                     for (int d_ = 0; d_ < 4; ++d_) for (int r = 0; r < 16; ++r) o[d_][r] *= al_l[crow(r, hi)]; } } while (0)
#define KBASE(t) ((j_lo + (t)) * KVBLK)
#define BIAS_T(t) (bias_h + KBASE(t) * 4)
#define ACT(t) (KBASE(t) <= qlo + QBLK - 1 && KBASE(t) + KVBLK - 1 >= qlo - W + 1)
#define MASKT(P0_, P1_, t) do { const int kb_ = KBASE(t); if ((!SK || ACT(t)) && (kb_ + KVBLK - 1 > qlo || kb_ <= qlo + QBLK - 1 - W)) mask_tile(P0_, P1_, qm - kb_, (unsigned)W); } while (0)
    constexpr int NQL = F32 ? 16 : 8;
    constexpr bool SK = WSKIP && !F32;
#define SEAM_K0() do { VMWN(NQL); if constexpr (F32) { SWRITE_KF(0); SBAR(); SLOAD_F((const float*)nxt.V, kbn); } else { SWRITE_HK(0); } SBAR(); } while (0)
    f32x16 pA0, pA1, pB0, pB1; float mnA, mnB, alA, alB; bf16x8 pa0, pa1, pa2, pa3;
    if constexpr (F32) { VMW(); SWRITE_VF(0); SBAR(); } else { SWRITE_HV(0); SBAR(); }
    if (NT > 1) { if constexpr (F32) SLOAD_F((const float*)Kh, KBASE(1)); else SLOAD_H(Kh, Vh, KBASE(1)); }
    SBAR(); qkt<0, SK>(pA0, pA1, K_lds, r32, hi, S.qr, ACT(0), BIAS_T(0));
    if constexpr (F32) { if (NT > 1) { VMW(); SWRITE_KF(1); SBAR(); SLOAD_F((const float*)Vh, KBASE(1)); } }
    MASKT(pA0, pA1, 0); partialSM(pA0, pA1, m_reg, mnA, alA);
    if (NT > 1) { VMW(); if constexpr (F32) { SWRITE_VF(1); SBAR(); if (NT > 2) SLOAD_F((const float*)Kh, KBASE(2)); } else SWRITE_H(1); }
    __syncthreads();
#define HALF_STEP(PX0, PX1, mnX, alX, PY0, PY1, alY, t, KB, VB, SB) do {                                                      \
        SBAR(); qkt<KB, SK>(PX0, PX1, K_lds, r32, hi, S.qr, ACT(t), BIAS_T(t));                                             \
        finishSM(PY0, PY1, alY, l_reg, pa0, pa1, pa2, pa3); SBAR();                                                           \
        if ((t) + 1 < NT) { if constexpr (F32) { VMW(); SWRITE_KF(SB); SBAR(); SLOAD_F((const float*)Vh, KBASE((t) + 1)); }  \
                            else { SLOAD_H(Kh, Vh, KBASE((t) + 1)); } SBAR(); }                                               \
        pv_tile<VB, SK>(o, vb0, pa0, pa1, pa2, pa3, ACT((t) - 1)); MASKT(PX0, PX1, (t)); partialSM(PX0, PX1, m_reg, mnX, alX);                                        \
        __syncthreads();                                                                                                      \
        if ((t) + 1 < NT) { VMW(); if constexpr (F32) { SWRITE_VF(SB); SBAR(); if ((t) + 2 < NT) SLOAD_F((const float*)Kh, KBASE((t) + 2)); } \
                            else { SWRITE_H(SB); } }                                                                          \
        RESC(alX); __syncthreads(); } while (0)
    for (int t = 1; t + 1 < NT; t += 2) {
        HALF_STEP(pB0, pB1, mnB, alB, pA0, pA1, alA, t, 1, 0, 0);
        HALF_STEP(pA0, pA1, mnA, alA, pB0, pB1, alB, t + 1, 0, 1, 1);
    }
    const bool even = (NT & 1) == 0;
    if (even) { SBAR(); qkt<1, SK>(pB0, pB1, K_lds, r32, hi, S.qr, ACT(NT - 1), BIAS_T(NT - 1)); SBAR(); }
#define QROW(e) (nxt.Q + (size_t)(wid * QBLK) * PITCH + qoff + ((e) >> 1) * 16 + ((e) & 1) * 4)
    if constexpr (F32) { SLOAD_F((const float*)nxt.K, kbn); SBAR();
#pragma unroll
        for (int e = 0; e < 8; ++e) S.tq[e] = *(const f32x4*)QROW(e); }
    else { SLOAD_H(nxt.K, nxt.V, kbn); SBAR();
#pragma unroll
        for (int d0 = 0; d0 < 8; ++d0) S.qr[d0] = load8<TIn>(nxt.Q + (size_t)(wid * QBLK) * PITCH + qoff + d0 * 16); }
    SBAR();
    finishSM(pA0, pA1, alA, l_reg, pa0, pa1, pa2, pa3); SBAR();
    if constexpr (F32) {
#pragma unroll
        for (int e = 8; e < 16; ++e) S.tq[e] = *(const f32x4*)QROW(e); SBAR(); }
#undef QROW
    pv_tile<0, SK>(o, vb0, pa0, pa1, pa2, pa3, ACT(even ? NT - 2 : NT - 1));
    if (even) { MASKT(pB0, pB1, NT - 1); partialSM(pB0, pB1, m_reg, mnB, alB); __syncthreads(); RESC(alB);
        finishSM(pB0, pB1, alB, l_reg, pa0, pa1, pa2, pa3); SBAR(); pv_tile<1, SK>(o, vb0, pa0, pa1, pa2, pa3, ACT(NT - 1)); }
    SBAR(); SEAM_K0();
    if (hi == 0) li_l[r32] = l_reg; asm volatile("s_waitcnt lgkmcnt(0)" ::: "memory");
    float rli[16];
#pragma unroll
    for (int r = 0; r < 16; ++r) rli[r] = __builtin_amdgcn_rcpf(li_l[crow(r, hi)]);
    TOut* Ow = cur.O + (size_t)(wid * QBLK) * PITCH;
#pragma unroll
    for (int r = 0; r < 16; ++r) { const int orow = (r & 3) + 8 * (r >> 2);
#pragma unroll
        for (int d0 = 0; d0 < 4; ++d0) { const float v = o[d0][r] * rli[r];
            if constexpr (same_t<TOut, float>::v) { Ow[(size_t)orow * PITCH + d0 * 32 + ooff] = v; }
            else { const float vn = __shfl_xor(v, 1);
                   if ((r32 & 1) == 0) *(unsigned*)(Ow + (size_t)orow * PITCH + d0 * 32 + ooff) = cvtpk(v, vn); } } }
    if constexpr (F32) {
#pragma unroll
        for (int d0 = 0; d0 < 8; ++d0) S.qr[d0] = pack8(S.tq[2 * d0], S.tq[2 * d0 + 1]); }
    __syncthreads();
#undef RESC
#undef KBASE
#undef BIAS_T
#undef ACT
#undef MASKT
#undef SEAM_K0
#undef HALF_STEP
}
#undef ROW
#undef VMW
#undef VMWN
#undef SLOAD_H
#undef SWRITE_HK
#undef SWRITE_HV
#undef SWRITE_H
#undef SLOAD_F
#undef SWRITE_KF
#undef SWRITE_VF

}
namespace swa {
using bf16 = unsigned short;
typedef short bf16x8 __attribute__((ext_vector_type(8)));
typedef short s16x4 __attribute__((ext_vector_type(4)));
typedef float f32x16 __attribute__((ext_vector_type(16)));
typedef unsigned u32x4 __attribute__((ext_vector_type(4)));
constexpr int KP = 144, VP = 520;
constexpr int LDS_K = 0, LDS_V = 256 * KP, LDS_TBL = LDS_V + 64 * VP, LDS_BYTES = LDS_TBL + 8 * 192 * 4;
constexpr float LOG2E = 1.4426950408889634f;
struct Tensors { const bf16* Q; const bf16* K; const bf16* V; bf16* O; const float* sinks; const float* relb; };
__device__ __forceinline__ int t5_bucket(int d) {
    if (d < 16) return d;
    return 16 + (d >= 19) + (d >= 21) + (d >= 24) + (d >= 27) + (d >= 31) + (d >= 35) + (d >= 40) + (d >= 46) + (d >= 52) + (d >= 59) + (d >= 67) + (d >= 77) + (d >= 87) + (d >= 99) + (d >= 113);
}
__device__ __forceinline__ unsigned cvtpk(float lo, float hi) { return pg8::cvt_pk_bf16(lo, hi); }

__device__ __forceinline__ void swa_unit(char* lds, const Tensors& T, int b, int kvh, int blk) {
    const int tid = threadIdx.x, wid = __builtin_amdgcn_readfirstlane(tid >> 6), lane = tid & 63, c32 = lane & 31, hi = lane >> 5;
    const int hq = kvh * 8 + wid;
    const float NEG = -__builtin_inff();
    const long tok0 = (long)b * 4096 + 128 * (blk - 1);
#pragma unroll
    for (int i = 0; i < 4; ++i) {
        const int id = tid + 512 * i, key = id >> 3, ch = id & 7;
        bf16x8 kv = {0, 0, 0, 0, 0, 0, 0, 0}, vv = {0, 0, 0, 0, 0, 0, 0, 0};
        if (blk > 0 || key >= 128) { const size_t off = (size_t)(tok0 + key) * 256 + kvh * 64 + ch * 8; kv = *(const bf16x8*)(T.K + off); vv = *(const bf16x8*)(T.V + off); }
        *(bf16x8*)(lds + LDS_K + key * KP + ch * 16) = kv;
#pragma unroll
        for (int j = 0; j < 8; ++j) *(short*)(lds + LDS_V + (ch * 8 + j) * VP + key * 2) = vv[j];
    }
    float* tbl = (float*)(lds + LDS_TBL) + wid * 192;
    for (int j = lane; j < 192; j += 64) { const int dist = j - 32; float v = NEG; if (dist >= 0 && dist < 128) v = T.relb[t5_bucket(dist) * 32 + hq] * LOG2E; tbl[j] = v; }
    const float sink2 = T.sinks[hq] * LOG2E;
    __syncthreads();
    const float* tb = tbl + (c32 - 4 * hi + 160);
    for (int a = 0; a < 4; ++a) {
        const size_t qrow = (size_t)b * 4096 + blk * 128 + a * 32 + c32;
        bf16x8 qf[4];
#pragma unroll
        for (int ks = 0; ks < 4; ++ks) qf[ks] = *(const bf16x8*)(T.Q + qrow * 2048 + hq * 64 + ks * 16 + hi * 8);
        f32x16 S[5];
#pragma unroll
        for (int t = 0; t < 5; ++t) {
            S[t] = f32x16{};
            const char* kp = lds + LDS_K + (32 * (a + t) + c32) * KP + hi * 16;
#pragma unroll
            for (int ks = 0; ks < 4; ++ks) { const bf16x8 kf = *(const bf16x8*)(kp + ks * 32); S[t] = __builtin_amdgcn_mfma_f32_32x32x16_bf16(kf, qf[ks], S[t], 0, 0, 0); }
        }
        float mx = sink2;
#pragma unroll
        for (int t = 0; t < 5; ++t) {
            const bool dead = (blk == 0) && (a + t < 4);
#pragma unroll
            for (int r = 0; r < 16; ++r) {
                float s = fmaf(S[t][r], 0.125f * LOG2E, tb[-((r & 3) + 8 * (r >> 2)) - 32 * t]);
                if (dead) s = NEG;
                S[t][r] = s; mx = fmaxf(mx, s);
            }
        }
        mx = fmaxf(mx, __shfl_xor(mx, 32));
        float sum = 0.f;
#pragma unroll
        for (int t = 0; t < 5; ++t)
#pragma unroll
            for (int r = 0; r < 16; ++r) { const float p = __builtin_amdgcn_exp2f(S[t][r] - mx); S[t][r] = p; sum += p; }
        sum += __shfl_xor(sum, 32);
        const float inv = 1.f / (sum + __builtin_amdgcn_exp2f(sink2 - mx));
        f32x16 O0 = f32x16{}, O1 = f32x16{};
#pragma unroll
        for (int t = 0; t < 5; ++t)
#pragma unroll
            for (int s = 0; s < 2; ++s) {
                u32x4 aw; aw.x = cvtpk(S[t][8 * s] * inv, S[t][8 * s + 1] * inv); aw.y = cvtpk(S[t][8 * s + 2] * inv, S[t][8 * s + 3] * inv);
                aw.z = cvtpk(S[t][8 * s + 4] * inv, S[t][8 * s + 5] * inv); aw.w = cvtpk(S[t][8 * s + 6] * inv, S[t][8 * s + 7] * inv);
                const bf16x8 af = __builtin_bit_cast(bf16x8, aw);
                const char* vp = lds + LDS_V + c32 * VP + (32 * (a + t) + 16 * s + 4 * hi) * 2;
                const s16x4 l0 = *(const s16x4*)(vp), h0 = *(const s16x4*)(vp + 16), l1 = *(const s16x4*)(vp + 32 * VP), h1 = *(const s16x4*)(vp + 32 * VP + 16);
                O0 = __builtin_amdgcn_mfma_f32_32x32x16_bf16(af, (bf16x8){l0[0], l0[1], l0[2], l0[3], h0[0], h0[1], h0[2], h0[3]}, O0, 0, 0, 0);
                O1 = __builtin_amdgcn_mfma_f32_32x32x16_bf16(af, (bf16x8){l1[0], l1[1], l1[2], l1[3], h1[0], h1[1], h1[2], h1[3]}, O1, 0, 0, 0);
            }
        bf16* Ob = T.O + ((size_t)b * 4096 + blk * 128 + a * 32) * 2048 + hq * 64;
#pragma unroll
        for (int r = 0; r < 16; ++r) { const int q = (r & 3) + 8 * (r >> 2) + 4 * hi;
            const float v0 = O0[r], v1 = O1[r]; const float n0 = __shfl_xor(v0, 1), n1 = __shfl_xor(v1, 1);
            if ((c32 & 1) == 0) { *(unsigned*)(Ob + (size_t)q * 2048 + c32) = cvtpk(v0, n0); *(unsigned*)(Ob + (size_t)q * 2048 + 32 + c32) = cvtpk(v1, n1); } }
    }
    __syncthreads();
}
}

constexpr int NWAVES = 8;
#ifndef FFN_I8
#define FFN_I8 1
#endif
#ifndef PG_ALIGN
#define PG_ALIGN true
#endif
#ifndef PG_SP2
#define PG_SP2 true
#endif
#ifndef PROBE8_SKIP_BF16
#define PROBE8_SKIP_BF16 0
#endif
#ifndef FFN_I8_TILES
#define FFN_I8_TILES 78
#endif
#ifndef MK_N_LAUNCHES
#define MK_N_LAUNCHES 1
#endif
constexpr int PER_PHASE = 11;
constexpr int N_LAUNCHES = MK_N_LAUNCHES;
static_assert(N_LAUNCHES == 1 || N_LAUNCHES == PER_PHASE, "MK_N_LAUNCHES is 1 or 11");

constexpr int BATCH = 4, SEQ = 4096, DM = 4096, M = BATCH * SEQ;
constexpr int H_A = 16, H_B = 32, HKV_B = 4;
constexpr int W_IN = 16912, D_FF = 11008;
constexpr int N_IN = pg8::IN_TILES * 256;
constexpr int N_INQ = pg8::INQ_TILES * 256;
constexpr int N_WIN = N_IN + N_INQ;
constexpr float EPS = 1e-6f;

constexpr size_t MiB = 1u << 20;
constexpr size_t WS_CTL = 0, CTL_ZERO_BYTES = 512 * 1024;
constexpr size_t WS_RSTD1 = 1 * MiB;
constexpr size_t WS_SX = 1 * MiB + 256 * 1024;
constexpr size_t WS_SA = 1 * MiB + 512 * 1024;
constexpr size_t WS_WIN = 2 * MiB;
constexpr size_t WS_WA = 136 * MiB, WS_WB = 152 * MiB, WS_WO = 168 * MiB;
constexpr size_t WS_Q4 = 200 * MiB;
constexpr size_t WS_KB = 456 * MiB, WS_VB = 464 * MiB;
constexpr size_t WS_LF = 472 * MiB, WS_CC = 473 * MiB;
constexpr size_t WS_SGA = 474 * MiB, WS_SGB = 602 * MiB;
constexpr size_t WS_WGU = 730 * MiB;
constexpr size_t WS_WD = 902 * MiB;
constexpr size_t WS_WGQ = 988 * MiB;
constexpr size_t WS_END = 1074 * MiB;
constexpr size_t WS_MIXED = WS_WIN;
constexpr size_t WS_X1B = WS_Q4;
constexpr size_t WS_HID = WS_Q4 + 128 * MiB;
static_assert(WS_WIN + (size_t)N_WIN * DM * 2 <= WS_WA && WS_HID + (size_t)M * D_FF * 2 <= WS_WGU && WS_WGU + (size_t)2 * D_FF * DM * 2 <= WS_WD && WS_WD + (size_t)DM * D_FF * 2 <= WS_WGQ && WS_WGQ + (size_t)2 * D_FF * DM <= WS_END, "d_ws map");
constexpr size_t DO_XB = 0, DO_OA = 128 * MiB, DO_OB = 192 * MiB;
constexpr size_t DO_XQ = 128 * MiB, DO_WINQ = 192 * MiB;
constexpr size_t DO_X1Q = 128 * MiB;
constexpr int CW_BAR = 4096;
constexpr int CW_RSQ2 = 16384, CW_RSQ3 = 32768;
constexpr int CW_NORM = 49152;
constexpr int CW_CMAX = 65536;
constexpr int CW_AMAX = 98304;
constexpr int CW_CMAXG = 114688;
static_assert(CW_CMAX + 2 * D_FF <= CW_AMAX && CW_AMAX + M <= CW_CMAXG && (CW_CMAXG + N_INQ) * 4 <= (int)CTL_ZERO_BYTES, "CTL words inside the memset region");

constexpr int RING_OFF = 0, RING_BYTES = 133120;
constexpr int MISC_OFF = 135168;
constexpr int LDS_BYTES = 147456;
static_assert(MISC_OFF + 128 <= LDS_BYTES && fox::LDS_BYTES <= RING_BYTES && swa::LDS_BYTES <= RING_BYTES && pg8::STAGE_BYTES <= RING_BYTES, "LDS map");

#define GAS __attribute__((address_space(1)))
#define LAS __attribute__((address_space(3)))
typedef unsigned short bf16;
typedef unsigned v4u __attribute__((ext_vector_type(4)));
typedef float f32x4 __attribute__((ext_vector_type(4)));
typedef GAS unsigned gu32;
#define RLX_AGENT __ATOMIC_RELAXED, __HIP_MEMORY_SCOPE_AGENT
#define LDS_WAIT() asm volatile("s_waitcnt lgkmcnt(0)" ::: "memory")
#define VM_WAIT() asm volatile("s_waitcnt vmcnt(0)" ::: "memory")

#define XB_TMO      128
#define XB_XCNT(j)  (256  + 64 * (j))
#define XB_XSUB(j)  (1280 + 64 * (j))
#define XB_XGEN(j)  (2304 + 64 * (j))
#define XB_TOP      3328
#define XB_TOPGEN   3392
#define XCD_BAR_WORDS 3456
#define XB_SPIN_CAP (1u << 18)

__device__ __forceinline__ unsigned xb_ld(unsigned* p)              { return __hip_atomic_load(p, __ATOMIC_RELAXED, __HIP_MEMORY_SCOPE_AGENT); }
__device__ __forceinline__ unsigned xb_add(unsigned* p, unsigned v) { return __hip_atomic_fetch_add(p, v, __ATOMIC_RELAXED, __HIP_MEMORY_SCOPE_AGENT); }
__device__ __forceinline__ unsigned xb_xcc_id() { return (unsigned)__builtin_amdgcn_s_getreg((3 << 11) | 20) & 0xFu; }
#define XB_SPIN(cond, bar) do { unsigned _sp = 0; while (cond) { __builtin_amdgcn_s_sleep(1); \
    if ((++_sp & 255u) == 0u) { if (xb_ld(&(bar)[XB_TMO])) break; if (_sp > XB_SPIN_CAP) { atomicAdd(&(bar)[XB_TMO], 1u); break; } } } } while (0)

struct XcdBarrier {
    unsigned* bar; unsigned x;
    volatile LAS unsigned* st;
};
__device__ __forceinline__ XcdBarrier xcd_barrier_post(unsigned* bar, volatile LAS unsigned* st) {
    XcdBarrier b; b.bar = bar; b.x = xb_xcc_id(); b.st = st;
    if (threadIdx.x == 0) (void)xb_add(&bar[XB_XCNT(b.x)], 1u);
    return b;
}
__device__ __forceinline__ void xcd_barrier_complete(unsigned* bar, unsigned x, unsigned& nloc, unsigned& nx) {
    const unsigned G = gridDim.x * gridDim.y * gridDim.z;
    unsigned sum, cnt, mine, sp = 0u;
    for (;;) {
        sum = 0u; cnt = 0u; mine = 0u;
#pragma unroll
        for (unsigned j = 0; j < 16; ++j) { const unsigned c = xb_ld(&bar[XB_XCNT(j)]); sum += c; cnt += (c > 0u) ? 1u : 0u; mine = (j == x) ? c : mine; }
        if (sum == G) break;
        __builtin_amdgcn_s_sleep(1);
        if ((++sp & 255u) == 0u) { if (xb_ld(&bar[XB_TMO])) break; if (sp > XB_SPIN_CAP) { atomicAdd(&bar[XB_TMO], 1u); break; } }
    }
    nloc = mine > 0u ? mine : 1u; nx = cnt > 0u ? cnt : 1u;
}
__device__ __forceinline__ void xcd_barrier(const XcdBarrier& b) {
    asm volatile("s_waitcnt vmcnt(0)" ::: "memory");
    __syncthreads();
    if (threadIdx.x == 0) {
        unsigned* bar = b.bar;
        __builtin_amdgcn_s_waitcnt(0);
        unsigned nloc = b.st[0], nx = b.st[1];
        if (nloc == 0u) { xcd_barrier_complete(bar, b.x, nloc, nx); b.st[0] = nloc; b.st[1] = nx; }
        const unsigned old = xb_add(&bar[XB_XSUB(b.x)], 1u);
        const unsigned gen = old / nloc;
        if (old + 1u == (gen + 1u) * nloc) {
            __builtin_amdgcn_fence(__ATOMIC_RELEASE, "agent");
            asm volatile("s_waitcnt vmcnt(0)" ::: "memory");
            const unsigned og = xb_add(&bar[XB_TOP], 1u);
            const unsigned tg = og / nx;
            if (og + 1u == (tg + 1u) * nx) xb_add(&bar[XB_TOPGEN], 1u);
            else XB_SPIN(xb_ld(&bar[XB_TOPGEN]) == tg, bar);
            __builtin_amdgcn_fence(__ATOMIC_ACQUIRE, "agent");
            xb_add(&bar[XB_XGEN(b.x)], 1u);
            asm volatile("s_waitcnt vmcnt(0)" ::: "memory");
        } else {
            XB_SPIN(xb_ld(&bar[XB_XGEN(b.x)]) == gen, bar);
            __builtin_amdgcn_fence(__ATOMIC_ACQUIRE, "agent");
            asm volatile("s_waitcnt vmcnt(0)" ::: "memory");
        }
    }
    __syncthreads();
}

__device__ __forceinline__ unsigned f2bf(float f) { unsigned u = __builtin_bit_cast(unsigned, f); return (u + 0x7fffu + ((u >> 16) & 1u)) >> 16; }
__device__ __forceinline__ unsigned pk2(float lo, float hi) { return f2bf(lo) | (f2bf(hi) << 16); }
__device__ __forceinline__ float wave_sum(float v) {
#pragma unroll
    for (int o = 1; o < 64; o <<= 1) v += __shfl_xor(v, o);
    return v;
}
__device__ __forceinline__ void p0_item(const float* W, int ldw, int srccol, int nvalid, const float* g, bf16* WT, int K, int dstrow, int k0, LAS float* scr, int lane, unsigned* cmax = nullptr, int wr0 = -1, int wc0 = 0) {
    const int rk = lane >> 4, c4 = (lane & 15) * 4;
    f32x4 v[16];
    if (wr0 >= 0) {
#pragma unroll
        for (int i = 0; i < 16; ++i) v[i] = *(const GAS f32x4*)(W + (size_t)(wr0 + i) * ldw + wc0 + 4 * lane);
    } else if (c4 < nvalid) {
#pragma unroll
        for (int i = 0; i < 16; ++i) v[i] = *(const GAS f32x4*)(W + (size_t)(k0 + 4 * i + rk) * ldw + srccol + c4);
    } else {
#pragma unroll
        for (int i = 0; i < 16; ++i) v[i] = (f32x4){0.f, 0.f, 0.f, 0.f};
    }
    if (g) {
#pragma unroll
        for (int i = 0; i < 16; ++i) v[i] = v[i] * g[k0 + 4 * i + rk];
    }
    if (cmax) {
        f32x4 mx = {0.f, 0.f, 0.f, 0.f};
#pragma unroll
        for (int i = 0; i < 16; ++i) { mx[0] = fmaxf(mx[0], fabsf(v[i][0])); mx[1] = fmaxf(mx[1], fabsf(v[i][1])); mx[2] = fmaxf(mx[2], fabsf(v[i][2])); mx[3] = fmaxf(mx[3], fabsf(v[i][3])); }
#pragma unroll
        for (int e = 0; e < 4; ++e) { mx[e] = fmaxf(mx[e], __shfl_xor(mx[e], 16)); mx[e] = fmaxf(mx[e], __shfl_xor(mx[e], 32)); }
        if (lane < 16) {
#pragma unroll
            for (int e = 0; e < 4; ++e) (void)__hip_atomic_fetch_max(cmax + dstrow + c4 + e, __builtin_bit_cast(unsigned, mx[e]), __ATOMIC_RELAXED, __HIP_MEMORY_SCOPE_AGENT); }
    }
#pragma unroll
    for (int i = 0; i < 16; ++i) { LAS float* s = scr + (4 * i + rk) * 65 + c4; s[0] = v[i][0]; s[1] = v[i][1]; s[2] = v[i][2]; s[3] = v[i][3]; }
    LDS_WAIT(); asm volatile("" ::: "memory");
    const int nl = lane & 7, kc = lane >> 3;
#pragma unroll
    for (int j = 0; j < 8; ++j) { const int n = nl + 8 * j; const LAS float* s = scr + (8 * kc) * 65 + n;
        v4u o; o.x = pk2(s[0 * 65], s[1 * 65]); o.y = pk2(s[2 * 65], s[3 * 65]); o.z = pk2(s[4 * 65], s[5 * 65]); o.w = pk2(s[6 * 65], s[7 * 65]);
#ifdef PROBE_NOWR
        if (wr0 != -2 || (o.x == 0x12345678u && j == 7))
#endif
        *(GAS v4u*)(WT + (size_t)(dstrow + n) * K + k0 + 8 * kc) = o; }
    LDS_WAIT(); asm volatile("" ::: "memory");
}

__device__ __forceinline__ unsigned q4(float a, float b, float c, float d, float sc) {
    const int ia = (int)fminf(fmaxf(__builtin_rintf(a * sc), -127.f), 127.f), ib = (int)fminf(fmaxf(__builtin_rintf(b * sc), -127.f), 127.f);
    const int ic = (int)fminf(fmaxf(__builtin_rintf(c * sc), -127.f), 127.f), id = (int)fminf(fmaxf(__builtin_rintf(d * sc), -127.f), 127.f);
    return (unsigned)(ia & 255) | ((unsigned)(ib & 255) << 8) | ((unsigned)(ic & 255) << 16) | ((unsigned)(id & 255) << 24);
}
__device__ __forceinline__ v4u q16(v4u p0, v4u p1, float sc) {
    v4u o; o.x = q4(pg8::bf_lo(p0.x), pg8::bf_hi(p0.x), pg8::bf_lo(p0.y), pg8::bf_hi(p0.y), sc); o.y = q4(pg8::bf_lo(p0.z), pg8::bf_hi(p0.z), pg8::bf_lo(p0.w), pg8::bf_hi(p0.w), sc);
    o.z = q4(pg8::bf_lo(p1.x), pg8::bf_hi(p1.x), pg8::bf_lo(p1.y), pg8::bf_hi(p1.y), sc); o.w = q4(pg8::bf_lo(p1.z), pg8::bf_hi(p1.z), pg8::bf_lo(p1.w), pg8::bf_hi(p1.w), sc); return o;
}
struct Args { const float* in[14]; float* out; unsigned char* ws; int ph_lo, ph_hi, li, pad; };

__global__ void __launch_bounds__(NWAVES * 64, 2) hybrid_fwd(Args args) {
    extern __shared__ __attribute__((aligned(16))) unsigned char lds[];
    LAS unsigned char* const L = (LAS unsigned char*)lds;
    volatile LAS unsigned* const MISC = (volatile LAS unsigned*)(L + MISC_OFF);
    const int tid = threadIdx.x, lane = tid & 63, wave = __builtin_amdgcn_readfirstlane(tid >> 6);
    const int G = gridDim.x; const int bx = blockIdx.x; const int vcu = (G % 8 == 0) ? (bx % 8) * (G / 8) + bx / 8 : bx;
    unsigned char* const ws = args.ws;
    gu32* const ctl = (gu32*)(ws + WS_CTL);
    for (int u = tid; u < (LDS_BYTES - MISC_OFF) / 4; u += NWAVES * 64) ((LAS unsigned*)(L + MISC_OFF))[u] = 0u;
    __syncthreads();
    XcdBarrier bar; bar.bar = (unsigned*)(ctl + CW_BAR); bar.x = 0; bar.st = nullptr;
    if (N_LAUNCHES != PER_PHASE) bar = xcd_barrier_post((unsigned*)(ctl + CW_BAR), MISC + 8);
#define GRID_BAR() do { if (N_LAUNCHES != PER_PHASE) xcd_barrier(bar); } while (0)
    const int lo = args.ph_lo, hi = args.ph_hi;
#ifndef PH_MASK
#define PH_MASK 0x7ff
#endif
#define IN(k) ((((PH_MASK) >> (k)) & 1) && lo <= (k) && (k) < hi)
#define BOTH(k) (IN(k) && IN((k) + 1))
    const int gw = vcu * NWAVES + wave, NGW = G * NWAVES;

    const float* x = args.in[0]; float* out = args.out;
#ifdef PROBE_DUP
    const bool dummy = args.pad != 0;
#else
    constexpr bool dummy = false;
#endif
    float* rstd1 = (float*)(ws + WS_RSTD1);
    float* rsq2 = (float*)(ws + WS_CTL) + CW_RSQ2; float* rsq3 = (float*)(ws + WS_CTL) + CW_RSQ3;
    bf16* WIN = (bf16*)(ws + WS_WIN); bf16* WA = (bf16*)(ws + WS_WA); bf16* WB = (bf16*)(ws + WS_WB); bf16* WO = (bf16*)(ws + WS_WO);
    bf16* WGU = (bf16*)(ws + WS_WGU); bf16* WD = (bf16*)(ws + WS_WD);
    bf16* Q4 = (bf16*)(ws + WS_Q4); bf16* KBt = (bf16*)(ws + WS_KB); bf16* VBt = (bf16*)(ws + WS_VB);
    float* LF = (float*)(ws + WS_LF); float* CC = (float*)(ws + WS_CC);
    bf16* SGA = (bf16*)(ws + WS_SGA); bf16* SGB = (bf16*)(ws + WS_SGB);
    bf16* MIXED = (bf16*)(ws + WS_MIXED); bf16* X1B = (bf16*)(ws + WS_X1B); bf16* HID = (bf16*)(ws + WS_HID);
    signed char* WGQ = (signed char*)(ws + WS_WGQ); signed char* XQ = (signed char*)out + DO_XQ; signed char* WINQ = (signed char*)out + DO_WINQ; float* SX = (float*)(ws + WS_SX); float* RSTD2 = (float*)(ws + WS_SX + 65536); signed char* X1Q = (signed char*)out + DO_X1Q; float* SA = (float*)(ws + WS_SA);
    bf16* XB = (bf16*)((unsigned char*)out + DO_XB); bf16* OA = (bf16*)((unsigned char*)out + DO_OA); bf16* OB = (bf16*)((unsigned char*)out + DO_OB);

    if (IN(0)) {
        LAS float* scr = (LAS float*)(L + RING_OFF + wave * 16640);
        const float* g1 = args.in[1]; const float* g2 = args.in[9];
        constexpr int I_IN = 64 * 96, I_FA = 64 * 4, I_GT = 64 * 168, I_A = 32 * 64, I_O = 64 * 64, I_G = 64 * 172, I_D = 172 * 64;
        constexpr int NITEMS = I_IN + I_FA + I_GT + 2 * I_A + I_O + 2 * I_G + I_D, P0_SHIFT = I_IN + I_FA + I_GT;
#ifdef PROBE_P0
#define PCM(x) (args.pad ? nullptr : (x))
#define PWT(x) (args.pad ? HID : (x))
#else
#define PCM(x) (x)
#define PWT(x) (x)
#endif
#ifdef PROBE_WIDE
#define WIDE_ARGS(NB, C0) , (args.pad ? 16 * (r / ((NB) / 4)) : -1), (C0) + 256 * (r % ((NB) / 4))
#elif defined(PROBE_NOWR)
#define WIDE_ARGS(NB, C0) , (args.pad ? -2 : -1), 0
#else
#define WIDE_ARGS(NB, C0)
#endif
        for (int it = gw; it < NITEMS; it += NGW) {
            int r = it + P0_SHIFT; if (r >= NITEMS) r -= NITEMS;

            if (r < I_IN) { const int kb = r / 96, nb = r % 96, n0 = 64 * nb; p0_item(args.in[2], W_IN, n0, 64, g1, PWT(WIN), DM, n0, 64 * kb, scr, lane, nullptr WIDE_ARGS(96, 0)); continue; } r -= I_IN;
            if (r < I_FA) { const int kb = r / 4, nb = r % 4; p0_item(args.in[2], W_IN, 6144, nb == 0 ? 16 : 0, g1, PWT(WIN), DM, 6144 + 64 * nb, 64 * kb, scr, lane); continue; } r -= I_FA;
            if (r < I_GT) { const int kb = r / 168, nb = r % 168, n0 = 64 * nb;
                int d0 = n0; if (n0 >= 2560) { const int c = n0 - 2560, isb = c >= 4096, cc = c - 4096 * isb; d0 = 2560 + 256 * (cc >> 7) + 128 * isb + (cc & 127); }
                p0_item(args.in[2], W_IN, 6160 + n0, 64, g1, PWT(WIN), DM, N_IN + d0, 64 * kb, scr, lane, PCM((unsigned*)(ctl + CW_CMAXG) - N_IN) WIDE_ARGS(168, 6160)); continue; } r -= I_GT;
            if (r < I_A) { const int kb = r / 64, nb = r % 64; p0_item(args.in[6], DM, 64 * nb, 64, nullptr, PWT(WA), 2048, 64 * nb, 64 * kb, scr, lane, nullptr WIDE_ARGS(64, 0)); continue; } r -= I_A;
            if (r < I_A) { const int kb = r / 64, nb = r % 64; p0_item(args.in[7], DM, 64 * nb, 64, nullptr, PWT(WB), 2048, 64 * nb, 64 * kb, scr, lane, nullptr WIDE_ARGS(64, 0)); continue; } r -= I_A;
            if (r < I_O) { const int kb = r / 64, nb = r % 64; p0_item(args.in[8], DM, 64 * nb, 64, nullptr, PWT(WO), DM, 64 * nb, 64 * kb, scr, lane, nullptr WIDE_ARGS(64, 0)); continue; } r -= I_O;
            if (r < I_G) { const int kb = r / 172, nb = r % 172, n0 = 64 * nb; p0_item(args.in[10], D_FF, n0, 64, g2, PWT(WGU), DM, 256 * (n0 >> 7) + (n0 & 127), 64 * kb, scr, lane, PCM((unsigned*)(ctl + CW_CMAX)) WIDE_ARGS(172, 0)); continue; } r -= I_G;
            if (r < I_G) { const int kb = r / 172, nb = r % 172, n0 = 64 * nb; p0_item(args.in[11], D_FF, n0, 64, g2, PWT(WGU), DM, 256 * (n0 >> 7) + 128 + (n0 & 127), 64 * kb, scr, lane, PCM((unsigned*)(ctl + CW_CMAX)) WIDE_ARGS(172, 0)); continue; } r -= I_G;
            { const int kb = r / 64, nb = r % 64; p0_item(args.in[12], DM, 64 * nb, 64, nullptr, PWT(WD), D_FF, 64 * nb, 64 * kb, scr, lane, nullptr WIDE_ARGS(64, 0)); }
        }
        for (int m = gw; m < M; m += NGW) {
            const GAS f32x4* xr = (const GAS f32x4*)(x + (size_t)m * DM) + lane;
            f32x4 v[16]; float s = 0.f;
#pragma unroll
            for (int j = 0; j < 16; ++j) { v[j] = xr[64 * j]; s += (v[j].x * v[j].x + v[j].y * v[j].y) + (v[j].z * v[j].z + v[j].w * v[j].w); }
            s = wave_sum(s);
            float amx = 0.f;
#pragma unroll
            for (int j = 0; j < 16; ++j) amx = fmaxf(amx, fmaxf(fmaxf(fabsf(v[j].x), fabsf(v[j].y)), fmaxf(fabsf(v[j].z), fabsf(v[j].w))));
#pragma unroll
            for (int o = 1; o < 64; o <<= 1) amx = fmaxf(amx, __shfl_xor(amx, o));
            const float rs1 = 1.f / sqrtf(s * (1.f / DM) + EPS), qs = amx > 0.f ? 127.f / amx : 0.f;
            if (lane == 0) { rstd1[m] = rs1; SX[m] = rs1 * amx * (1.f / 127.f); }
            GAS unsigned* q4p = (GAS unsigned*)(XQ + (size_t)m * DM) + lane;
#pragma unroll
            for (int j = 0; j < 16; ++j) q4p[64 * j] = q4(v[j].x, v[j].y, v[j].z, v[j].w, qs);
            GAS unsigned long long* o8 = (GAS unsigned long long*)(XB + (size_t)m * DM) + lane;
#pragma unroll
            for (int j = 0; j < 16; ++j) o8[64 * j] = (unsigned long long)pk2(v[j].x, v[j].y) | ((unsigned long long)pk2(v[j].z, v[j].w) << 32);
        }
        if (BOTH(0)) GRID_BAR();
    }

    if (IN(1)) {
        {   const unsigned* cm = (const unsigned*)(ctl + CW_CMAXG);
            v4u p[8];
            if (gw < N_INQ) { const GAS v4u* src = (const GAS v4u*)(WIN + (size_t)(N_IN + gw) * DM) + 2 * lane;
#pragma unroll
                for (int j = 0; j < 4; ++j) { p[2 * j] = src[128 * j]; p[2 * j + 1] = src[128 * j + 1]; } }
            for (int n = gw; n < N_INQ; n += NGW) {
                v4u pn[8];
                if (n + NGW < N_INQ) { const GAS v4u* src = (const GAS v4u*)(WIN + (size_t)(N_IN + n + NGW) * DM) + 2 * lane;
#pragma unroll
                    for (int j = 0; j < 4; ++j) { pn[2 * j] = src[128 * j]; pn[2 * j + 1] = src[128 * j + 1]; } }
                const float mxv = __builtin_bit_cast(float, __hip_atomic_load(cm + n, RLX_AGENT)); const float sc = mxv > 0.f ? 127.f / mxv : 0.f;
                GAS v4u* dst = (GAS v4u*)(WINQ + (size_t)n * DM) + lane;
#pragma unroll
                for (int j = 0; j < 4; ++j) dst[64 * j] = q16(p[2 * j], p[2 * j + 1], sc);
#pragma unroll
                for (int j = 0; j < 8; ++j) p[j] = pn[j];
            }
        }
        if (BOTH(1)) GRID_BAR();
    }

    if (IN(2)) {
        { pg8::Gemm g{XB, WIN, M, N_IN, DM, nullptr, nullptr}; pg8::StaticOrder S; S.init(M, N_IN, G, bx);
          pg8::EpiInProj E{rstd1, Q4, LF, args.in[3], (unsigned*)(ctl + CW_NORM)};
          pg8::gemm_phase<pg8::EpiInProj, pg8::StaticOrder, PG_ALIGN, PG_SP2>(L + RING_OFF, g, S, E); }
        VM_WAIT(); __syncthreads();
        { pg8::Gemm g{(const bf16*)XQ, (const bf16*)WINQ, M, N_INQ, DM, nullptr, nullptr};
          pg8::TailOrder S; S.init(M, N_INQ, G, bx); S.nfull = (G == 256) ? 9 : (1 << 30); S.c0 = 64;
          typedef pg8::EpiGates8<WS_Q4 + (size_t)3 * M * 2048 * 2, WS_KB, WS_VB> EpiG;
          EpiG E{SX, (const unsigned*)(ctl + CW_CMAXG), ws, SGA, SGB};
          pg8::gemm_phase<EpiG, pg8::TailOrder, PG_ALIGN, PG_SP2>(L + RING_OFF, g, S, E); }
        if (BOTH(2)) GRID_BAR();
    }


    if (IN(4)) {
#ifndef NO_FOX
        {
            using namespace fox;
            constexpr int NX = 8, TOTAL = NX * BATCH * H_A;
            char* fl = (char*)lds + RING_OFF;
            const bf16* Qa = Q4; const bf16* Ka = Q4 + (size_t)M * 2048; const bf16* Va = Q4 + (size_t)2 * M * 2048;
            int Lc = vcu;
            if (Lc < TOTAL) {
                const int W = 1 << 20;
                constexpr float RS = 11.313708498984761f;
                float* wtot = (float*)(fl + 2 * SHM_V + 2 * SHM_K);
#define FOX_TABLE(slot_, L_) do { if ((L_) < TOTAL) { int tq_ = tid; asm volatile("" : "+v"(tq_));     \
                    const int bh_ = (L_) / NX, x_ = (L_) % NX, nk_ = (16 - x_) * QB, s0_ = 8 * tq_; float* tb_ = (float*)(fl + LDS_BIAS + (slot_) * 16384); \
                    float v_[8]; const float* lp_ = LF + ((size_t)(bh_ >> 4) * SEQ + s0_) * 16 + (bh_ & 15); \
                    _Pragma("unroll") for (int i_ = 0; i_ < 8; ++i_) v_[i_] = (s0_ < nk_) ? lp_[(size_t)i_ * 16] : 0.f; \
                    _Pragma("unroll") for (int i_ = 1; i_ < 8; ++i_) v_[i_] += v_[i_ - 1]; \
                    float incl_ = v_[7]; _Pragma("unroll") for (int o_ = 1; o_ < 64; o_ <<= 1) { const float t_ = __shfl_up(incl_, o_); if (lane >= o_) incl_ += t_; } \
                    if (lane == 63) wtot[wave] = incl_; __syncthreads(); \
                    float off_ = incl_ - v_[7]; for (int w_ = 0; w_ < wave; ++w_) off_ += wtot[w_]; \
                    if (s0_ < nk_) { _Pragma("unroll") for (int i_ = 0; i_ < 8; ++i_) tb_[s0_ + i_] = off_ + v_[i_]; } __syncthreads(); \
                    const float cref_ = tb_[x_ * QB]; __syncthreads(); \
                    if (s0_ < nk_) { _Pragma("unroll") for (int i_ = 0; i_ < 8; ++i_) tb_[s0_ + i_] = (cref_ - tb_[s0_ + i_]) * RS; } __syncthreads(); } } while (0)
#define FOX_NSUM(t_, bh_) (__builtin_bit_cast(float, __hip_atomic_load((unsigned*)(ctl + CW_NORM) + ((t_) * 64 + (bh_)) * 4 + 0, RLX_AGENT)) + __builtin_bit_cast(float, __hip_atomic_load((unsigned*)(ctl + CW_NORM) + ((t_) * 64 + (bh_)) * 4 + 1, RLX_AGENT)) + \
                           __builtin_bit_cast(float, __hip_atomic_load((unsigned*)(ctl + CW_NORM) + ((t_) * 64 + (bh_)) * 4 + 2, RLX_AGENT)) + __builtin_bit_cast(float, __hip_atomic_load((unsigned*)(ctl + CW_NORM) + ((t_) * 64 + (bh_)) * 4 + 3, RLX_AGENT)))
#define FOX_U2(bh_) (2.02f * SCALE * sqrtf(FOX_NSUM(0, bh_) * FOX_NSUM(1, bh_)))
#define FOX_JLO(slot_, qb_, u2_) ([&]() { const float* tb_ = (const float*)(fl + LDS_BIAS + (slot_) * 16384); const int p0_ = (qb_) * QB, nd_ = p0_ / KVBLK; const float bq_ = tb_[p0_]; bool keep_ = true; \
                if (lane < nd_) keep_ = ((tb_[KVBLK * lane + KVBLK - 1] - bq_) * (1.f / RS) + (u2_) > -104.f); return (int)__builtin_amdgcn_readfirstlane((int)__builtin_ctzll(__ballot(keep_))); }())
#define FOX_REF(bh_, qb_, slot_) BlockRef<bf16, bf16>{ Qa + ((size_t)((bh_) >> 4) * SEQ + (size_t)(qb_) * QB) * PITCH + ((bh_) & 15) * D, Ka + ((size_t)((bh_) >> 4) * SEQ) * PITCH + ((bh_) & 15) * D, \
                                               Va + ((size_t)((bh_) >> 4) * SEQ) * PITCH + ((bh_) & 15) * D, OA + ((size_t)((bh_) >> 4) * SEQ + (size_t)(qb_) * QB) * PITCH + ((bh_) & 15) * D, (qb_) * QB, \
                                               FOX_JLO(slot_, qb_, FOX_U2(bh_)), LDS_BIAS + (slot_) * 16384 }
                int bh = Lc / NX, xx = Lc % NX, pass = 0, slot = 0;
                FOX_TABLE(0, Lc); FOX_TABLE(1, Lc + G);
                BlockRef<bf16, bf16> cur = FOX_REF(bh, xx, 0);
                Seam<bf16> S;
                causal_swa_prime<bf16, bf16>(cur, W, fl, S);
                for (;;) {
                    const bool more_pass = pass == 0, more_item = Lc + G < TOTAL, last = !more_pass && !more_item;
                    int bhn = bh, xxn = xx, passn = pass + 1, Ln = Lc, slotn = slot;
                    if (!more_pass) { passn = 0; Ln = more_item ? Lc + G : Lc; bhn = Ln / NX; xxn = Ln % NX; slotn = slot ^ 1; }
                    const int qbn = passn ? 15 - xxn : xxn;
                    const BlockRef<bf16, bf16> nxt = last ? cur : FOX_REF(bhn, qbn, slotn);
                    causal_swa_block<bf16, bf16>(cur, nxt, SEQ, W, fl, S);
                    if (last) break;
                    if (passn == 0) FOX_TABLE(slot, Lc + 2 * G);
                    cur = nxt; bh = bhn; xx = xxn; pass = passn; Lc = Ln; slot = slotn;
                }
#undef FOX_REF
#undef FOX_TABLE
#undef FOX_NSUM
#undef FOX_JLO
#undef FOX_U2
            }
        }
#endif
        VM_WAIT(); __syncthreads();
#ifndef NO_SWA
        if (!dummy) {
            const swa::Tensors T{Q4 + (size_t)3 * M * 2048, KBt, VBt, OB, args.in[4], args.in[5]};
#ifdef PROBE_SWA_REP
#ifdef PROBE_SWA_MODE
            for (int u_ = vcu; u_ < BATCH * HKV_B * 32 * (PROBE_SWA_REP - 1); u_ += G) { const int u = u_ & 511; swa::swa_unit<PROBE_SWA_MODE>((char*)lds + RING_OFF, T, u >> 7, (u >> 5) & 3, u & 31); }
            for (int u = vcu; u < BATCH * HKV_B * 32; u += G) swa::swa_unit((char*)lds + RING_OFF, T, u >> 7, (u >> 5) & 3, u & 31);
#else
            for (int u_ = vcu; u_ < BATCH * HKV_B * 32 * PROBE_SWA_REP; u_ += G) { const int u = u_ & 511; swa::swa_unit((char*)lds + RING_OFF, T, u >> 7, (u >> 5) & 3, u & 31); }
#endif
#else
            for (int u = vcu; u < BATCH * HKV_B * 32; u += G) swa::swa_unit((char*)lds + RING_OFF, T, u >> 7, (u >> 5) & 3, u & 31);
#endif
        }
#endif
        if (BOTH(4)) GRID_BAR();
    }

    if (IN(5)) {
        pg8::Gemm g{OA, WA, M, DM, 2048, OB, WB}; pg8::SQ_DUAL S; S.init(M, DM, G, bx); pg8::EpiMix E{SGA, SGB, MIXED};
        pg8::gemm_phase<pg8::EpiMix, pg8::SQ_DUAL, PG_ALIGN, PG_SP2>(L + RING_OFF, g, S, E);
        if (BOTH(5)) GRID_BAR();
    }

    if (IN(6)) {
#if defined(PROBE_DUP) && defined(PROBE_P5_NULL)
        if (dummy) { pg8::Gemm g{MIXED, WO, M, DM, DM, nullptr, nullptr}; pg8::EpiNull E{HID};
#if defined(PROBE_P5_HOT)
            pg8::HotOrder S; S.init(M, DM, G, bx); pg8::gemm_phase<pg8::EpiNull, pg8::HotOrder, PG_ALIGN, PG_SP2>(L + RING_OFF, g, S, E);
#else
            pg8::StaticOrder S; S.init(M, DM, G, bx); pg8::gemm_phase<pg8::EpiNull, pg8::StaticOrder, PG_ALIGN, PG_SP2>(L + RING_OFF, g, S, E);
#endif
        } else {
#endif
        pg8::Gemm g{MIXED, WO, M, DM, DM, nullptr, nullptr}; pg8::SQ_ORDER S; S.init(M, DM, G, bx); pg8::EpiOutX1 E{XB, dummy ? HID : X1B};
        pg8::gemm_phase<pg8::EpiOutX1, pg8::SQ_ORDER, PG_ALIGN, PG_SP2>(L + RING_OFF, g, S, E);
#if defined(PROBE_DUP) && defined(PROBE_P5_NULL)
        }
#endif
        if (BOTH(6)) GRID_BAR();
    }

    if (IN(7)) {
#if defined(PROBE_DUP) && defined(PROBE_MFMA_CLOCK)
        if (dummy) {
            typedef short b8 __attribute__((ext_vector_type(8)));
            b8 a = {(short)(0x3f80 + lane), 0x3f80, 0x3f81, 0x3f82, 0x3f83, 0x3f84, 0x3f85, 0x3f86}, b = {0x3f80, (short)(0x3f80 + wave), 0x3f81, 0x3f82, 0x3f83, 0x3f84, 0x3f85, 0x3f86};
            f32x4 c[16];
#pragma unroll
            for (int i = 0; i < 16; ++i) c[i] = (f32x4){0.f, 0.f, 0.f, 0.f};
            for (int it = 0; it < PROBE_MFMA_CLOCK; ++it) {
#pragma unroll
                for (int i = 0; i < 16; ++i) c[i] = __builtin_amdgcn_mfma_f32_16x16x32_bf16(a, b, c[i], 0, 0, 0);
            }
            f32x4 s = c[0];
#pragma unroll
            for (int i = 1; i < 16; ++i) s = s + c[i];
            if (s[0] == 12345.678f) ((float*)HID)[tid] = s[1] + s[2] + s[3];
        } else
#endif
        {
            v4u p[8];
            if (gw < M) { const GAS v4u* src = (const GAS v4u*)(X1B + (size_t)gw * DM) + 2 * lane;
#pragma unroll
                for (int j = 0; j < 4; ++j) { p[2 * j] = src[128 * j]; p[2 * j + 1] = src[128 * j + 1]; } }
            for (int m = gw; m < M; m += NGW) {
                v4u pn[8];
                if (m + NGW < M) { const GAS v4u* src = (const GAS v4u*)(X1B + (size_t)(m + NGW) * DM) + 2 * lane;
#pragma unroll
                    for (int j = 0; j < 4; ++j) { pn[2 * j] = src[128 * j]; pn[2 * j + 1] = src[128 * j + 1]; } }
                float s = 0.f, amx = 0.f;
#pragma unroll
                for (int j = 0; j < 8; ++j) {
#pragma unroll
                    for (int e = 0; e < 4; ++e) { const float a = pg8::bf_lo(p[j][e]), b = pg8::bf_hi(p[j][e]); s += a * a + b * b; amx = fmaxf(amx, fmaxf(fabsf(a), fabsf(b))); } }
                s = wave_sum(s);
#pragma unroll
                for (int o = 1; o < 64; o <<= 1) amx = fmaxf(amx, __shfl_xor(amx, o));
                const float rs2 = 1.f / sqrtf(s * (1.f / DM) + EPS), sc = amx > 0.f ? 127.f / amx : 0.f;
                if (lane == 0) { RSTD2[m] = rs2; SA[m] = rs2 * amx * (1.f / 127.f); }
                GAS v4u* dst = (GAS v4u*)(X1Q + (size_t)m * DM) + lane;
#pragma unroll
                for (int j = 0; j < 4; ++j) dst[64 * j] = q16(p[2 * j], p[2 * j + 1], sc);
#pragma unroll
                for (int j = 0; j < 8; ++j) p[j] = pn[j];
            }
        }
        {
            const unsigned* cm = (const unsigned*)(ctl + CW_CMAX);
            constexpr int NQ = FFN_I8 ? FFN_I8_TILES * 256 : 0;
            v4u p[8];
            if (gw < NQ) { const GAS v4u* src = (const GAS v4u*)(WGU + (size_t)gw * DM) + 2 * lane;
#pragma unroll
                for (int j = 0; j < 4; ++j) { p[2 * j] = src[128 * j]; p[2 * j + 1] = src[128 * j + 1]; } }
            for (int n = gw; n < NQ; n += NGW) {
                v4u pn[8];
                if (n + NGW < NQ) { const GAS v4u* src = (const GAS v4u*)(WGU + (size_t)(n + NGW) * DM) + 2 * lane;
#pragma unroll
                    for (int j = 0; j < 4; ++j) { pn[2 * j] = src[128 * j]; pn[2 * j + 1] = src[128 * j + 1]; } }
                const float mxv = __builtin_bit_cast(float, __hip_atomic_load(cm + n, RLX_AGENT)); const float sc = mxv > 0.f ? 127.f / mxv : 0.f;
                GAS v4u* dst = (GAS v4u*)(WGQ + (size_t)n * DM) + lane;
#pragma unroll
                for (int j = 0; j < 4; ++j) dst[64 * j] = q16(p[2 * j], p[2 * j + 1], sc);
#pragma unroll
                for (int j = 0; j < 8; ++j) p[j] = pn[j];
            }
        }
        if (BOTH(7)) GRID_BAR();
    }

    if (IN(8)) {
#if FFN_I8
        {
            pg8::Gemm g8{(const bf16*)X1Q, (const bf16*)WGQ, M, FFN_I8_TILES * 256, DM, nullptr, nullptr}; pg8::StaticOrder S; S.init(M, FFN_I8_TILES * 256, G, bx);
#if defined(PROBE_DUP) && defined(PROBE_NULL8)
            if (dummy) { pg8::EpiNull8 E{HID}; pg8::gemm_phase<pg8::EpiNull8, pg8::StaticOrder, PG_ALIGN, PG_SP2>(L + RING_OFF, g8, S, E); } else
#endif
            { pg8::EpiSwiGLU8 E{SA, (const unsigned*)(ctl + CW_CMAX), HID};
            pg8::gemm_phase<pg8::EpiSwiGLU8, pg8::StaticOrder, PG_ALIGN, PG_SP2>(L + RING_OFF, g8, S, E); } }
        if (FFN_I8_TILES < 86 && !(PROBE8_SKIP_BF16 && dummy)) {
            VM_WAIT(); __syncthreads();
            pg8::Gemm g{X1B, WGU + (size_t)FFN_I8_TILES * 256 * DM, M, (86 - FFN_I8_TILES) * 256, DM, nullptr, nullptr}; pg8::StaticOrder S; S.init(M, (86 - FFN_I8_TILES) * 256, G, bx);
            pg8::EpiSwiGLU E{RSTD2, HID, FFN_I8_TILES};
            pg8::gemm_phase<pg8::EpiSwiGLU, pg8::StaticOrder, PG_ALIGN, PG_SP2>(L + RING_OFF, g, S, E); }
#else
        { pg8::Gemm g{X1B, WGU, M, 2 * D_FF, DM, nullptr, nullptr}; pg8::StaticOrder S; S.init(M, 2 * D_FF, G, bx); pg8::EpiSwiGLU E{RSTD2, HID, 0};
          pg8::gemm_phase<pg8::EpiSwiGLU, pg8::StaticOrder, PG_ALIGN, PG_SP2>(L + RING_OFF, g, S, E); }
#endif
        if (BOTH(8)) GRID_BAR();
    }

    if (IN(9)) {
#if defined(PROBE_DUP) && defined(PROBE_P8_HOT)
        if (dummy) { pg8::Gemm g{HID, WD, M, DM, D_FF, nullptr, nullptr}; pg8::HotOrder S; S.init(M, DM, G, bx); pg8::EpiDownX2 E{X1B, MIXED};
            pg8::gemm_phase<pg8::EpiDownX2, pg8::HotOrder, PG_ALIGN, PG_SP2>(L + RING_OFF, g, S, E); } else
#endif
        { pg8::Gemm g{HID, WD, M, DM, D_FF, nullptr, nullptr}; pg8::SQ_ORDER S; S.init(M, DM, G, bx); pg8::EpiDownX2 E{X1B, dummy ? MIXED : X1B};
        pg8::gemm_phase<pg8::EpiDownX2, pg8::SQ_ORDER, PG_ALIGN, PG_SP2>(L + RING_OFF, g, S, E); }
        if (BOTH(9)) GRID_BAR();
    }

    if (IN(10)) {
        const float* fg = args.in[13];
        for (int m = gw; m < M; m += 2 * NGW) {
            const GAS v4u* xr0 = (const GAS v4u*)(X1B + (size_t)m * DM) + lane; const GAS v4u* xr1 = xr0 + (size_t)NGW * (DM / 8);
            float* ob = dummy ? (float*)HID : out;
            GAS f32x4* or0 = (GAS f32x4*)(ob + (size_t)m * DM) + 2 * lane; GAS f32x4* or1 = or0 + (size_t)NGW * (DM / 4); const GAS f32x4* gr = (const GAS f32x4*)fg + 2 * lane;
            v4u p[8], q[8]; float s0 = 0.f, s1 = 0.f;
#pragma unroll
            for (int j = 0; j < 8; ++j) { p[j] = xr0[64 * j]; q[j] = xr1[64 * j]; }
#pragma unroll
            for (int j = 0; j < 8; ++j) {
#pragma unroll
                for (int e = 0; e < 4; ++e) { const float a = pg8::bf_lo(p[j][e]), b = pg8::bf_hi(p[j][e]), c = pg8::bf_lo(q[j][e]), d = pg8::bf_hi(q[j][e]); s0 += a * a + b * b; s1 += c * c + d * d; } }
            s0 = wave_sum(s0); s1 = wave_sum(s1);
            const float rs0 = 1.f / sqrtf(s0 * (1.f / DM) + EPS), rs1 = 1.f / sqrtf(s1 * (1.f / DM) + EPS);
#pragma unroll
            for (int j = 0; j < 8; ++j) { const f32x4 g0 = gr[128 * j], g1 = gr[128 * j + 1];
                const f32x4 a0 = {pg8::bf_lo(p[j].x), pg8::bf_hi(p[j].x), pg8::bf_lo(p[j].y), pg8::bf_hi(p[j].y)}, a1 = {pg8::bf_lo(p[j].z), pg8::bf_hi(p[j].z), pg8::bf_lo(p[j].w), pg8::bf_hi(p[j].w)};
                const f32x4 b0 = {pg8::bf_lo(q[j].x), pg8::bf_hi(q[j].x), pg8::bf_lo(q[j].y), pg8::bf_hi(q[j].y)}, b1 = {pg8::bf_lo(q[j].z), pg8::bf_hi(q[j].z), pg8::bf_lo(q[j].w), pg8::bf_hi(q[j].w)};
                or0[128 * j] = a0 * rs0 * g0; or0[128 * j + 1] = a1 * rs0 * g1; or1[128 * j] = b0 * rs1 * g0; or1[128 * j + 1] = b1 * rs1 * g1; }
        }
    }
#undef IN
#undef BOTH
#undef GRID_BAR
}

extern "C" void kernel_launch(void* const* d_in, const int* in_sizes, int n_in, void* d_out, int out_size, void* d_ws, size_t ws_size, hipStream_t stream) {
    static int grid = 0;
    if (grid == 0) {
        if (n_in != 14 || in_sizes[0] != M * DM || out_size != M * DM || ws_size < WS_END) {
            fprintf(stderr, "kernel_launch: built for 14 inputs, x/out of %d floats, >= %zu bytes of workspace; got n_in %d, in0 %d, out %d, ws %zu; nothing launched\n", M * DM, (size_t)WS_END, n_in, n_in > 0 ? in_sizes[0] : -1, out_size, ws_size);
            grid = -1; return; }
        int dev = 0, cus = 0, per_cu = 0;
        if (hipGetDevice(&dev) != hipSuccess || hipDeviceGetAttribute(&cus, hipDeviceAttributeMultiprocessorCount, dev) != hipSuccess) { fprintf(stderr, "kernel_launch: device query failed\n"); grid = -1; return; }
        if (hipFuncSetAttribute((const void*)hybrid_fwd, hipFuncAttributeMaxDynamicSharedMemorySize, LDS_BYTES) != hipSuccess) { fprintf(stderr, "kernel_launch: hipFuncSetAttribute failed\n"); grid = -1; return; }
        if (hipOccupancyMaxActiveBlocksPerMultiprocessor(&per_cu, (const void*)hybrid_fwd, NWAVES * 64, LDS_BYTES) != hipSuccess || per_cu < 1)
            fprintf(stderr, "kernel_launch: note: occupancy query reports %d workgroups per CU\n", per_cu);
        (void)hipGetLastError();
        grid = cus;
    }
    if (grid < 0) return;
    if (hipMemsetAsync((char*)d_ws + WS_CTL, 0, CTL_ZERO_BYTES, stream) != hipSuccess) { fprintf(stderr, "kernel_launch: hipMemsetAsync failed\n"); return; }
    Args a{};
    for (int i = 0; i < 14; ++i) a.in[i] = (const float*)d_in[i];
    a.out = (float*)d_out; a.ws = (unsigned char*)d_ws;
    for (int li = 0; li < N_LAUNCHES; ++li) {
        a.ph_lo = (N_LAUNCHES == PER_PHASE) ? li : 0; a.ph_hi = (N_LAUNCHES == PER_PHASE) ? li + 1 : PER_PHASE; a.li = li; a.pad = 0;
#ifdef PROBE_DUP
        if (N_LAUNCHES == PER_PHASE && ((PROBE_DUP >> li) & 1)) { a.pad = 1; hipLaunchKernelGGL(hybrid_fwd, dim3(grid), dim3(NWAVES * 64), LDS_BYTES, stream, a); a.pad = 0; }
#endif
        hipLaunchKernelGGL(hybrid_fwd, dim3(grid), dim3(NWAVES * 64), LDS_BYTES, stream, a);
        const hipError_t le = hipPeekAtLastError();
        if (le != hipSuccess) { fprintf(stderr, "kernel_launch: launch %d failed: %s\n", li, hipGetErrorName(le)); break; }
    }
}
```

```cpp
#include <hip/hip_runtime.h>
#include <cstdio>
#include <cstdint>

namespace pg8 {
#define PG8_LAS __attribute__((address_space(3)))
typedef unsigned short bf16_t;
typedef short bf16x8 __attribute__((ext_vector_type(8)));
typedef float f32x4 __attribute__((ext_vector_type(4)));
typedef unsigned u32x4 __attribute__((ext_vector_type(4)));
typedef int i32x4 __attribute__((ext_vector_type(4)));
constexpr int BM = 256, BK = 64, HALF = 128, HTB = HALF * BK * 2  , STAGE_BYTES = 8 * HTB, NXCD = 8, WGM = 8;

__host__ __device__ __forceinline__ int lds_byte(int r, int c) { const int st = (r >> 4) * 2 + (c >> 5), rr = r & 15, cc = c & 31, ob = rr * 64 + cc * 2; return st * 1024 + (ob ^ (((ob >> 9) & 1) << 5)); }
__host__ __device__ __forceinline__ void stage_rc(int b, int& R, int& C) { const int st = b / 1024, sb = b % 1024, swz = sb ^ (((sb >> 9) & 1) << 5); R = (st >> 1) * 16 + swz / 64; C = (st & 1) * 32 + (swz % 64) / 2; }
__host__ __device__ __forceinline__ int perm32(int rho) { const int n = rho >> 4, i = rho & 15; return 8 * (i >> 2) + 4 * n + (i & 3); }

struct Unit { int pm, pn, src; };
struct Gemm { const bf16_t* A; const bf16_t* Bt; int M, N, K; const bf16_t* A2; const bf16_t* Bt2; };

struct StaticOrder {
    int nM, nN, nwg, G, c;
    __host__ __device__ void init(int M, int N, int G_, int c_) { nM = M / BM; nN = N / BM; nwg = nM * nN; G = G_; c = c_; }
    __host__ __device__ bool next(int i, Unit& u) const {
        const long L = (long)i * G + c; if (L >= nwg) return false;
        int wgid = (int)L; { const int q = nwg / NXCD, r = nwg % NXCD, xcd = wgid % NXCD, off = wgid / NXCD; wgid = (xcd < r ? xcd * (q + 1) : r * (q + 1) + (xcd - r) * q) + off; }
        const int nig = WGM * nN, gid = wgid / nig, fm = gid * WGM, gsz = (nM - fm) < WGM ? (nM - fm) : WGM;
        u.pm = fm + ((wgid % nig) % gsz); u.pn = (wgid % nig) / gsz; u.src = 0; return true;
    }
    __device__ __forceinline__ void a_ready(const Unit&) const {}
    __device__ __forceinline__ void done(const Unit&) const {}
};
struct TailOrder : StaticOrder {
    int nfull, c0;
    __host__ __device__ bool next(int i, Unit& u) const {
        long L;
        if (i < nfull) L = (long)i * G + c; else { if (c < c0) return false; L = (long)nfull * G + (long)(i - nfull) * (G - c0) + (c - c0); }
        if (L >= nwg) return false;
        int wgid = (int)L; { const int q = nwg / NXCD, r = nwg % NXCD, xcd = wgid % NXCD, off = wgid / NXCD; wgid = (xcd < r ? xcd * (q + 1) : r * (q + 1) + (xcd - r) * q) + off; }
        const int nig = WGM * nN, gid = wgid / nig, fm = gid * WGM, gsz = (nM - fm) < WGM ? (nM - fm) : WGM;
        u.pm = fm + ((wgid % nig) % gsz); u.pn = (wgid % nig) / gsz; u.src = 0; return true;
    }
};
struct SquareOrder : StaticOrder {
    __host__ __device__ bool next(int i, Unit& u) const {
        if (G != 256 || nM != 64 || nN != 16) return StaticOrder::next(i, u);
        if (i >= 4) return false;
        const int k = c & 7, s = c >> 3; u.pm = 16 * i + 8 * (k & 1) + (s & 7); u.pn = 4 * (k >> 1) + (s >> 3); u.src = 0; return true;
    }
};
#ifndef SQ_ORDER
#define SQ_ORDER SquareOrder
#define SQ_DUAL DualSquare
#endif
struct DualSquare : SquareOrder {
    __host__ __device__ bool next(int i, Unit& u) const { const bool ok = SquareOrder::next(i >> 1, u); u.src = i & 1; return ok; }
};
struct DualOrder : StaticOrder {
    __host__ __device__ bool next(int i, Unit& u) const { const bool ok = StaticOrder::next(i >> 1, u); u.src = i & 1; return ok; }
};

struct HotOrder : StaticOrder {
    __host__ __device__ bool next(int i, Unit& u) const { const bool ok = StaticOrder::next(i, u); u.pm = c & 7; u.pn = 0; return ok; }
};
__device__ __forceinline__ f32x4 mma16(bf16x8 a, bf16x8 b, f32x4 c) { return __builtin_amdgcn_mfma_f32_16x16x32_bf16(a, b, c, 0, 0, 0); }
__device__ __forceinline__ i32x4 mma16(bf16x8 a, bf16x8 b, i32x4 c) { return __builtin_amdgcn_mfma_i32_16x16x64_i8(__builtin_bit_cast(i32x4, a), __builtin_bit_cast(i32x4, b), c, 0, 0, 0); }
typedef float f32x2_t __attribute__((ext_vector_type(2)));
typedef __bf16 bf16x2_t __attribute__((ext_vector_type(2)));
__device__ __forceinline__ unsigned cvt_pk_bf16(float lo, float hi) { const f32x2_t v = {lo, hi}; const bf16x2_t b = __builtin_convertvector(v, bf16x2_t); return __builtin_bit_cast(unsigned, b); }
__device__ __forceinline__ float bf_lo(unsigned w) { return __builtin_bit_cast(float, w << 16); }
__device__ __forceinline__ float bf_hi(unsigned w) { return __builtin_bit_cast(float, w & 0xffff0000u); }
__device__ __forceinline__ float sigmoid_f(float x) { return __builtin_amdgcn_rcpf(1.f + __builtin_amdgcn_exp2f(-1.4426950408889634f * x)); }
__device__ __forceinline__ u32x4 pack8(f32x4 v0, f32x4 v1) { u32x4 w; w.x = cvt_pk_bf16(v0[0], v0[1]); w.y = cvt_pk_bf16(v0[2], v0[3]); w.z = cvt_pk_bf16(v1[0], v1[1]); w.w = cvt_pk_bf16(v1[2], v1[3]); return w; }

constexpr int IN_TILES = 25;
constexpr int INQ_TILES = 42;
struct EpiInProj {
    static constexpr bool PERM = true, AFTER_DRAIN = false, DUAL = false, I8 = false; typedef f32x4 acc_t;
    const float* rstd; bf16_t* q4;   float* lf; const float* bfor; unsigned* nrm;
    __device__ __forceinline__ void operator()(const f32x4 (&acc)[2][2][4][2], const Unit& u, int wr, int wc, int fr, int fq) const {
        const int row0 = u.pm * BM + wr * 64 + fr; const int pn = u.pn;
        float rs[2][4];
        if (pn == 24) {
            if (wc == 0 && fq < 2) {
#pragma unroll
                for (int ai = 0; ai < 2; ++ai)
#pragma unroll
                    for (int m = 0; m < 4; ++m) rs[ai][m] = rstd[row0 + ai * HALF + m * 16];
                const f32x4 b0 = *(const f32x4*)(bfor + 8 * fq), b1 = *(const f32x4*)(bfor + 8 * fq + 4);
#pragma unroll
                for (int ai = 0; ai < 2; ++ai)
#pragma unroll
                    for (int m = 0; m < 4; ++m) { const int row = row0 + ai * HALF + m * 16;
#pragma unroll
                        for (int n = 0; n < 2; ++n) { const f32x4 v = acc[ai][0][m][n] * rs[ai][m]; const f32x4 b = n ? b1 : b0; f32x4 o;
#pragma unroll
                            for (int j = 0; j < 4; ++j) { const float z = v[j] + b[j]; o[j] = fminf(z, 0.f) - log1pf(expf(-fabsf(z))); }
                            *(f32x4*)(lf + (size_t)row * 16 + 8 * fq + 4 * n) = o; } }
            }
            return;
        }
#pragma unroll
        for (int ai = 0; ai < 2; ++ai)
#pragma unroll
            for (int m = 0; m < 4; ++m) rs[ai][m] = rstd[row0 + ai * HALF + m * 16];
        bf16_t* base = q4 + (size_t)(pn >> 3) * ((size_t)16384 * 2048);
        const int col0 = (pn & 7) * BM + wc * 32 + 8 * fq;
        float mxh[2] = {0.f, 0.f};
#pragma unroll
        for (int ai = 0; ai < 2; ++ai)
#pragma unroll
            for (int m = 0; m < 4; ++m) { const int row = row0 + ai * HALF + m * 16; const float r = rs[ai][m]; bf16_t* rowp = base + (size_t)row * 2048 + col0;
#pragma unroll
                for (int bj = 0; bj < 2; ++bj) { const f32x4 v0 = acc[ai][bj][m][0] * r, v1 = acc[ai][bj][m][1] * r; *(u32x4*)(rowp + bj * HALF) = pack8(v0, v1);
                    if (pn < 16) { float ss = (v0[0] * v0[0] + v0[1] * v0[1]) + (v0[2] * v0[2] + v0[3] * v0[3]) + (v1[0] * v1[0] + v1[1] * v1[1]) + (v1[2] * v1[2] + v1[3] * v1[3]);
                        ss += __shfl_xor(ss, 16); ss += __shfl_xor(ss, 32); mxh[bj] = fmaxf(mxh[bj], ss); } } }
        if (pn < 16) {
#pragma unroll
            for (int bj = 0; bj < 2; ++bj) { float v = mxh[bj]; v = fmaxf(v, __shfl_xor(v, 1)); v = fmaxf(v, __shfl_xor(v, 2)); v = fmaxf(v, __shfl_xor(v, 4)); v = fmaxf(v, __shfl_xor(v, 8));
                if (fr == 0 && fq == 0) (void)__hip_atomic_fetch_max(nrm + (((pn >> 3) * 64 + (u.pm >> 4) * 16 + 2 * (pn & 7) + bj) * 4 + wc), __builtin_bit_cast(unsigned, v), __ATOMIC_RELAXED, __HIP_MEMORY_SCOPE_AGENT); }
        }
    }
};
template <size_t OQB, size_t OKB, size_t OVB>
struct EpiGates8 {
    static constexpr bool PERM = true, AFTER_DRAIN = false, DUAL = false, I8 = true; typedef i32x4 acc_t;
    const float* sx; const unsigned* cmax; unsigned char* wsb; bf16_t* gr; bf16_t* gs;
    __device__ __forceinline__ void operator()(const i32x4 (&acc)[2][2][4][2], const Unit& u, int wr, int wc, int fr, int fq) const {
        const int row0 = u.pm * BM + wr * 64 + fr, cl = wc * 32 + 8 * fq; const int pn = u.pn;
        float rs[2][4];
#pragma unroll
        for (int ai = 0; ai < 2; ++ai)
#pragma unroll
            for (int m = 0; m < 4; ++m) rs[ai][m] = sx[row0 + ai * HALF + m * 16];
        f32x4 sc[2][2];
#pragma unroll
        for (int bj = 0; bj < 2; ++bj) { const f32x4* c = (const f32x4*)(cmax + pn * BM + bj * HALF + cl); sc[bj][0] = c[0] * (1.f / 127.f); sc[bj][1] = c[1] * (1.f / 127.f); }
        if (pn >= 10) {
            const int col0 = (pn - 10) * HALF + cl; const float T = 9.094947017729282e-13f;
#pragma unroll
            for (int ai = 0; ai < 2; ++ai)
#pragma unroll
                for (int m = 0; m < 4; ++m) { const size_t off = (size_t)(row0 + ai * HALF + m * 16) * 4096 + col0; const float r = rs[ai][m]; f32x4 r0, r1, s0, s1;
#pragma unroll
                    for (int j = 0; j < 4; ++j) {
                        const float a0 = sigmoid_f((float)acc[ai][0][m][0][j] * (r * sc[0][0][j])), a1 = sigmoid_f((float)acc[ai][0][m][1][j] * (r * sc[0][1][j]));
                        s0[j] = fmaxf(sigmoid_f((float)acc[ai][1][m][0][j] * (r * sc[1][0][j])), T); s1[j] = fmaxf(sigmoid_f((float)acc[ai][1][m][1][j] * (r * sc[1][1][j])), T);
                        r0[j] = a0 * __builtin_amdgcn_rcpf(s0[j]); r1[j] = a1 * __builtin_amdgcn_rcpf(s1[j]); }
                    *(u32x4*)(gr + off) = pack8(r0, r1); *(u32x4*)(gs + off) = pack8(s0, s1);
                    __builtin_amdgcn_sched_barrier(0); }
            return;
        }
        size_t boff = OQB; int ldc = 2048, colt = pn * BM;
        if (pn == 8) boff = OKB; if (pn == 9) boff = OVB; if (pn >= 8) { ldc = 256; colt = 0; }
        bf16_t* base = (bf16_t*)(wsb + boff);
        const int col0 = colt + cl;
#pragma unroll
        for (int ai = 0; ai < 2; ++ai)
#pragma unroll
            for (int m = 0; m < 4; ++m) { const int row = row0 + ai * HALF + m * 16; const float r = rs[ai][m]; bf16_t* rowp = base + (size_t)row * ldc + col0;
#pragma unroll
                for (int bj = 0; bj < 2; ++bj) { f32x4 v0, v1;
#pragma unroll
                    for (int j = 0; j < 4; ++j) { v0[j] = (float)acc[ai][bj][m][0][j] * (r * sc[bj][0][j]); v1[j] = (float)acc[ai][bj][m][1][j] * (r * sc[bj][1][j]); }
                    *(u32x4*)(rowp + bj * HALF) = pack8(v0, v1); } }
    }
};
struct EpiMix {
    static constexpr bool PERM = true, AFTER_DRAIN = false, DUAL = true, I8 = false; typedef f32x4 acc_t;
    const bf16_t* gr; const bf16_t* gs; bf16_t* mixed;
    template <bool FINAL> __device__ __forceinline__ void run(f32x4 (&acc)[2][2][4][2], const Unit& u, int wr, int wc, int fr, int fq) const {
        const int row0 = u.pm * BM + wr * 64 + fr, col0 = u.pn * BM + wc * 32 + 8 * fq; const bf16_t* g = FINAL ? gs : gr;
        u32x4 b[2], bn[2];
        { const size_t off = (size_t)row0 * 4096 + col0; b[0] = *(const u32x4*)(g + off); b[1] = *(const u32x4*)(g + off + HALF); }
#pragma unroll
        for (int it = 0; it < 8; ++it) { const int ai = it >> 2, m = it & 3; const size_t off = (size_t)(row0 + ai * HALF + m * 16) * 4096 + col0;
            if (it + 1 < 8) { const size_t offn = (size_t)(row0 + ((it + 1) >> 2) * HALF + ((it + 1) & 3) * 16) * 4096 + col0; bn[0] = *(const u32x4*)(g + offn); bn[1] = *(const u32x4*)(g + offn + HALF); }
#pragma unroll
            for (int bj = 0; bj < 2; ++bj) { const u32x4 y = b[bj]; f32x4 v0 = acc[ai][bj][m][0], v1 = acc[ai][bj][m][1];
                v0[0] *= bf_lo(y.x); v0[1] *= bf_hi(y.x); v0[2] *= bf_lo(y.y); v0[3] *= bf_hi(y.y); v1[0] *= bf_lo(y.z); v1[1] *= bf_hi(y.z); v1[2] *= bf_lo(y.w); v1[3] *= bf_hi(y.w);
                if (FINAL) *(u32x4*)(mixed + off + bj * HALF) = pack8(v0, v1); else { acc[ai][bj][m][0] = v0; acc[ai][bj][m][1] = v1; } }
            b[0] = bn[0]; b[1] = bn[1]; }
    }
    __device__ __forceinline__ void mid(f32x4 (&acc)[2][2][4][2], const Unit& u, int wr, int wc, int fr, int fq) const { run<false>(acc, u, wr, wc, fr, fq); }
    __device__ __forceinline__ void operator()(f32x4 (&acc)[2][2][4][2], const Unit& u, int wr, int wc, int fr, int fq) const { run<true>(acc, u, wr, wc, fr, fq); }
};
struct EpiOutX1 {
    static constexpr bool PERM = true, AFTER_DRAIN = false, DUAL = false, I8 = false; typedef f32x4 acc_t;
    const bf16_t* res; bf16_t* cp;
    __device__ __forceinline__ void operator()(const f32x4 (&acc)[2][2][4][2], const Unit& u, int wr, int wc, int fr, int fq) const {
        const int row0 = u.pm * BM + wr * 64 + fr, col0 = u.pn * BM + wc * 32 + 8 * fq;
        u32x4 p[2], pn[2];
        { const size_t off = (size_t)row0 * 4096 + col0; p[0] = *(const u32x4*)(res + off); p[1] = *(const u32x4*)(res + off + HALF); }
#pragma unroll
        for (int it = 0; it < 8; ++it) { const int ai = it >> 2, m = it & 3; const size_t off = (size_t)(row0 + ai * HALF + m * 16) * 4096 + col0;
            if (it + 1 < 8) { const size_t offn = (size_t)(row0 + ((it + 1) >> 2) * HALF + ((it + 1) & 3) * 16) * 4096 + col0; pn[0] = *(const u32x4*)(res + offn); pn[1] = *(const u32x4*)(res + offn + HALF); }
#pragma unroll
            for (int bj = 0; bj < 2; ++bj) { const u32x4 q = p[bj]; f32x4 v0 = acc[ai][bj][m][0], v1 = acc[ai][bj][m][1];
                v0[0] += bf_lo(q.x); v0[1] += bf_hi(q.x); v0[2] += bf_lo(q.y); v0[3] += bf_hi(q.y); v1[0] += bf_lo(q.z); v1[1] += bf_hi(q.z); v1[2] += bf_lo(q.w); v1[3] += bf_hi(q.w);
                *(u32x4*)(cp + off + bj * HALF) = pack8(v0, v1); }
            p[0] = pn[0]; p[1] = pn[1]; }
    }
};
struct EpiDownX2 {
    static constexpr bool PERM = true, AFTER_DRAIN = false, DUAL = false, I8 = false; typedef f32x4 acc_t;
    const bf16_t* xb; bf16_t* xo;
    __device__ __forceinline__ void operator()(const f32x4 (&acc)[2][2][4][2], const Unit& u, int wr, int wc, int fr, int fq) const {
        const int row0 = u.pm * BM + wr * 64 + fr, col0 = u.pn * BM + wc * 32 + 8 * fq;
        u32x4 p[2], pn[2];
        { const size_t off = (size_t)row0 * 4096 + col0; p[0] = *(const u32x4*)(xb + off); p[1] = *(const u32x4*)(xb + off + HALF); }
#pragma unroll
        for (int it = 0; it < 8; ++it) { const int ai = it >> 2, m = it & 3; const size_t off = (size_t)(row0 + ai * HALF + m * 16) * 4096 + col0;
            if (it + 1 < 8) { const size_t offn = (size_t)(row0 + ((it + 1) >> 2) * HALF + ((it + 1) & 3) * 16) * 4096 + col0; pn[0] = *(const u32x4*)(xb + offn); pn[1] = *(const u32x4*)(xb + offn + HALF); }
#pragma unroll
            for (int bj = 0; bj < 2; ++bj) { const u32x4 q = p[bj]; f32x4 v0 = acc[ai][bj][m][0], v1 = acc[ai][bj][m][1];
                v0[0] += bf_lo(q.x); v0[1] += bf_hi(q.x); v0[2] += bf_lo(q.y); v0[3] += bf_hi(q.y); v1[0] += bf_lo(q.z); v1[1] += bf_hi(q.z); v1[2] += bf_lo(q.w); v1[3] += bf_hi(q.w);
                *(u32x4*)(xo + off + bj * HALF) = pack8(v0, v1); }
            p[0] = pn[0]; p[1] = pn[1]; }
    }
};
struct EpiSwiGLU {
    static constexpr bool PERM = true, AFTER_DRAIN = false, DUAL = false, I8 = false; typedef f32x4 acc_t;
    const float* rstd; bf16_t* hid; int pn0;
    __device__ __forceinline__ void operator()(const f32x4 (&acc)[2][2][4][2], const Unit& u, int wr, int wc, int fr, int fq) const {
        const int row0 = u.pm * BM + wr * 64 + fr, col0 = (u.pn + pn0) * HALF + wc * 32 + 8 * fq;
        float rs[2][4];
#pragma unroll
        for (int ai = 0; ai < 2; ++ai)
#pragma unroll
            for (int m = 0; m < 4; ++m) rs[ai][m] = rstd[row0 + ai * HALF + m * 16];
#pragma unroll
        for (int ai = 0; ai < 2; ++ai)
#pragma unroll
            for (int m = 0; m < 4; ++m) { const int row = row0 + ai * HALF + m * 16; const float r = rs[ai][m];
                f32x4 h0, h1;
#pragma unroll
                for (int j = 0; j < 4; ++j) { const float g0 = acc[ai][0][m][0][j] * r, g1 = acc[ai][0][m][1][j] * r;
                    h0[j] = g0 * sigmoid_f(g0) * (acc[ai][1][m][0][j] * r); h1[j] = g1 * sigmoid_f(g1) * (acc[ai][1][m][1][j] * r); }
                *(u32x4*)(hid + (size_t)row * 11008 + col0) = pack8(h0, h1); }
    }
};

struct EpiSwiGLU8 {
    static constexpr bool PERM = true, AFTER_DRAIN = false, DUAL = false, I8 = true; typedef i32x4 acc_t;
    const float* sa; const unsigned* cmax; bf16_t* hid;
    __device__ __forceinline__ void operator()(const i32x4 (&acc)[2][2][4][2], const Unit& u, int wr, int wc, int fr, int fq) const {
        const int row0 = u.pm * BM + wr * 64 + fr, cl = wc * 32 + 8 * fq, col0 = u.pn * HALF + cl;
        float rs[2][4];
#pragma unroll
        for (int ai = 0; ai < 2; ++ai)
#pragma unroll
            for (int m = 0; m < 4; ++m) rs[ai][m] = sa[row0 + ai * HALF + m * 16];
        const f32x4* cg = (const f32x4*)(cmax + u.pn * BM + cl); const f32x4* cu = (const f32x4*)(cmax + u.pn * BM + HALF + cl);
        const f32x4 sg0 = cg[0] * (1.f / 127.f), sg1 = cg[1] * (1.f / 127.f), su0 = cu[0] * (1.f / 127.f), su1 = cu[1] * (1.f / 127.f);
#pragma unroll
        for (int ai = 0; ai < 2; ++ai)
#pragma unroll
            for (int m = 0; m < 4; ++m) { const int row = row0 + ai * HALF + m * 16; const float r = rs[ai][m];
                f32x4 h0, h1;
#pragma unroll
                for (int j = 0; j < 4; ++j) { const float g0 = (float)acc[ai][0][m][0][j] * (r * sg0[j]), g1 = (float)acc[ai][0][m][1][j] * (r * sg1[j]);
                    h0[j] = g0 * sigmoid_f(g0) * ((float)acc[ai][1][m][0][j] * (r * su0[j])); h1[j] = g1 * sigmoid_f(g1) * ((float)acc[ai][1][m][1][j] * (r * su1[j])); }
                *(u32x4*)(hid + (size_t)row * 11008 + col0) = pack8(h0, h1); }
    }
};

struct EpiNull8 {
    static constexpr bool PERM = true, AFTER_DRAIN = false, DUAL = false, I8 = true; typedef i32x4 acc_t;
    bf16_t* sink;
    __device__ __forceinline__ void operator()(const i32x4 (&acc)[2][2][4][2], const Unit& u, int wr, int wc, int fr, int fq) const {
        if (sink == nullptr) {
#pragma unroll
            for (int ai = 0; ai < 2; ++ai)
#pragma unroll
                for (int m = 0; m < 4; ++m)
#pragma unroll
                    for (int bj = 0; bj < 2; ++bj) *(i32x4*)((int*)nullptr + (size_t)(ai * 4 + m) * 4096 + bj * HALF + fr * 8 + fq * 1024 + u.pm) = acc[ai][bj][m][0] + acc[ai][bj][m][1]; }
    }
};

struct EpiNull {
    static constexpr bool PERM = true, AFTER_DRAIN = false, DUAL = false, I8 = false; typedef f32x4 acc_t;
    bf16_t* sink;
    __device__ __forceinline__ void operator()(const f32x4 (&acc)[2][2][4][2], const Unit& u, int wr, int wc, int fr, int fq) const {
        if (sink == nullptr) {
#pragma unroll
            for (int ai = 0; ai < 2; ++ai)
#pragma unroll
                for (int m = 0; m < 4; ++m)
#pragma unroll
                    for (int bj = 0; bj < 2; ++bj) *(u32x4*)((bf16_t*)nullptr + (size_t)(ai * 4 + m) * 4096 + bj * HALF + fr * 8 + fq * 1024 + u.pm) = pack8(acc[ai][bj][m][0], acc[ai][bj][m][1]); }
    }
};


template <class Epi, class Sched, bool ALIGN_EPI = false, bool SP2 = false>
__device__ __forceinline__ void gemm_phase(PG8_LAS unsigned char* lds, const Gemm g, const Sched& S, const Epi& E) {
    const int tid = threadIdx.x, wid = __builtin_amdgcn_readfirstlane(tid >> 6), lane = tid & 63, wr = wid >> 2, wc = wid & 3, fr = lane & 15, fq = lane >> 4;
    constexpr bool I8 = Epi::I8;
    typedef typename Epi::acc_t acc_t;
    const int pitchB = g.K * (I8 ? 1 : 2), nt = pitchB / (BK * 2);
    unsigned voffA[2], voffB[2];
#pragma unroll
    for (int i = 0; i < 2; ++i) { int R, C; stage_rc(tid * 16 + i * 8192, R, C); const int Rb = Epi::PERM ? ((R & ~31) + perm32(R & 31)) : R;
        voffA[i] = (unsigned)(R * pitchB + C * 2); voffB[i] = (unsigned)(Rb * pitchB + C * 2); }
    const size_t kstep = (size_t)(BK * 2);
    const size_t hstep = (size_t)HALF * pitchB;
    const size_t tstep = 2 * hstep;
    const unsigned ldsw = (unsigned)wid * 1024u;
    const int aoff = lds_byte(wr * 64 + fr, fq * 8), boff = lds_byte(wc * 32 + fr, fq * 8);
#define PG8_SA(b, h) (((b) * 2 + (h)) * HTB)
#define PG8_SB(b, h) ((4 + (b) * 2 + (h)) * HTB)
#define PG8_STAGE(bufoff, gbase, voff) do { _Pragma("unroll") for (int _i = 0; _i < 2; ++_i) \
        __builtin_amdgcn_global_load_lds((const unsigned*)((const char*)(gbase) + (voff)[_i]), (PG8_LAS unsigned*)(lds + (bufoff) + ldsw + _i * 8192), 16, 0, 0); } while (0)
#define PG8_LDA(dst, b, h) do { _Pragma("unroll") for (int m = 0; m < 4; ++m) _Pragma("unroll") for (int k = 0; k < 2; ++k) dst[m][k] = *(const PG8_LAS bf16x8*)(lds + PG8_SA(b, h) + aoff + m * 2048 + k * 1024); } while (0)
#define PG8_LDB(dst, b, h) do { _Pragma("unroll") for (int n = 0; n < 2; ++n) _Pragma("unroll") for (int k = 0; k < 2; ++k) dst[n][k] = *(const PG8_LAS bf16x8*)(lds + PG8_SB(b, h) + boff + n * 2048 + k * 1024); } while (0)
#define PG8_MMA(ai, bj, At, Bt) do { __builtin_amdgcn_s_setprio(1); _Pragma("unroll") for (int m = 0; m < 4; ++m) _Pragma("unroll") for (int n = 0; n < 2; ++n) _Pragma("unroll") for (int k = 0; k < 2; ++k) \
        acc[ai][bj][m][n] = mma16(Bt[n][k], At[m][k], acc[ai][bj][m][n]); __builtin_amdgcn_s_setprio(0); } while (0)
#define PG8_WAIT_V(n) asm volatile("s_waitcnt vmcnt(" #n ")" ::: "memory")
#define PG8_WAIT_L(n) asm volatile("s_waitcnt lgkmcnt(" #n ")" ::: "memory")
#define PG8_BAR __builtin_amdgcn_s_barrier()
#define PG8_SCHED __builtin_amdgcn_sched_barrier(0)
    Unit cur, nxt; int ui = 0;
    if (!S.next(0, cur)) return;
    acc_t acc[2][2][4][2];
#pragma unroll
    for (int a = 0; a < 2; ++a)
#pragma unroll
        for (int b = 0; b < 2; ++b)
#pragma unroll
            for (int m = 0; m < 4; ++m)
#pragma unroll
                for (int n = 0; n < 2; ++n) acc[a][b][m][n] = acc_t{};
    bf16x8 At[4][2], B0[2][2], B1[2][2];
    const char* cA = (const char*)(cur.src ? g.A2 : g.A) + (size_t)cur.pm * tstep; const char* cB = (const char*)(cur.src ? g.Bt2 : g.Bt) + (size_t)cur.pn * tstep;
    S.a_ready(cur);
    if constexpr (SP2) {
        PG8_STAGE(PG8_SB(0, 0), cB, voffB); PG8_STAGE(PG8_SB(0, 1), cB + hstep, voffB); PG8_STAGE(PG8_SA(0, 0), cA, voffA); PG8_STAGE(PG8_SA(0, 1), cA + hstep, voffA);
        if (wr == 1) PG8_BAR;
        PG8_WAIT_V(2); PG8_BAR;
        PG8_STAGE(PG8_SB(1, 0), cB + kstep, voffB); PG8_STAGE(PG8_SA(1, 0), cA + kstep, voffA); PG8_STAGE(PG8_SB(1, 1), cB + hstep + kstep, voffB);
        PG8_WAIT_V(6); PG8_BAR;
    } else {
        PG8_STAGE(PG8_SB(0, 0), cB, voffB); PG8_STAGE(PG8_SA(0, 0), cA, voffA); PG8_STAGE(PG8_SB(0, 1), cB + hstep, voffB); PG8_STAGE(PG8_SA(0, 1), cA + hstep, voffA);
        if (wr == 1) PG8_BAR;
        PG8_WAIT_V(4); PG8_BAR;
        PG8_STAGE(PG8_SB(1, 0), cB + kstep, voffB); PG8_STAGE(PG8_SA(1, 0), cA + kstep, voffA); PG8_STAGE(PG8_SB(1, 1), cB + hstep + kstep, voffB);
        PG8_WAIT_V(6); PG8_BAR;
    }
    for (;;) {
        const bool has_next = S.next(ui + 1, nxt);
        const char* nA = has_next ? (const char*)(nxt.src ? g.A2 : g.A) + (size_t)nxt.pm * tstep : cA; const char* nB = has_next ? (const char*)(nxt.src ? g.Bt2 : g.Bt) + (size_t)nxt.pn * tstep : cB;
        for (int t = 0; t < nt; t += 2) {
            const bool last = (t == nt - 2);
            const char* a1 = cA + (size_t)(t + 1) * kstep;
            const char* a2 = last ? nA : cA + (size_t)(t + 2) * kstep; const char* b2 = last ? nB : cB + (size_t)(t + 2) * kstep;
            const char* a3 = a2 + kstep; const char* b3 = b2 + kstep;
            if (last && has_next) S.a_ready(nxt);
            if constexpr (SP2) {
            PG8_LDB(B0, 0, 0); PG8_LDB(B1, 0, 1); PG8_SCHED; PG8_LDA(At, 0, 0); PG8_STAGE(PG8_SA(1, 1), a1 + hstep, voffA);
            PG8_WAIT_V(8); PG8_WAIT_L(0); PG8_BAR; PG8_MMA(0, 0, At, B0); PG8_MMA(0, 1, At, B1); PG8_BAR; PG8_SCHED;
            PG8_LDA(At, 0, 1); PG8_STAGE(PG8_SB(0, 0), b2, voffB); PG8_STAGE(PG8_SB(0, 1), b2 + hstep, voffB); PG8_STAGE(PG8_SA(0, 0), a2, voffA);
            PG8_WAIT_V(8); PG8_WAIT_L(0); PG8_BAR; PG8_MMA(1, 0, At, B0); PG8_MMA(1, 1, At, B1); PG8_BAR; PG8_SCHED;
            PG8_LDB(B0, 1, 0); PG8_LDB(B1, 1, 1); PG8_SCHED; PG8_LDA(At, 1, 0); PG8_STAGE(PG8_SA(0, 1), a2 + hstep, voffA);
            PG8_WAIT_V(8); PG8_WAIT_L(0); PG8_BAR; PG8_MMA(0, 0, At, B0); PG8_MMA(0, 1, At, B1); PG8_BAR; PG8_SCHED;
            PG8_LDA(At, 1, 1); PG8_STAGE(PG8_SB(1, 0), b3, voffB); PG8_STAGE(PG8_SB(1, 1), b3 + hstep, voffB); PG8_STAGE(PG8_SA(1, 0), a3, voffA);
            PG8_WAIT_V(8); PG8_WAIT_L(0); PG8_BAR; PG8_MMA(1, 0, At, B0); PG8_MMA(1, 1, At, B1); PG8_BAR; PG8_SCHED;
            } else {
            PG8_LDB(B0, 0, 0); PG8_SCHED; PG8_LDA(At, 0, 0); PG8_STAGE(PG8_SA(1, 1), a1 + hstep, voffA);
            PG8_WAIT_L(8); PG8_BAR; PG8_WAIT_L(0); PG8_MMA(0, 0, At, B0); PG8_BAR; PG8_SCHED;
            PG8_LDB(B1, 0, 1); PG8_STAGE(PG8_SB(0, 0), b2, voffB);
            PG8_BAR; PG8_WAIT_L(0); PG8_MMA(0, 1, At, B1); PG8_BAR;
            PG8_LDA(At, 0, 1); PG8_STAGE(PG8_SA(0, 0), a2, voffA);
            PG8_BAR; PG8_WAIT_L(0); PG8_MMA(1, 0, At, B0); PG8_BAR; PG8_SCHED;
            PG8_STAGE(PG8_SB(0, 1), b2 + hstep, voffB);
            PG8_WAIT_V(6); PG8_BAR; PG8_MMA(1, 1, At, B1); PG8_BAR;
            PG8_LDB(B0, 1, 0); PG8_SCHED; PG8_LDA(At, 1, 0); PG8_STAGE(PG8_SA(0, 1), a2 + hstep, voffA);
            PG8_WAIT_L(8); PG8_BAR; PG8_WAIT_L(0); PG8_MMA(0, 0, At, B0); PG8_BAR; PG8_SCHED;
            PG8_LDB(B1, 1, 1); PG8_STAGE(PG8_SB(1, 0), b3, voffB);
            PG8_BAR; PG8_WAIT_L(0); PG8_MMA(0, 1, At, B1); PG8_BAR;
            PG8_LDA(At, 1, 1); PG8_STAGE(PG8_SA(1, 0), a3, voffA);
            PG8_BAR; PG8_WAIT_L(0); PG8_MMA(1, 0, At, B0); PG8_BAR; PG8_SCHED;
            PG8_STAGE(PG8_SB(1, 1), b3 + hstep, voffB);
            PG8_WAIT_V(6); PG8_BAR; PG8_MMA(1, 1, At, B1); PG8_BAR;
            }
        }
        if constexpr (ALIGN_EPI) { if (wr == 0) PG8_BAR; }
        bool keep_acc = false;
        if constexpr (Epi::DUAL) { if (cur.src == 0) { E.mid(acc, cur, wr, wc, fr, fq); keep_acc = true; } }
        if (!keep_acc) { E(acc, cur, wr, wc, fr, fq); S.done(cur); }
        if (!has_next) break;
        if (!keep_acc) {
#pragma unroll
        for (int a = 0; a < 2; ++a)
#pragma unroll
            for (int b = 0; b < 2; ++b)
#pragma unroll
                for (int m = 0; m < 4; ++m)
#pragma unroll
                    for (int n = 0; n < 2; ++n) acc[a][b][m][n] = acc_t{};
        }
        cur = nxt; cA = nA; cB = nB; ++ui;
        if constexpr (ALIGN_EPI) { if (wr == 1) PG8_BAR; }
    }
    PG8_WAIT_V(0);
    if constexpr (!ALIGN_EPI) { if (wr == 0) PG8_BAR; }
    PG8_BAR;
#undef PG8_SA
#undef PG8_SB
#undef PG8_STAGE
#undef PG8_LDA
#undef PG8_LDB
#undef PG8_MMA
#undef PG8_WAIT_V
#undef PG8_WAIT_L
#undef PG8_BAR
#undef PG8_SCHED
}
}
namespace fox {
using bf16 = unsigned short;
typedef short bf16x8 __attribute__((ext_vector_type(8)));
typedef short s16x4 __attribute__((ext_vector_type(4)));
typedef float f32x16 __attribute__((ext_vector_type(16)));
typedef float f32x4 __attribute__((ext_vector_type(4)));
typedef unsigned u32x4 __attribute__((ext_vector_type(4)));
template <class A, class Bt> struct same_t { static constexpr bool v = false; };
template <class A> struct same_t<A, A> { static constexpr bool v = true; };
constexpr int D = 128, PITCH = 2048;
constexpr float SCALE = 0.08838834764831845f;
constexpr float THR = 8.f;
constexpr bool WSKIP = false;
constexpr int NW = 8, QBLK = 32, KVBLK = 64, QB = NW * QBLK;
constexpr int SHM_V = KVBLK * D * 2, SHM_K = KVBLK * D * 2;
constexpr int LDS_BIAS = 2 * SHM_V + 2 * SHM_K + NW * 64 * 4;
constexpr int LDS_BYTES = LDS_BIAS + 2 * 4096 * 4;
#define KSWZ(row, colB) ((row) * 256 + ((colB) ^ (((row) & 7) << 4)))
#define SBAR() __builtin_amdgcn_sched_barrier(0)
__device__ __forceinline__ int v_st(int k, int c) { const int kk = (k & ~0xC) | ((k & 4) << 1) | ((k & 8) >> 1); return ((kk >> 3) * 4 + (c >> 5)) * 512 + ((kk & 7) * 32 + (c & 31)) * 2; }
__device__ __forceinline__ int v_rd_base(int lane) { return ((lane & 3) << 3) | (((lane >> 2) & 3) << 6) | (((lane >> 4) & 1) << 5) | (((lane >> 5) & 1) << 8); }
constexpr int v_rd_off(int d0, int ks, int half) { return d0 * 512 + ks * 4096 + half * 2048; }
__device__ __forceinline__ int crow(int r, int hi) { return (r & 3) + 8 * (r >> 2) + 4 * hi; }
__device__ __forceinline__ unsigned cvtpk(float lo, float hi) { return pg8::cvt_pk_bf16(lo, hi); }
__device__ __forceinline__ bf16x8 pack8(f32x4 a, f32x4 b) {
    u32x4 w = {cvtpk(a[0], a[1]), cvtpk(a[2], a[3]), cvtpk(b[0], b[1]), cvtpk(b[2], b[3])};
    return *reinterpret_cast<bf16x8*>(&w);
}
template <class T> __device__ __forceinline__ bf16x8 load8(const T* p) {
    if constexpr (same_t<T, float>::v) { return pack8(*(const f32x4*)p, *(const f32x4*)(p + 4)); }
    else { return *reinterpret_cast<const bf16x8*>(p); }
}
__device__ __forceinline__ void mask_tile(f32x16& p0, f32x16& p1, int dq, unsigned W) {
    const float NEG = -__builtin_inff();
#pragma unroll
    for (int r = 0; r < 16; ++r) {
        const int c = (r & 3) + 8 * (r >> 2);
        if ((unsigned)(dq - c) >= W) p0[r] = NEG;
        if ((unsigned)(dq - c - 32) >= W) p1[r] = NEG;
    }
}
__device__ __forceinline__ void partialSM(f32x16& p0, f32x16& p1, float& m_reg, float& mn, float& alpha) {
    float pmax = p0[0]; for (int r = 1; r < 16; ++r) pmax = fmaxf(pmax, p0[r]); for (int r = 0; r < 16; ++r) pmax = fmaxf(pmax, p1[r]);
    { auto rr = __builtin_amdgcn_permlane32_swap(__float_as_uint(pmax), __float_as_uint(pmax), false, false);
      pmax = fmaxf(__uint_as_float(rr[0]), __uint_as_float(rr[1])); }
    constexpr float C2 = 1.4426950408889634f * SCALE;
    if (__builtin_expect(__all((pmax - m_reg) * SCALE <= THR), 1)) { mn = m_reg; alpha = 1.f; }
    else { mn = fmaxf(m_reg, pmax); alpha = __builtin_amdgcn_exp2f((m_reg - mn) * C2); m_reg = mn; }
    const float mnL = -mn * C2;
    for (int r = 0; r < 16; ++r) p0[r] = fmaf(p0[r], C2, mnL); for (int r = 0; r < 16; ++r) p1[r] = fmaf(p1[r], C2, mnL);
    for (int r = 0; r < 16; ++r) p0[r] = __builtin_amdgcn_exp2f(p0[r]);
}
__device__ __forceinline__ void finishSM(f32x16& p0, f32x16& p1, float alpha, float& l_reg, bf16x8& pa0, bf16x8& pa1, bf16x8& pa2, bf16x8& pa3) {
    for (int r = 0; r < 16; ++r) p1[r] = __builtin_amdgcn_exp2f(p1[r]);
    float ps = 0; for (int r = 0; r < 16; ++r) ps += p0[r]; for (int r = 0; r < 16; ++r) ps += p1[r];
    { auto rr = __builtin_amdgcn_permlane32_swap(__float_as_uint(ps), __float_as_uint(ps), false, false);
      ps = __uint_as_float(rr[0]) + __uint_as_float(rr[1]); }
    l_reg = l_reg * alpha + ps;
#define PK4(P, B_, OUT) do { unsigned a0 = cvtpk(P[B_+0], P[B_+1]), a1 = cvtpk(P[B_+2], P[B_+3]);                          \
        unsigned b0 = cvtpk(P[B_+4], P[B_+5]), b1 = cvtpk(P[B_+6], P[B_+7]);                                             \
        auto r0 = __builtin_amdgcn_permlane32_swap(a0, b0, false, false); auto r1 = __builtin_amdgcn_permlane32_swap(a1, b1, false, false); \
        u32x4 w = {r0[0], r1[0], r0[1], r1[1]}; OUT = *reinterpret_cast<bf16x8*>(&w); } while (0)
    PK4(p0, 0, pa0); PK4(p0, 8, pa1); PK4(p1, 0, pa2); PK4(p1, 8, pa3);
#undef PK4
}
template <int KB, bool SK>
__device__ __forceinline__ void qkt(f32x16& p0, f32x16& p1, const char* K_lds, int r32, int hi, const bf16x8* qr, bool act, const char* bias_t) {
    if (SK && !act) { const float NEG = -__builtin_inff();
#pragma unroll
        for (int r = 0; r < 16; ++r) { p0[r] = NEG; p1[r] = NEG; } return; }
#ifdef FOX_NOBIAS
    p0 = f32x16{}; p1 = f32x16{};
#else
#pragma unroll
    for (int g = 0; g < 4; ++g) { const f32x4 b0 = *reinterpret_cast<const f32x4*>(bias_t + g * 32), b1 = *reinterpret_cast<const f32x4*>(bias_t + 128 + g * 32);
        p0[4 * g] = b0[0]; p0[4 * g + 1] = b0[1]; p0[4 * g + 2] = b0[2]; p0[4 * g + 3] = b0[3]; p1[4 * g] = b1[0]; p1[4 * g + 1] = b1[1]; p1[4 * g + 2] = b1[2]; p1[4 * g + 3] = b1[3]; }
#endif
    const char* kb[4];
#pragma unroll
    for (int dd = 0; dd < 4; ++dd) kb[dd] = K_lds + KB * SHM_K + KSWZ(r32, (dd * 16 + hi * 8) * 2);
#pragma unroll
    for (int d0 = 0; d0 < 8; ++d0) { const char* a = kb[d0 & 3] + (d0 >> 2) * 128;
        bf16x8 b0 = *reinterpret_cast<const bf16x8*>(a);
        bf16x8 b1 = *reinterpret_cast<const bf16x8*>(a + 32 * 256);
        p0 = __builtin_amdgcn_mfma_f32_32x32x16_bf16(b0, qr[d0], p0, 0, 0, 0);
        p1 = __builtin_amdgcn_mfma_f32_32x32x16_bf16(b1, qr[d0], p1, 0, 0, 0); }
}
template <int VB, bool SK>
__device__ __forceinline__ void pv_tile(f32x16* o, int vb0, bf16x8 pa0, bf16x8 pa1, bf16x8 pa2, bf16x8 pa3, bool act) {
    if (SK && !act) return;
#define TRRD(dst, off) asm volatile("ds_read_b64_tr_b16 %0, %1 offset:%2" : "=&v"(dst) : "v"(vb0), "i"(off) : "memory")
#define PV_D0(d0) do { s16x4 l0, l1, l2, l3, h0, h1, h2, h3; constexpr int b_ = VB * SHM_V + v_rd_off(d0, 0, 0);     \
        TRRD(l0, b_); TRRD(h0, b_ + 2048); TRRD(l1, b_ + 4096); TRRD(h1, b_ + 6144); TRRD(l2, b_ + 8192); TRRD(h2, b_ + 10240); TRRD(l3, b_ + 12288); TRRD(h3, b_ + 14336); \
        asm volatile("s_waitcnt lgkmcnt(0)" ::: "memory"); SBAR();                 \
        o[d0] = __builtin_amdgcn_mfma_f32_32x32x16_bf16(pa0, (bf16x8){l0[0], l0[1], l0[2], l0[3], h0[0], h0[1], h0[2], h0[3]}, o[d0], 0, 0, 0);   \
        o[d0] = __builtin_amdgcn_mfma_f32_32x32x16_bf16(pa1, (bf16x8){l1[0], l1[1], l1[2], l1[3], h1[0], h1[1], h1[2], h1[3]}, o[d0], 0, 0, 0);   \
        o[d0] = __builtin_amdgcn_mfma_f32_32x32x16_bf16(pa2, (bf16x8){l2[0], l2[1], l2[2], l2[3], h2[0], h2[1], h2[2], h2[3]}, o[d0], 0, 0, 0);   \
        o[d0] = __builtin_amdgcn_mfma_f32_32x32x16_bf16(pa3, (bf16x8){l3[0], l3[1], l3[2], l3[3], h3[0], h3[1], h3[2], h3[3]}, o[d0], 0, 0, 0); } while (0)
    PV_D0(0); PV_D0(1); PV_D0(2); PV_D0(3);
#undef PV_D0
#undef TRRD
}
template <class TIn, class TOut> struct BlockRef { const TIn* Q; const TIn* K; const TIn* V; TOut* O; int P0; int jlo; int boff; };
template <class TIn> struct Seam {
    bf16x8 qr[8];
    bf16x8 st_v0, st_v1, st_k0, st_k1; f32x4 sf0, sf1, sf2, sf3;
    f32x4 tq[16];
};
__device__ __forceinline__ int swa_jlo(int P0, int W) { const int lowk = P0 - W + 1; return lowk > 0 ? lowk / KVBLK : 0; }
#define ROW(p, k0, rr) ((p) + ((size_t)(k0) + ((rr) - sr)) * PITCH + soff)
#define VMW() asm volatile("s_waitcnt vmcnt(0)" ::: "memory")
#define VMWN(n) asm volatile("s_waitcnt vmcnt(%0)" :: "i"(n) : "memory")
#define SLOAD_H(Kp, Vp, k0) do { S.st_v0 = load8<TIn>(ROW(Vp, k0, sr)); S.st_v1 = load8<TIn>(ROW(Vp, k0, 32 + sr));              \
                         S.st_k0 = load8<TIn>(ROW(Kp, k0, sr)); S.st_k1 = load8<TIn>(ROW(Kp, k0, 32 + sr)); } while (0)
#define SWRITE_HK(bf) do { *(bf16x8*)(K_lds + (bf) * SHM_K + kws) = S.st_k0; *(bf16x8*)(K_lds + (bf) * SHM_K + kws + 32 * 256) = S.st_k1; } while (0)
#define SWRITE_HV(bf) do { *(bf16x8*)(V_lds + (bf) * SHM_V + vst0) = S.st_v0; *(bf16x8*)(V_lds + (bf) * SHM_V + vst1) = S.st_v1; } while (0)
#define SWRITE_H(bf) do { SWRITE_HV(bf); SWRITE_HK(bf); } while (0)
#define SLOAD_F(p, k0) do { S.sf0 = *(const f32x4*)ROW(p, k0, sr); S.sf1 = *(const f32x4*)(ROW(p, k0, sr) + 4);                \
                            S.sf2 = *(const f32x4*)ROW(p, k0, 32 + sr); S.sf3 = *(const f32x4*)(ROW(p, k0, 32 + sr) + 4); } while (0)
#define SWRITE_KF(bf) do { *(bf16x8*)(K_lds + (bf) * SHM_K + kws) = pack8(S.sf0, S.sf1); *(bf16x8*)(K_lds + (bf) * SHM_K + kws + 32 * 256) = pack8(S.sf2, S.sf3); } while (0)
#define SWRITE_VF(bf) do { *(bf16x8*)(V_lds + (bf) * SHM_V + vst0) = pack8(S.sf0, S.sf1); *(bf16x8*)(V_lds + (bf) * SHM_V + vst1) = pack8(S.sf2, S.sf3); } while (0)
template <class TIn, class TOut>
__device__ __forceinline__ void causal_swa_prime(const BlockRef<TIn, TOut>& cur, int W, char* lds, Seam<TIn>& S) {
    constexpr bool F32 = same_t<TIn, float>::v;
    const int tid = threadIdx.x, wid = __builtin_amdgcn_readfirstlane(tid >> 6), lane = tid & 63, r32 = lane & 31, hi = lane >> 5;
    const int sr = tid >> 4, sc = (tid & 15) * 8, kws = KSWZ(sr, sc * 2); char* K_lds = lds + 2 * SHM_V; const unsigned soff = (unsigned)(sr * PITCH + sc), qoff = (unsigned)(r32 * PITCH + hi * 8);
    const int kb0 = cur.jlo * KVBLK;
    for (int d0 = 0; d0 < 8; ++d0) S.qr[d0] = load8<TIn>(cur.Q + (size_t)(wid * QBLK) * PITCH + qoff + d0 * 16);
    if constexpr (F32) { SLOAD_F((const float*)cur.K, kb0); VMW(); SWRITE_KF(0); SBAR(); SLOAD_F((const float*)cur.V, kb0); }
    else { SLOAD_H(cur.K, cur.V, kb0); VMW(); SWRITE_HK(0); }
    __syncthreads();
}
template <class TIn, class TOut>
__device__ __forceinline__ void causal_swa_block(const BlockRef<TIn, TOut>& cur, const BlockRef<TIn, TOut>& nxt, int skv, int W, char* lds, Seam<TIn>& S) {
    constexpr bool F32 = same_t<TIn, float>::v;
    const int tid = threadIdx.x, wid = __builtin_amdgcn_readfirstlane(tid >> 6), lane = tid & 63, r32 = lane & 31, hi = lane >> 5;
    const int j_lo = cur.jlo;
    int j_hi = (cur.P0 + QB - 1) / KVBLK + 1; if (j_hi > skv / KVBLK) j_hi = skv / KVBLK;
    const int NT = j_hi - j_lo;
    const int kbn = nxt.jlo * KVBLK;
    const int qlo = cur.P0 + wid * QBLK, qm = qlo + r32 - 4 * hi;
    char* V_lds = lds; char* K_lds = lds + 2 * SHM_V; const char* bias_h = lds + cur.boff + hi * 16;
    float* ws = (float*)(lds + 2 * SHM_V + 2 * SHM_K) + wid * 64; float* li_l = ws, * al_l = ws + 32;
    float m_reg = -1e30f, l_reg = 0; f32x16 o[4] = {};
    const int sr = tid >> 4, sc = (tid & 15) * 8, vst0 = v_st(sr, sc), vst1 = v_st(32 + sr, sc), kws = KSWZ(sr, sc * 2); const unsigned soff = (unsigned)(sr * PITCH + sc), qoff = (unsigned)(r32 * PITCH + hi * 8), ooff = (unsigned)(4 * hi * PITCH + r32);
    const int vb0 = (int)(uintptr_t)V_lds + v_rd_base(lane);
    const TIn* Kh = cur.K; const TIn* Vh = cur.V;
#define RESC(a) do { if (__any((a) < 1.f)) { if (hi == 0) al_l[r32] = (a); asm volatile("s_waitcnt lgkmcnt(0)" ::: "memory");              \
                     for (int d_ = 0; d_ < 4; ++d_) for (int r = 0; r < 16; ++r) o[d_][r] *= al_l[crow(r, hi)]; } } while (0)
#define KBASE(t) ((j_lo + (t)) * KVBLK)
#define BIAS_T(t) (bias_h + KBASE(t) * 4)
#define ACT(t) (KBASE(t) <= qlo + QBLK - 1 && KBASE(t) + KVBLK - 1 >= qlo - W + 1)
#define MASKT(P0_, P1_, t) do { const int kb_ = KBASE(t); if ((!SK || ACT(t)) && (kb_ + KVBLK - 1 > qlo || kb_ <= qlo + QBLK - 1 - W)) mask_tile(P0_, P1_, qm - kb_, (unsigned)W); } while (0)
    constexpr int NQL = F32 ? 16 : 8;
    constexpr bool SK = WSKIP && !F32;
#define SEAM_K0() do { VMWN(NQL); if constexpr (F32) { SWRITE_KF(0); SBAR(); SLOAD_F((const float*)nxt.V, kbn); } else { SWRITE_HK(0); } SBAR(); } while (0)
    f32x16 pA0, pA1, pB0, pB1; float mnA, mnB, alA, alB; bf16x8 pa0, pa1, pa2, pa3;
    if constexpr (F32) { VMW(); SWRITE_VF(0); SBAR(); } else { SWRITE_HV(0); SBAR(); }
    if (NT > 1) { if constexpr (F32) SLOAD_F((const float*)Kh, KBASE(1)); else SLOAD_H(Kh, Vh, KBASE(1)); }
    SBAR(); qkt<0, SK>(pA0, pA1, K_lds, r32, hi, S.qr, ACT(0), BIAS_T(0));
    if constexpr (F32) { if (NT > 1) { VMW(); SWRITE_KF(1); SBAR(); SLOAD_F((const float*)Vh, KBASE(1)); } }
    MASKT(pA0, pA1, 0); partialSM(pA0, pA1, m_reg, mnA, alA);
    if (NT > 1) { VMW(); if constexpr (F32) { SWRITE_VF(1); SBAR(); if (NT > 2) SLOAD_F((const float*)Kh, KBASE(2)); } else SWRITE_H(1); }
    __syncthreads();
#define HALF_STEP(PX0, PX1, mnX, alX, PY0, PY1, alY, t, KB, VB, SB) do {                                                      \
        SBAR(); qkt<KB, SK>(PX0, PX1, K_lds, r32, hi, S.qr, ACT(t), BIAS_T(t));                                             \
        finishSM(PY0, PY1, alY, l_reg, pa0, pa1, pa2, pa3); SBAR();                                                           \
        if ((t) + 1 < NT) { if constexpr (F32) { VMW(); SWRITE_KF(SB); SBAR(); SLOAD_F((const float*)Vh, KBASE((t) + 1)); }  \
                            else { SLOAD_H(Kh, Vh, KBASE((t) + 1)); } SBAR(); }                                               \
        pv_tile<VB, SK>(o, vb0, pa0, pa1, pa2, pa3, ACT((t) - 1)); MASKT(PX0, PX1, (t)); partialSM(PX0, PX1, m_reg, mnX, alX);                                        \
        __syncthreads();                                                                                                      \
        if ((t) + 1 < NT) { VMW(); if constexpr (F32) { SWRITE_VF(SB); SBAR(); if ((t) + 2 < NT) SLOAD_F((const float*)Kh, KBASE((t) + 2)); } \
                            else { SWRITE_H(SB); } }                                                                          \
        RESC(alX); __syncthreads(); } while (0)
    for (int t = 1; t + 1 < NT; t += 2) {
        HALF_STEP(pB0, pB1, mnB, alB, pA0, pA1, alA, t, 1, 0, 0);
        HALF_STEP(pA0, pA1, mnA, alA, pB0, pB1, alB, t + 1, 0, 1, 1);
    }
    const bool even = (NT & 1) == 0;
    if (even) { SBAR(); qkt<1, SK>(pB0, pB1, K_lds, r32, hi, S.qr, ACT(NT - 1), BIAS_T(NT - 1)); SBAR(); }
#define QROW(e) (nxt.Q + (size_t)(wid * QBLK) * PITCH + qoff + ((e) >> 1) * 16 + ((e) & 1) * 4)
    if constexpr (F32) { SLOAD_F((const float*)nxt.K, kbn); SBAR();
#pragma unroll
        for (int e = 0; e < 8; ++e) S.tq[e] = *(const f32x4*)QROW(e); }
    else { SLOAD_H(nxt.K, nxt.V, kbn); SBAR();
#pragma unroll
        for (int d0 = 0; d0 < 8; ++d0) S.qr[d0] = load8<TIn>(nxt.Q + (size_t)(wid * QBLK) * PITCH + qoff + d0 * 16); }
    SBAR();
    finishSM(pA0, pA1, alA, l_reg, pa0, pa1, pa2, pa3); SBAR();
    if constexpr (F32) {
#pragma unroll
        for (int e = 8; e < 16; ++e) S.tq[e] = *(const f32x4*)QROW(e); SBAR(); }
#undef QROW
    pv_tile<0, SK>(o, vb0, pa0, pa1, pa2, pa3, ACT(even ? NT - 2 : NT - 1));
    if (even) { MASKT(pB0, pB1, NT - 1); partialSM(pB0, pB1, m_reg, mnB, alB); __syncthreads(); RESC(alB);
        finishSM(pB0, pB1, alB, l_reg, pa0, pa1, pa2, pa3); SBAR(); pv_tile<1, SK>(o, vb0, pa0, pa1, pa2, pa3, ACT(NT - 1)); }
    SBAR(); SEAM_K0();
    if (hi == 0) li_l[r32] = l_reg; asm volatile("s_waitcnt lgkmcnt(0)" ::: "memory");
    float rli[16];
#pragma unroll
    for (int r = 0; r < 16; ++r) rli[r] = __builtin_amdgcn_rcpf(li_l[crow(r, hi)]);
    TOut* Ow = cur.O + (size_t)(wid * QBLK) * PITCH;
#pragma unroll
    for (int r = 0; r < 16; ++r) { const int orow = (r & 3) + 8 * (r >> 2);
#pragma unroll
        for (int d0 = 0; d0 < 4; ++d0) { const float v = o[d0][r] * rli[r];
            if constexpr (same_t<TOut, float>::v) { Ow[(size_t)orow * PITCH + d0 * 32 + ooff] = v; }
            else { const float vn = __shfl_xor(v, 1);
                   if ((r32 & 1) == 0) *(unsigned*)(Ow + (size_t)orow * PITCH + d0 * 32 + ooff) = cvtpk(v, vn); } } }
    if constexpr (F32) {
#pragma unroll
        for (int d0 = 0; d0 < 8; ++d0) S.qr[d0] = pack8(S.tq[2 * d0], S.tq[2 * d0 + 1]); }
    __syncthreads();
#undef RESC
#undef KBASE
#undef BIAS_T
#undef ACT
#undef MASKT
#undef SEAM_K0
#undef HALF_STEP
}
#undef ROW
#undef VMW
#undef VMWN
#undef SLOAD_H
#undef SWRITE_HK
#undef SWRITE_HV
#undef SWRITE_H
#undef SLOAD_F
#undef SWRITE_KF
#undef SWRITE_VF

}
namespace swa {
using bf16 = unsigned short;
typedef short bf16x8 __attribute__((ext_vector_type(8)));
typedef short s16x4 __attribute__((ext_vector_type(4)));
typedef float f32x16 __attribute__((ext_vector_type(16)));
typedef unsigned u32x4 __attribute__((ext_vector_type(4)));
constexpr int KP = 144, VP = 520;
constexpr int LDS_K = 0, LDS_V = 256 * KP, LDS_TBL = LDS_V + 64 * VP, LDS_BYTES = LDS_TBL + 8 * 192 * 4;
constexpr float LOG2E = 1.4426950408889634f;
struct Tensors { const bf16* Q; const bf16* K; const bf16* V; bf16* O; const float* sinks; const float* relb; };
__device__ __forceinline__ int t5_bucket(int d) {
    if (d < 16) return d;
    return 16 + (d >= 19) + (d >= 21) + (d >= 24) + (d >= 27) + (d >= 31) + (d >= 35) + (d >= 40) + (d >= 46) + (d >= 52) + (d >= 59) + (d >= 67) + (d >= 77) + (d >= 87) + (d >= 99) + (d >= 113);
}
__device__ __forceinline__ unsigned cvtpk(float lo, float hi) { return pg8::cvt_pk_bf16(lo, hi); }

__device__ __forceinline__ void swa_unit(char* lds, const Tensors& T, int b, int kvh, int blk) {
    const int tid = threadIdx.x, wid = __builtin_amdgcn_readfirstlane(tid >> 6), lane = tid & 63, c32 = lane & 31, hi = lane >> 5;
    const int hq = kvh * 8 + wid;
    const float NEG = -__builtin_inff();
    const long tok0 = (long)b * 4096 + 128 * (blk - 1);
#pragma unroll
    for (int i = 0; i < 4; ++i) {
        const int id = tid + 512 * i, key = id >> 3, ch = id & 7;
        bf16x8 kv = {0, 0, 0, 0, 0, 0, 0, 0}, vv = {0, 0, 0, 0, 0, 0, 0, 0};
        if (blk > 0 || key >= 128) { const size_t off = (size_t)(tok0 + key) * 256 + kvh * 64 + ch * 8; kv = *(const bf16x8*)(T.K + off); vv = *(const bf16x8*)(T.V + off); }
        *(bf16x8*)(lds + LDS_K + key * KP + ch * 16) = kv;
#pragma unroll
        for (int j = 0; j < 8; ++j) *(short*)(lds + LDS_V + (ch * 8 + j) * VP + key * 2) = vv[j];
    }
    float* tbl = (float*)(lds + LDS_TBL) + wid * 192;
    for (int j = lane; j < 192; j += 64) { const int dist = j - 32; float v = NEG; if (dist >= 0 && dist < 128) v = T.relb[t5_bucket(dist) * 32 + hq] * LOG2E; tbl[j] = v; }
    const float sink2 = T.sinks[hq] * LOG2E;
    __syncthreads();
    const float* tb = tbl + (c32 - 4 * hi + 160);
    for (int a = 0; a < 4; ++a) {
        const size_t qrow = (size_t)b * 4096 + blk * 128 + a * 32 + c32;
        bf16x8 qf[4];
#pragma unroll
        for (int ks = 0; ks < 4; ++ks) qf[ks] = *(const bf16x8*)(T.Q + qrow * 2048 + hq * 64 + ks * 16 + hi * 8);
        f32x16 S[5];
#pragma unroll
        for (int t = 0; t < 5; ++t) {
            S[t] = f32x16{};
            const char* kp = lds + LDS_K + (32 * (a + t) + c32) * KP + hi * 16;
#pragma unroll
            for (int ks = 0; ks < 4; ++ks) { const bf16x8 kf = *(const bf16x8*)(kp + ks * 32); S[t] = __builtin_amdgcn_mfma_f32_32x32x16_bf16(kf, qf[ks], S[t], 0, 0, 0); }
        }
        float mx = sink2;
#pragma unroll
        for (int t = 0; t < 5; ++t) {
            const bool dead = (blk == 0) && (a + t < 4);
#pragma unroll
            for (int r = 0; r < 16; ++r) {
                float s = fmaf(S[t][r], 0.125f * LOG2E, tb[-((r & 3) + 8 * (r >> 2)) - 32 * t]);
                if (dead) s = NEG;
                S[t][r] = s; mx = fmaxf(mx, s);
            }
        }
        mx = fmaxf(mx, __shfl_xor(mx, 32));
        float sum = 0.f;
#pragma unroll
        for (int t = 0; t < 5; ++t)
#pragma unroll
            for (int r = 0; r < 16; ++r) { const float p = __builtin_amdgcn_exp2f(S[t][r] - mx); S[t][r] = p; sum += p; }
        sum += __shfl_xor(sum, 32);
        const float inv = 1.f / (sum + __builtin_amdgcn_exp2f(sink2 - mx));
        f32x16 O0 = f32x16{}, O1 = f32x16{};
#pragma unroll
        for (int t = 0; t < 5; ++t)
#pragma unroll
            for (int s = 0; s < 2; ++s) {
                u32x4 aw; aw.x = cvtpk(S[t][8 * s] * inv, S[t][8 * s + 1] * inv); aw.y = cvtpk(S[t][8 * s + 2] * inv, S[t][8 * s + 3] * inv);
                aw.z = cvtpk(S[t][8 * s + 4] * inv, S[t][8 * s + 5] * inv); aw.w = cvtpk(S[t][8 * s + 6] * inv, S[t][8 * s + 7] * inv);
                const bf16x8 af = __builtin_bit_cast(bf16x8, aw);
                const char* vp = lds + LDS_V + c32 * VP + (32 * (a + t) + 16 * s + 4 * hi) * 2;
                const s16x4 l0 = *(const s16x4*)(vp), h0 = *(const s16x4*)(vp + 16), l1 = *(const s16x4*)(vp + 32 * VP), h1 = *(const s16x4*)(vp + 32 * VP + 16);
                O0 = __builtin_amdgcn_mfma_f32_32x32x16_bf16(af, (bf16x8){l0[0], l0[1], l0[2], l0[3], h0[0], h0[1], h0[2], h0[3]}, O0, 0, 0, 0);
                O1 = __builtin_amdgcn_mfma_f32_32x32x16_bf16(af, (bf16x8){l1[0], l1[1], l1[2], l1[3], h1[0], h1[1], h1[2], h1[3]}, O1, 0, 0, 0);
            }
        bf16* Ob = T.O + ((size_t)b * 4096 + blk * 128 + a * 32) * 2048 + hq * 64;
#pragma unroll
        for (int r = 0; r < 16; ++r) { const int q = (r & 3) + 8 * (r >> 2) + 4 * hi;
            const float v0 = O0[r], v1 = O1[r]; const float n0 = __shfl_xor(v0, 1), n1 = __shfl_xor(v1, 1);
            if ((c32 & 1) == 0) { *(unsigned*)(Ob + (size_t)q * 2048 + c32) = cvtpk(v0, n0); *(unsigned*)(Ob + (size_t)q * 2048 + 32 + c32) = cvtpk(v1, n1); } }
    }
    __syncthreads();
}
}

constexpr int NWAVES = 8;
#ifndef FFN_I8
#define FFN_I8 1
#endif
#ifndef PG_ALIGN
#define PG_ALIGN true
#endif
#ifndef PG_SP2
#define PG_SP2 true
#endif
#ifndef PROBE8_SKIP_BF16
#define PROBE8_SKIP_BF16 0
#endif
#ifndef FFN_I8_TILES
#define FFN_I8_TILES 78
#endif
#ifndef MK_N_LAUNCHES
#define MK_N_LAUNCHES 1
#endif
constexpr int PER_PHASE = 11;
constexpr int N_LAUNCHES = MK_N_LAUNCHES;
static_assert(N_LAUNCHES == 1 || N_LAUNCHES == PER_PHASE, "MK_N_LAUNCHES is 1 or 11");

constexpr int BATCH = 4, SEQ = 4096, DM = 4096, M = BATCH * SEQ;
constexpr int H_A = 16, H_B = 32, HKV_B = 4;
constexpr int W_IN = 16912, D_FF = 11008;
constexpr int N_IN = pg8::IN_TILES * 256;
constexpr int N_INQ = pg8::INQ_TILES * 256;
constexpr int N_WIN = N_IN + N_INQ;
constexpr float EPS = 1e-6f;

constexpr size_t MiB = 1u << 20;
constexpr size_t WS_CTL = 0, CTL_ZERO_BYTES = 512 * 1024;
constexpr size_t WS_RSTD1 = 1 * MiB;
constexpr size_t WS_SX = 1 * MiB + 256 * 1024;
constexpr size_t WS_SA = 1 * MiB + 512 * 1024;
constexpr size_t WS_WIN = 2 * MiB;
constexpr size_t WS_WA = 136 * MiB, WS_WB = 152 * MiB, WS_WO = 168 * MiB;
constexpr size_t WS_Q4 = 200 * MiB;
constexpr size_t WS_KB = 456 * MiB, WS_VB = 464 * MiB;
constexpr size_t WS_LF = 472 * MiB, WS_CC = 473 * MiB;
constexpr size_t WS_SGA = 474 * MiB, WS_SGB = 602 * MiB;
constexpr size_t WS_WGU = 730 * MiB;
constexpr size_t WS_WD = 902 * MiB;
constexpr size_t WS_WGQ = 988 * MiB;
constexpr size_t WS_END = 1074 * MiB;
constexpr size_t WS_MIXED = WS_WIN;
constexpr size_t WS_X1B = WS_Q4;
constexpr size_t WS_HID = WS_Q4 + 128 * MiB;
static_assert(WS_WIN + (size_t)N_WIN * DM * 2 <= WS_WA && WS_HID + (size_t)M * D_FF * 2 <= WS_WGU && WS_WGU + (size_t)2 * D_FF * DM * 2 <= WS_WD && WS_WD + (size_t)DM * D_FF * 2 <= WS_WGQ && WS_WGQ + (size_t)2 * D_FF * DM <= WS_END, "d_ws map");
constexpr size_t DO_XB = 0, DO_OA = 128 * MiB, DO_OB = 192 * MiB;
constexpr size_t DO_XQ = 128 * MiB, DO_WINQ = 192 * MiB;
constexpr size_t DO_X1Q = 128 * MiB;
constexpr int CW_BAR = 4096;
constexpr int CW_RSQ2 = 16384, CW_RSQ3 = 32768;
constexpr int CW_NORM = 49152;
constexpr int CW_CMAX = 65536;
constexpr int CW_AMAX = 98304;
constexpr int CW_CMAXG = 114688;
static_assert(CW_CMAX + 2 * D_FF <= CW_AMAX && CW_AMAX + M <= CW_CMAXG && (CW_CMAXG + N_INQ) * 4 <= (int)CTL_ZERO_BYTES, "CTL words inside the memset region");

constexpr int RING_OFF = 0, RING_BYTES = 133120;
constexpr int MISC_OFF = 135168;
constexpr int LDS_BYTES = 147456;
static_assert(MISC_OFF + 128 <= LDS_BYTES && fox::LDS_BYTES <= RING_BYTES && swa::LDS_BYTES <= RING_BYTES && pg8::STAGE_BYTES <= RING_BYTES, "LDS map");

#define GAS __attribute__((address_space(1)))
#define LAS __attribute__((address_space(3)))
typedef unsigned short bf16;
typedef unsigned v4u __attribute__((ext_vector_type(4)));
typedef float f32x4 __attribute__((ext_vector_type(4)));
typedef GAS unsigned gu32;
#define RLX_AGENT __ATOMIC_RELAXED, __HIP_MEMORY_SCOPE_AGENT
#define LDS_WAIT() asm volatile("s_waitcnt lgkmcnt(0)" ::: "memory")
#define VM_WAIT() asm volatile("s_waitcnt vmcnt(0)" ::: "memory")

#define XB_TMO      128
#define XB_XCNT(j)  (256  + 64 * (j))
#define XB_XSUB(j)  (1280 + 64 * (j))
#define XB_XGEN(j)  (2304 + 64 * (j))
#define XB_TOP      3328
#define XB_TOPGEN   3392
#define XCD_BAR_WORDS 3456
#define XB_SPIN_CAP (1u << 18)

__device__ __forceinline__ unsigned xb_ld(unsigned* p)              { return __hip_atomic_load(p, __ATOMIC_RELAXED, __HIP_MEMORY_SCOPE_AGENT); }
__device__ __forceinline__ unsigned xb_add(unsigned* p, unsigned v) { return __hip_atomic_fetch_add(p, v, __ATOMIC_RELAXED, __HIP_MEMORY_SCOPE_AGENT); }
__device__ __forceinline__ unsigned xb_xcc_id() { return (unsigned)__builtin_amdgcn_s_getreg((3 << 11) | 20) & 0xFu; }
#define XB_SPIN(cond, bar) do { unsigned _sp = 0; while (cond) { __builtin_amdgcn_s_sleep(1); \
    if ((++_sp & 255u) == 0u) { if (xb_ld(&(bar)[XB_TMO])) break; if (_sp > XB_SPIN_CAP) { atomicAdd(&(bar)[XB_TMO], 1u); break; } } } } while (0)

struct XcdBarrier {
    unsigned* bar; unsigned x;
    volatile LAS unsigned* st;
};
__device__ __forceinline__ XcdBarrier xcd_barrier_post(unsigned* bar, volatile LAS unsigned* st) {
    XcdBarrier b; b.bar = bar; b.x = xb_xcc_id(); b.st = st;
    if (threadIdx.x == 0) (void)xb_add(&bar[XB_XCNT(b.x)], 1u);
    return b;
}
__device__ __forceinline__ void xcd_barrier_complete(unsigned* bar, unsigned x, unsigned& nloc, unsigned& nx) {
    const unsigned G = gridDim.x * gridDim.y * gridDim.z;
    unsigned sum, cnt, mine, sp = 0u;
    for (;;) {
        sum = 0u; cnt = 0u; mine = 0u;
#pragma unroll
        for (unsigned j = 0; j < 16; ++j) { const unsigned c = xb_ld(&bar[XB_XCNT(j)]); sum += c; cnt += (c > 0u) ? 1u : 0u; mine = (j == x) ? c : mine; }
        if (sum == G) break;
        __builtin_amdgcn_s_sleep(1);
        if ((++sp & 255u) == 0u) { if (xb_ld(&bar[XB_TMO])) break; if (sp > XB_SPIN_CAP) { atomicAdd(&bar[XB_TMO], 1u); break; } }
    }
    nloc = mine > 0u ? mine : 1u; nx = cnt > 0u ? cnt : 1u;
}
__device__ __forceinline__ void xcd_barrier(const XcdBarrier& b) {
    asm volatile("s_waitcnt vmcnt(0)" ::: "memory");
    __syncthreads();
    if (threadIdx.x == 0) {
        unsigned* bar = b.bar;
        __builtin_amdgcn_s_waitcnt(0);
        unsigned nloc = b.st[0], nx = b.st[1];
        if (nloc == 0u) { xcd_barrier_complete(bar, b.x, nloc, nx); b.st[0] = nloc; b.st[1] = nx; }
        const unsigned old = xb_add(&bar[XB_XSUB(b.x)], 1u);
        const unsigned gen = old / nloc;
        if (old + 1u == (gen + 1u) * nloc) {
            __builtin_amdgcn_fence(__ATOMIC_RELEASE, "agent");
            asm volatile("s_waitcnt vmcnt(0)" ::: "memory");
            const unsigned og = xb_add(&bar[XB_TOP], 1u);
            const unsigned tg = og / nx;
            if (og + 1u == (tg + 1u) * nx) xb_add(&bar[XB_TOPGEN], 1u);
            else XB_SPIN(xb_ld(&bar[XB_TOPGEN]) == tg, bar);
            __builtin_amdgcn_fence(__ATOMIC_ACQUIRE, "agent");
            xb_add(&bar[XB_XGEN(b.x)], 1u);
            asm volatile("s_waitcnt vmcnt(0)" ::: "memory");
        } else {
            XB_SPIN(xb_ld(&bar[XB_XGEN(b.x)]) == gen, bar);
            __builtin_amdgcn_fence(__ATOMIC_ACQUIRE, "agent");
            asm volatile("s_waitcnt vmcnt(0)" ::: "memory");
        }
    }
    __syncthreads();
}

__device__ __forceinline__ unsigned f2bf(float f) { unsigned u = __builtin_bit_cast(unsigned, f); return (u + 0x7fffu + ((u >> 16) & 1u)) >> 16; }
__device__ __forceinline__ unsigned pk2(float lo, float hi) { return f2bf(lo) | (f2bf(hi) << 16); }
__device__ __forceinline__ float wave_sum(float v) {
#pragma unroll
    for (int o = 1; o < 64; o <<= 1) v += __shfl_xor(v, o);
    return v;
}
#ifndef P0_NT
#define P0_NT 1
#endif
#if P0_NT
#define P0_LD(p) __builtin_nontemporal_load(p)
#else
#define P0_LD(p) (*(p))
#endif
__device__ __forceinline__ void p0_item(const float* W, int ldw, int srccol, int nvalid, const float* g, bf16* WT, int K, int dstrow, int k0, LAS float* scr, int lane, unsigned* cmax = nullptr, int wr0 = -1, int wc0 = 0) {
    const int rk = lane >> 4, c4 = (lane & 15) * 4;
    f32x4 v[16];
    if (wr0 >= 0) {
#pragma unroll
        for (int i = 0; i < 16; ++i) v[i] = *(const GAS f32x4*)(W + (size_t)(wr0 + i) * ldw + wc0 + 4 * lane);
    } else if (c4 < nvalid) {
#pragma unroll
        for (int i = 0; i < 16; ++i) v[i] = P0_LD((const GAS f32x4*)(W + (size_t)(k0 + 4 * i + rk) * ldw + srccol + c4));
    } else {
#pragma unroll
        for (int i = 0; i < 16; ++i) v[i] = (f32x4){0.f, 0.f, 0.f, 0.f};
    }
    if (g) {
#pragma unroll
        for (int i = 0; i < 16; ++i) v[i] = v[i] * g[k0 + 4 * i + rk];
    }
    if (cmax) {
        f32x4 mx = {0.f, 0.f, 0.f, 0.f};
#pragma unroll
        for (int i = 0; i < 16; ++i) { mx[0] = fmaxf(mx[0], fabsf(v[i][0])); mx[1] = fmaxf(mx[1], fabsf(v[i][1])); mx[2] = fmaxf(mx[2], fabsf(v[i][2])); mx[3] = fmaxf(mx[3], fabsf(v[i][3])); }
#pragma unroll
        for (int e = 0; e < 4; ++e) { mx[e] = fmaxf(mx[e], __shfl_xor(mx[e], 16)); mx[e] = fmaxf(mx[e], __shfl_xor(mx[e], 32)); }
        if (lane < 16) {
#pragma unroll
            for (int e = 0; e < 4; ++e) (void)__hip_atomic_fetch_max(cmax + dstrow + c4 + e, __builtin_bit_cast(unsigned, mx[e]), __ATOMIC_RELAXED, __HIP_MEMORY_SCOPE_AGENT); }
    }
#pragma unroll
    for (int i = 0; i < 16; ++i) { LAS float* s = scr + (4 * i + rk) * 65 + c4; s[0] = v[i][0]; s[1] = v[i][1]; s[2] = v[i][2]; s[3] = v[i][3]; }
    LDS_WAIT(); asm volatile("" ::: "memory");
    const int nl = lane & 7, kc = lane >> 3;
#pragma unroll
    for (int j = 0; j < 8; ++j) { const int n = nl + 8 * j; const LAS float* s = scr + (8 * kc) * 65 + n;
        v4u o; o.x = pk2(s[0 * 65], s[1 * 65]); o.y = pk2(s[2 * 65], s[3 * 65]); o.z = pk2(s[4 * 65], s[5 * 65]); o.w = pk2(s[6 * 65], s[7 * 65]);
#ifdef PROBE_NOWR
        if (wr0 != -2 || (o.x == 0x12345678u && j == 7))
#endif
        *(GAS v4u*)(WT + (size_t)(dstrow + n) * K + k0 + 8 * kc) = o; }
    LDS_WAIT(); asm volatile("" ::: "memory");
}

__device__ __forceinline__ unsigned q4(float a, float b, float c, float d, float sc) {
    const int ia = (int)fminf(fmaxf(__builtin_rintf(a * sc), -127.f), 127.f), ib = (int)fminf(fmaxf(__builtin_rintf(b * sc), -127.f), 127.f);
    const int ic = (int)fminf(fmaxf(__builtin_rintf(c * sc), -127.f), 127.f), id = (int)fminf(fmaxf(__builtin_rintf(d * sc), -127.f), 127.f);
    return (unsigned)(ia & 255) | ((unsigned)(ib & 255) << 8) | ((unsigned)(ic & 255) << 16) | ((unsigned)(id & 255) << 24);
}
__device__ __forceinline__ v4u q16(v4u p0, v4u p1, float sc) {
    v4u o; o.x = q4(pg8::bf_lo(p0.x), pg8::bf_hi(p0.x), pg8::bf_lo(p0.y), pg8::bf_hi(p0.y), sc); o.y = q4(pg8::bf_lo(p0.z), pg8::bf_hi(p0.z), pg8::bf_lo(p0.w), pg8::bf_hi(p0.w), sc);
    o.z = q4(pg8::bf_lo(p1.x), pg8::bf_hi(p1.x), pg8::bf_lo(p1.y), pg8::bf_hi(p1.y), sc); o.w = q4(pg8::bf_lo(p1.z), pg8::bf_hi(p1.z), pg8::bf_lo(p1.w), pg8::bf_hi(p1.w), sc); return o;
}
struct Args { const float* in[14]; float* out; unsigned char* ws; int ph_lo, ph_hi, li, pad; };

__global__ void __launch_bounds__(NWAVES * 64, 2) hybrid_fwd(Args args) {
    extern __shared__ __attribute__((aligned(16))) unsigned char lds[];
    LAS unsigned char* const L = (LAS unsigned char*)lds;
    volatile LAS unsigned* const MISC = (volatile LAS unsigned*)(L + MISC_OFF);
    const int tid = threadIdx.x, lane = tid & 63, wave = __builtin_amdgcn_readfirstlane(tid >> 6);
    const int G = gridDim.x; const int bx = blockIdx.x; const int vcu = (G % 8 == 0) ? (bx % 8) * (G / 8) + bx / 8 : bx;
    unsigned char* const ws = args.ws;
    gu32* const ctl = (gu32*)(ws + WS_CTL);
    for (int u = tid; u < (LDS_BYTES - MISC_OFF) / 4; u += NWAVES * 64) ((LAS unsigned*)(L + MISC_OFF))[u] = 0u;
    __syncthreads();
    XcdBarrier bar; bar.bar = (unsigned*)(ctl + CW_BAR); bar.x = 0; bar.st = nullptr;
    if (N_LAUNCHES != PER_PHASE) bar = xcd_barrier_post((unsigned*)(ctl + CW_BAR), MISC + 8);
#define GRID_BAR() do { if (N_LAUNCHES != PER_PHASE) xcd_barrier(bar); } while (0)
    const int lo = args.ph_lo, hi = args.ph_hi;
#ifndef PH_MASK
#define PH_MASK 0x7ff
#endif
#define IN(k) ((((PH_MASK) >> (k)) & 1) && lo <= (k) && (k) < hi)
#define BOTH(k) (IN(k) && IN((k) + 1))
    const int gw = vcu * NWAVES + wave, NGW = G * NWAVES;

    const float* x = args.in[0]; float* out = args.out;
#ifdef PROBE_DUP
    const bool dummy = args.pad != 0;
#else
    constexpr bool dummy = false;
#endif
    float* rstd1 = (float*)(ws + WS_RSTD1);
    float* rsq2 = (float*)(ws + WS_CTL) + CW_RSQ2; float* rsq3 = (float*)(ws + WS_CTL) + CW_RSQ3;
    bf16* WIN = (bf16*)(ws + WS_WIN); bf16* WA = (bf16*)(ws + WS_WA); bf16* WB = (bf16*)(ws + WS_WB); bf16* WO = (bf16*)(ws + WS_WO);
    bf16* WGU = (bf16*)(ws + WS_WGU); bf16* WD = (bf16*)(ws + WS_WD);
    bf16* Q4 = (bf16*)(ws + WS_Q4); bf16* KBt = (bf16*)(ws + WS_KB); bf16* VBt = (bf16*)(ws + WS_VB);
    float* LF = (float*)(ws + WS_LF); float* CC = (float*)(ws + WS_CC);
    bf16* SGA = (bf16*)(ws + WS_SGA); bf16* SGB = (bf16*)(ws + WS_SGB);
    bf16* MIXED = (bf16*)(ws + WS_MIXED); bf16* X1B = (bf16*)(ws + WS_X1B); bf16* HID = (bf16*)(ws + WS_HID);
    signed char* WGQ = (signed char*)(ws + WS_WGQ); signed char* XQ = (signed char*)out + DO_XQ; signed char* WINQ = (signed char*)out + DO_WINQ; float* SX = (float*)(ws + WS_SX); float* RSTD2 = (float*)(ws + WS_SX + 65536); signed char* X1Q = (signed char*)out + DO_X1Q; float* SA = (float*)(ws + WS_SA);
    bf16* XB = (bf16*)((unsigned char*)out + DO_XB); bf16* OA = (bf16*)((unsigned char*)out + DO_OA); bf16* OB = (bf16*)((unsigned char*)out + DO_OB);

    if (IN(0)) {
        LAS float* scr = (LAS float*)(L + RING_OFF + wave * 16640);
        const float* g1 = args.in[1]; const float* g2 = args.in[9];
        constexpr int I_IN = 64 * 96, I_FA = 64 * 4, I_GT = 64 * 168, I_A = 32 * 64, I_O = 64 * 64, I_G = 64 * 172, I_D = 172 * 64;
        constexpr int NITEMS = I_IN + I_FA + I_GT + 2 * I_A + I_O + 2 * I_G + I_D, P0_SHIFT = I_IN + I_FA + I_GT;
#ifdef PROBE_P0
#define PCM(x) (args.pad ? nullptr : (x))
#define PWT(x) (args.pad ? HID : (x))
#else
#define PCM(x) (x)
#define PWT(x) (x)
#endif
#ifdef PROBE_WIDE
#define WIDE_ARGS(NB, C0) , (args.pad ? 16 * (r / ((NB) / 4)) : -1), (C0) + 256 * (r % ((NB) / 4))
#elif defined(PROBE_NOWR)
#define WIDE_ARGS(NB, C0) , (args.pad ? -2 : -1), 0
#else
#define WIDE_ARGS(NB, C0)
#endif
        for (int it = gw; it < NITEMS; it += NGW) {
            int r = it + P0_SHIFT; if (r >= NITEMS) r -= NITEMS;

            if (r < I_IN) { const int kb = r / 96, nb = r % 96, n0 = 64 * nb; p0_item(args.in[2], W_IN, n0, 64, g1, PWT(WIN), DM, n0, 64 * kb, scr, lane, nullptr WIDE_ARGS(96, 0)); continue; } r -= I_IN;
            if (r < I_FA) { const int kb = r / 4, nb = r % 4; p0_item(args.in[2], W_IN, 6144, nb == 0 ? 16 : 0, g1, PWT(WIN), DM, 6144 + 64 * nb, 64 * kb, scr, lane); continue; } r -= I_FA;
            if (r < I_GT) { const int kb = r / 168, nb = r % 168, n0 = 64 * nb;
                int d0 = n0; if (n0 >= 2560) { const int c = n0 - 2560, isb = c >= 4096, cc = c - 4096 * isb; d0 = 2560 + 256 * (cc >> 7) + 128 * isb + (cc & 127); }
                p0_item(args.in[2], W_IN, 6160 + n0, 64, g1, PWT(WIN), DM, N_IN + d0, 64 * kb, scr, lane, PCM((unsigned*)(ctl + CW_CMAXG) - N_IN) WIDE_ARGS(168, 6160)); continue; } r -= I_GT;
            if (r < I_A) { const int kb = r / 64, nb = r % 64; p0_item(args.in[6], DM, 64 * nb, 64, nullptr, PWT(WA), 2048, 64 * nb, 64 * kb, scr, lane, nullptr WIDE_ARGS(64, 0)); continue; } r -= I_A;
            if (r < I_A) { const int kb = r / 64, nb = r % 64; p0_item(args.in[7], DM, 64 * nb, 64, nullptr, PWT(WB), 2048, 64 * nb, 64 * kb, scr, lane, nullptr WIDE_ARGS(64, 0)); continue; } r -= I_A;
            if (r < I_O) { const int kb = r / 64, nb = r % 64; p0_item(args.in[8], DM, 64 * nb, 64, nullptr, PWT(WO), DM, 64 * nb, 64 * kb, scr, lane, nullptr WIDE_ARGS(64, 0)); continue; } r -= I_O;
            if (r < I_G) { const int kb = r / 172, nb = r % 172, n0 = 64 * nb; p0_item(args.in[10], D_FF, n0, 64, g2, PWT(WGU), DM, 256 * (n0 >> 7) + (n0 & 127), 64 * kb, scr, lane, PCM((unsigned*)(ctl + CW_CMAX)) WIDE_ARGS(172, 0)); continue; } r -= I_G;
            if (r < I_G) { const int kb = r / 172, nb = r % 172, n0 = 64 * nb; p0_item(args.in[11], D_FF, n0, 64, g2, PWT(WGU), DM, 256 * (n0 >> 7) + 128 + (n0 & 127), 64 * kb, scr, lane, PCM((unsigned*)(ctl + CW_CMAX)) WIDE_ARGS(172, 0)); continue; } r -= I_G;
            { const int kb = r / 64, nb = r % 64; p0_item(args.in[12], DM, 64 * nb, 64, nullptr, PWT(WD), D_FF, 64 * nb, 64 * kb, scr, lane, nullptr WIDE_ARGS(64, 0)); }
        }
        for (int m = gw; m < M; m += NGW) {
            const GAS f32x4* xr = (const GAS f32x4*)(x + (size_t)m * DM) + lane;
            f32x4 v[16]; float s = 0.f;
#pragma unroll
            for (int j = 0; j < 16; ++j) { v[j] = P0_LD(xr + 64 * j); s += (v[j].x * v[j].x + v[j].y * v[j].y) + (v[j].z * v[j].z + v[j].w * v[j].w); }
            s = wave_sum(s);
            float amx = 0.f;
#pragma unroll
            for (int j = 0; j < 16; ++j) amx = fmaxf(amx, fmaxf(fmaxf(fabsf(v[j].x), fabsf(v[j].y)), fmaxf(fabsf(v[j].z), fabsf(v[j].w))));
#pragma unroll
            for (int o = 1; o < 64; o <<= 1) amx = fmaxf(amx, __shfl_xor(amx, o));
            const float rs1 = 1.f / sqrtf(s * (1.f / DM) + EPS), qs = amx > 0.f ? 127.f / amx : 0.f;
            if (lane == 0) { rstd1[m] = rs1; SX[m] = rs1 * amx * (1.f / 127.f); }
            GAS unsigned* q4p = (GAS unsigned*)(XQ + (size_t)m * DM) + lane;
#pragma unroll
            for (int j = 0; j < 16; ++j) q4p[64 * j] = q4(v[j].x, v[j].y, v[j].z, v[j].w, qs);
            GAS unsigned long long* o8 = (GAS unsigned long long*)(XB + (size_t)m * DM) + lane;
#pragma unroll
            for (int j = 0; j < 16; ++j) o8[64 * j] = (unsigned long long)pk2(v[j].x, v[j].y) | ((unsigned long long)pk2(v[j].z, v[j].w) << 32);
        }
        if (BOTH(0)) GRID_BAR();
    }

    if (IN(1)) {
        {   const unsigned* cm = (const unsigned*)(ctl + CW_CMAXG);
            v4u p[8];
            if (gw < N_INQ) { const GAS v4u* src = (const GAS v4u*)(WIN + (size_t)(N_IN + gw) * DM) + 2 * lane;
#pragma unroll
                for (int j = 0; j < 4; ++j) { p[2 * j] = src[128 * j]; p[2 * j + 1] = src[128 * j + 1]; } }
            for (int n = gw; n < N_INQ; n += NGW) {
                v4u pn[8];
                if (n + NGW < N_INQ) { const GAS v4u* src = (const GAS v4u*)(WIN + (size_t)(N_IN + n + NGW) * DM) + 2 * lane;
#pragma unroll
                    for (int j = 0; j < 4; ++j) { pn[2 * j] = src[128 * j]; pn[2 * j + 1] = src[128 * j + 1]; } }
                const float mxv = __builtin_bit_cast(float, __hip_atomic_load(cm + n, RLX_AGENT)); const float sc = mxv > 0.f ? 127.f / mxv : 0.f;
                GAS v4u* dst = (GAS v4u*)(WINQ + (size_t)n * DM) + lane;
#pragma unroll
                for (int j = 0; j < 4; ++j) dst[64 * j] = q16(p[2 * j], p[2 * j + 1], sc);
#pragma unroll
                for (int j = 0; j < 8; ++j) p[j] = pn[j];
            }
        }
        if (BOTH(1)) GRID_BAR();
    }

    if (IN(2)) {
        { pg8::Gemm g{XB, WIN, M, N_IN, DM, nullptr, nullptr}; pg8::StaticOrder S; S.init(M, N_IN, G, bx);
          pg8::EpiInProj E{rstd1, Q4, LF, args.in[3], (unsigned*)(ctl + CW_NORM)};
          pg8::gemm_phase<pg8::EpiInProj, pg8::StaticOrder, PG_ALIGN, PG_SP2>(L + RING_OFF, g, S, E); }
        VM_WAIT(); __syncthreads();
        { pg8::Gemm g{(const bf16*)XQ, (const bf16*)WINQ, M, N_INQ, DM, nullptr, nullptr};
          pg8::TailOrder S; S.init(M, N_INQ, G, bx); S.nfull = (G == 256) ? 9 : (1 << 30); S.c0 = 64;
          typedef pg8::EpiGates8<WS_Q4 + (size_t)3 * M * 2048 * 2, WS_KB, WS_VB> EpiG;
          EpiG E{SX, (const unsigned*)(ctl + CW_CMAXG), ws, SGA, SGB};
          pg8::gemm_phase<EpiG, pg8::TailOrder, PG_ALIGN, PG_SP2>(L + RING_OFF, g, S, E); }
        if (BOTH(2)) GRID_BAR();
    }


    if (IN(4)) {
#ifndef NO_FOX
        {
            using namespace fox;
            constexpr int NX = 8, TOTAL = NX * BATCH * H_A;
            char* fl = (char*)lds + RING_OFF;
            const bf16* Qa = Q4; const bf16* Ka = Q4 + (size_t)M * 2048; const bf16* Va = Q4 + (size_t)2 * M * 2048;
            int Lc = vcu;
            if (Lc < TOTAL) {
                const int W = 1 << 20;
                constexpr float RS = 11.313708498984761f;
                float* wtot = (float*)(fl + 2 * SHM_V + 2 * SHM_K);
#define FOX_TABLE(slot_, L_) do { if ((L_) < TOTAL) { int tq_ = tid; asm volatile("" : "+v"(tq_));     \
                    const int bh_ = (L_) / NX, x_ = (L_) % NX, nk_ = (16 - x_) * QB, s0_ = 8 * tq_; float* tb_ = (float*)(fl + LDS_BIAS + (slot_) * 16384); \
                    float v_[8]; const float* lp_ = LF + ((size_t)(bh_ >> 4) * SEQ + s0_) * 16 + (bh_ & 15); \
                    _Pragma("unroll") for (int i_ = 0; i_ < 8; ++i_) v_[i_] = (s0_ < nk_) ? lp_[(size_t)i_ * 16] : 0.f; \
                    _Pragma("unroll") for (int i_ = 1; i_ < 8; ++i_) v_[i_] += v_[i_ - 1]; \
                    float incl_ = v_[7]; _Pragma("unroll") for (int o_ = 1; o_ < 64; o_ <<= 1) { const float t_ = __shfl_up(incl_, o_); if (lane >= o_) incl_ += t_; } \
                    if (lane == 63) wtot[wave] = incl_; __syncthreads(); \
                    float off_ = incl_ - v_[7]; for (int w_ = 0; w_ < wave; ++w_) off_ += wtot[w_]; \
                    if (s0_ < nk_) { _Pragma("unroll") for (int i_ = 0; i_ < 8; ++i_) tb_[s0_ + i_] = off_ + v_[i_]; } __syncthreads(); \
                    const float cref_ = tb_[x_ * QB]; __syncthreads(); \
                    if (s0_ < nk_) { _Pragma("unroll") for (int i_ = 0; i_ < 8; ++i_) tb_[s0_ + i_] = (cref_ - tb_[s0_ + i_]) * RS; } __syncthreads(); } } while (0)
#define FOX_NSUM(t_, bh_) (__builtin_bit_cast(float, __hip_atomic_load((unsigned*)(ctl + CW_NORM) + ((t_) * 64 + (bh_)) * 4 + 0, RLX_AGENT)) + __builtin_bit_cast(float, __hip_atomic_load((unsigned*)(ctl + CW_NORM) + ((t_) * 64 + (bh_)) * 4 + 1, RLX_AGENT)) + \
                           __builtin_bit_cast(float, __hip_atomic_load((unsigned*)(ctl + CW_NORM) + ((t_) * 64 + (bh_)) * 4 + 2, RLX_AGENT)) + __builtin_bit_cast(float, __hip_atomic_load((unsigned*)(ctl + CW_NORM) + ((t_) * 64 + (bh_)) * 4 + 3, RLX_AGENT)))
#define FOX_U2(bh_) (2.02f * SCALE * sqrtf(FOX_NSUM(0, bh_) * FOX_NSUM(1, bh_)))
#define FOX_JLO(slot_, qb_, u2_) ([&]() { const float* tb_ = (const float*)(fl + LDS_BIAS + (slot_) * 16384); const int p0_ = (qb_) * QB, nd_ = p0_ / KVBLK; const float bq_ = tb_[p0_]; bool keep_ = true; \
                if (lane < nd_) keep_ = ((tb_[KVBLK * lane + KVBLK - 1] - bq_) * (1.f / RS) + (u2_) > -104.f); return (int)__builtin_amdgcn_readfirstlane((int)__builtin_ctzll(__ballot(keep_))); }())
#define FOX_REF(bh_, qb_, slot_) BlockRef<bf16, bf16>{ Qa + ((size_t)((bh_) >> 4) * SEQ + (size_t)(qb_) * QB) * PITCH + ((bh_) & 15) * D, Ka + ((size_t)((bh_) >> 4) * SEQ) * PITCH + ((bh_) & 15) * D, \
                                               Va + ((size_t)((bh_) >> 4) * SEQ) * PITCH + ((bh_) & 15) * D, OA + ((size_t)((bh_) >> 4) * SEQ + (size_t)(qb_) * QB) * PITCH + ((bh_) & 15) * D, (qb_) * QB, \
                                               FOX_JLO(slot_, qb_, FOX_U2(bh_)), LDS_BIAS + (slot_) * 16384 }
                int bh = Lc / NX, xx = Lc % NX, pass = 0, slot = 0;
                FOX_TABLE(0, Lc); FOX_TABLE(1, Lc + G);
                BlockRef<bf16, bf16> cur = FOX_REF(bh, xx, 0);
                Seam<bf16> S;
                causal_swa_prime<bf16, bf16>(cur, W, fl, S);
                for (;;) {
                    const bool more_pass = pass == 0, more_item = Lc + G < TOTAL, last = !more_pass && !more_item;
                    int bhn = bh, xxn = xx, passn = pass + 1, Ln = Lc, slotn = slot;
                    if (!more_pass) { passn = 0; Ln = more_item ? Lc + G : Lc; bhn = Ln / NX; xxn = Ln % NX; slotn = slot ^ 1; }
                    const int qbn = passn ? 15 - xxn : xxn;
                    const BlockRef<bf16, bf16> nxt = last ? cur : FOX_REF(bhn, qbn, slotn);
                    causal_swa_block<bf16, bf16>(cur, nxt, SEQ, W, fl, S);
                    if (last) break;
                    if (passn == 0) FOX_TABLE(slot, Lc + 2 * G);
                    cur = nxt; bh = bhn; xx = xxn; pass = passn; Lc = Ln; slot = slotn;
                }
#undef FOX_REF
#undef FOX_TABLE
#undef FOX_NSUM
#undef FOX_JLO
#undef FOX_U2
            }
        }
#endif
        VM_WAIT(); __syncthreads();
#ifndef NO_SWA
        if (!dummy) {
            const swa::Tensors T{Q4 + (size_t)3 * M * 2048, KBt, VBt, OB, args.in[4], args.in[5]};
#ifdef PROBE_SWA_REP
#ifdef PROBE_SWA_MODE
            for (int u_ = vcu; u_ < BATCH * HKV_B * 32 * (PROBE_SWA_REP - 1); u_ += G) { const int u = u_ & 511; swa::swa_unit<PROBE_SWA_MODE>((char*)lds + RING_OFF, T, u >> 7, (u >> 5) & 3, u & 31); }
            for (int u = vcu; u < BATCH * HKV_B * 32; u += G) swa::swa_unit((char*)lds + RING_OFF, T, u >> 7, (u >> 5) & 3, u & 31);
#else
            for (int u_ = vcu; u_ < BATCH * HKV_B * 32 * PROBE_SWA_REP; u_ += G) { const int u = u_ & 511; swa::swa_unit((char*)lds + RING_OFF, T, u >> 7, (u >> 5) & 3, u & 31); }
#endif
#else
            for (int u = vcu; u < BATCH * HKV_B * 32; u += G) swa::swa_unit((char*)lds + RING_OFF, T, u >> 7, (u >> 5) & 3, u & 31);
#endif
        }
#endif
        if (BOTH(4)) GRID_BAR();
    }

    if (IN(5)) {
        pg8::Gemm g{OA, WA, M, DM, 2048, OB, WB}; pg8::SQ_DUAL S; S.init(M, DM, G, bx); pg8::EpiMix E{SGA, SGB, MIXED};
        pg8::gemm_phase<pg8::EpiMix, pg8::SQ_DUAL, PG_ALIGN, PG_SP2>(L + RING_OFF, g, S, E);
        if (BOTH(5)) GRID_BAR();
    }

    if (IN(6)) {
#if defined(PROBE_DUP) && defined(PROBE_P5_NULL)
        if (dummy) { pg8::Gemm g{MIXED, WO, M, DM, DM, nullptr, nullptr}; pg8::EpiNull E{HID};
#if defined(PROBE_P5_HOT)
            pg8::HotOrder S; S.init(M, DM, G, bx); pg8::gemm_phase<pg8::EpiNull, pg8::HotOrder, PG_ALIGN, PG_SP2>(L + RING_OFF, g, S, E);
#else
            pg8::StaticOrder S; S.init(M, DM, G, bx); pg8::gemm_phase<pg8::EpiNull, pg8::StaticOrder, PG_ALIGN, PG_SP2>(L + RING_OFF, g, S, E);
#endif
        } else {
#endif
        pg8::Gemm g{MIXED, WO, M, DM, DM, nullptr, nullptr}; pg8::SQ_ORDER S; S.init(M, DM, G, bx); pg8::EpiOutX1 E{XB, dummy ? HID : X1B};
        pg8::gemm_phase<pg8::EpiOutX1, pg8::SQ_ORDER, PG_ALIGN, PG_SP2>(L + RING_OFF, g, S, E);
#if defined(PROBE_DUP) && defined(PROBE_P5_NULL)
        }
#endif
        if (BOTH(6)) GRID_BAR();
    }

    if (IN(7)) {
#if defined(PROBE_DUP) && defined(PROBE_MFMA_CLOCK)
        if (dummy) {
            typedef short b8 __attribute__((ext_vector_type(8)));
            b8 a = {(short)(0x3f80 + lane), 0x3f80, 0x3f81, 0x3f82, 0x3f83, 0x3f84, 0x3f85, 0x3f86}, b = {0x3f80, (short)(0x3f80 + wave), 0x3f81, 0x3f82, 0x3f83, 0x3f84, 0x3f85, 0x3f86};
            f32x4 c[16];
#pragma unroll
            for (int i = 0; i < 16; ++i) c[i] = (f32x4){0.f, 0.f, 0.f, 0.f};
            for (int it = 0; it < PROBE_MFMA_CLOCK; ++it) {
#pragma unroll
                for (int i = 0; i < 16; ++i) c[i] = __builtin_amdgcn_mfma_f32_16x16x32_bf16(a, b, c[i], 0, 0, 0);
            }
            f32x4 s = c[0];
#pragma unroll
            for (int i = 1; i < 16; ++i) s = s + c[i];
            if (s[0] == 12345.678f) ((float*)HID)[tid] = s[1] + s[2] + s[3];
        } else
#endif
        {
            v4u p[8];
            if (gw < M) { const GAS v4u* src = (const GAS v4u*)(X1B + (size_t)gw * DM) + 2 * lane;
#pragma unroll
                for (int j = 0; j < 4; ++j) { p[2 * j] = src[128 * j]; p[2 * j + 1] = src[128 * j + 1]; } }
            for (int m = gw; m < M; m += NGW) {
                v4u pn[8];
                if (m + NGW < M) { const GAS v4u* src = (const GAS v4u*)(X1B + (size_t)(m + NGW) * DM) + 2 * lane;
#pragma unroll
                    for (int j = 0; j < 4; ++j) { pn[2 * j] = src[128 * j]; pn[2 * j + 1] = src[128 * j + 1]; } }
                float s = 0.f, amx = 0.f;
#pragma unroll
                for (int j = 0; j < 8; ++j) {
#pragma unroll
                    for (int e = 0; e < 4; ++e) { const float a = pg8::bf_lo(p[j][e]), b = pg8::bf_hi(p[j][e]); s += a * a + b * b; amx = fmaxf(amx, fmaxf(fabsf(a), fabsf(b))); } }
                s = wave_sum(s);
#pragma unroll
                for (int o = 1; o < 64; o <<= 1) amx = fmaxf(amx, __shfl_xor(amx, o));
                const float rs2 = 1.f / sqrtf(s * (1.f / DM) + EPS), sc = amx > 0.f ? 127.f / amx : 0.f;
                if (lane == 0) { RSTD2[m] = rs2; SA[m] = rs2 * amx * (1.f / 127.f); }
                GAS v4u* dst = (GAS v4u*)(X1Q + (size_t)m * DM) + lane;
#pragma unroll
                for (int j = 0; j < 4; ++j) dst[64 * j] = q16(p[2 * j], p[2 * j + 1], sc);
#pragma unroll
                for (int j = 0; j < 8; ++j) p[j] = pn[j];
            }
        }
        {
            const unsigned* cm = (const unsigned*)(ctl + CW_CMAX);
            constexpr int NQ = FFN_I8 ? FFN_I8_TILES * 256 : 0;
            v4u p[8];
            if (gw < NQ) { const GAS v4u* src = (const GAS v4u*)(WGU + (size_t)gw * DM) + 2 * lane;
#pragma unroll
                for (int j = 0; j < 4; ++j) { p[2 * j] = src[128 * j]; p[2 * j + 1] = src[128 * j + 1]; } }
            for (int n = gw; n < NQ; n += NGW) {
                v4u pn[8];
                if (n + NGW < NQ) { const GAS v4u* src = (const GAS v4u*)(WGU + (size_t)(n + NGW) * DM) + 2 * lane;
#pragma unroll
                    for (int j = 0; j < 4; ++j) { pn[2 * j] = src[128 * j]; pn[2 * j + 1] = src[128 * j + 1]; } }
                const float mxv = __builtin_bit_cast(float, __hip_atomic_load(cm + n, RLX_AGENT)); const float sc = mxv > 0.f ? 127.f / mxv : 0.f;
                GAS v4u* dst = (GAS v4u*)(WGQ + (size_t)n * DM) + lane;
#pragma unroll
                for (int j = 0; j < 4; ++j) dst[64 * j] = q16(p[2 * j], p[2 * j + 1], sc);
#pragma unroll
                for (int j = 0; j < 8; ++j) p[j] = pn[j];
            }
        }
        if (BOTH(7)) GRID_BAR();
    }

    if (IN(8)) {
#if FFN_I8
        {
            pg8::Gemm g8{(const bf16*)X1Q, (const bf16*)WGQ, M, FFN_I8_TILES * 256, DM, nullptr, nullptr}; pg8::StaticOrder S; S.init(M, FFN_I8_TILES * 256, G, bx);
#if defined(PROBE_DUP) && defined(PROBE_NULL8)
            if (dummy) { pg8::EpiNull8 E{HID}; pg8::gemm_phase<pg8::EpiNull8, pg8::StaticOrder, PG_ALIGN, PG_SP2>(L + RING_OFF, g8, S, E); } else
#endif
            { pg8::EpiSwiGLU8 E{SA, (const unsigned*)(ctl + CW_CMAX), HID};
            pg8::gemm_phase<pg8::EpiSwiGLU8, pg8::StaticOrder, PG_ALIGN, PG_SP2>(L + RING_OFF, g8, S, E); } }
        if (FFN_I8_TILES < 86 && !(PROBE8_SKIP_BF16 && dummy)) {
            VM_WAIT(); __syncthreads();
            pg8::Gemm g{X1B, WGU + (size_t)FFN_I8_TILES * 256 * DM, M, (86 - FFN_I8_TILES) * 256, DM, nullptr, nullptr}; pg8::StaticOrder S; S.init(M, (86 - FFN_I8_TILES) * 256, G, bx);
            pg8::EpiSwiGLU E{RSTD2, HID, FFN_I8_TILES};
            pg8::gemm_phase<pg8::EpiSwiGLU, pg8::StaticOrder, PG_ALIGN, PG_SP2>(L + RING_OFF, g, S, E); }
#else
        { pg8::Gemm g{X1B, WGU, M, 2 * D_FF, DM, nullptr, nullptr}; pg8::StaticOrder S; S.init(M, 2 * D_FF, G, bx); pg8::EpiSwiGLU E{RSTD2, HID, 0};
          pg8::gemm_phase<pg8::EpiSwiGLU, pg8::StaticOrder, PG_ALIGN, PG_SP2>(L + RING_OFF, g, S, E); }
#endif
        if (BOTH(8)) GRID_BAR();
    }

    if (IN(9)) {
#if defined(PROBE_DUP) && defined(PROBE_P8_HOT)
        if (dummy) { pg8::Gemm g{HID, WD, M, DM, D_FF, nullptr, nullptr}; pg8::HotOrder S; S.init(M, DM, G, bx); pg8::EpiDownX2 E{X1B, MIXED};
            pg8::gemm_phase<pg8::EpiDownX2, pg8::HotOrder, PG_ALIGN, PG_SP2>(L + RING_OFF, g, S, E); } else
#endif
        { pg8::Gemm g{HID, WD, M, DM, D_FF, nullptr, nullptr}; pg8::SQ_ORDER S; S.init(M, DM, G, bx); pg8::EpiDownX2 E{X1B, dummy ? MIXED : X1B};
        pg8::gemm_phase<pg8::EpiDownX2, pg8::SQ_ORDER, PG_ALIGN, PG_SP2>(L + RING_OFF, g, S, E); }
        if (BOTH(9)) GRID_BAR();
    }

    if (IN(10)) {
        const float* fg = args.in[13];
        for (int m = gw; m < M; m += 2 * NGW) {
            const GAS v4u* xr0 = (const GAS v4u*)(X1B + (size_t)m * DM) + lane; const GAS v4u* xr1 = xr0 + (size_t)NGW * (DM / 8);
            float* ob = dummy ? (float*)HID : out;
            GAS f32x4* or0 = (GAS f32x4*)(ob + (size_t)m * DM) + 2 * lane; GAS f32x4* or1 = or0 + (size_t)NGW * (DM / 4); const GAS f32x4* gr = (const GAS f32x4*)fg + 2 * lane;
            v4u p[8], q[8]; float s0 = 0.f, s1 = 0.f;
#pragma unroll
            for (int j = 0; j < 8; ++j) { p[j] = xr0[64 * j]; q[j] = xr1[64 * j]; }
#pragma unroll
            for (int j = 0; j < 8; ++j) {
#pragma unroll
                for (int e = 0; e < 4; ++e) { const float a = pg8::bf_lo(p[j][e]), b = pg8::bf_hi(p[j][e]), c = pg8::bf_lo(q[j][e]), d = pg8::bf_hi(q[j][e]); s0 += a * a + b * b; s1 += c * c + d * d; } }
            s0 = wave_sum(s0); s1 = wave_sum(s1);
            const float rs0 = 1.f / sqrtf(s0 * (1.f / DM) + EPS), rs1 = 1.f / sqrtf(s1 * (1.f / DM) + EPS);
#pragma unroll
            for (int j = 0; j < 8; ++j) { const f32x4 g0 = gr[128 * j], g1 = gr[128 * j + 1];
                const f32x4 a0 = {pg8::bf_lo(p[j].x), pg8::bf_hi(p[j].x), pg8::bf_lo(p[j].y), pg8::bf_hi(p[j].y)}, a1 = {pg8::bf_lo(p[j].z), pg8::bf_hi(p[j].z), pg8::bf_lo(p[j].w), pg8::bf_hi(p[j].w)};
                const f32x4 b0 = {pg8::bf_lo(q[j].x), pg8::bf_hi(q[j].x), pg8::bf_lo(q[j].y), pg8::bf_hi(q[j].y)}, b1 = {pg8::bf_lo(q[j].z), pg8::bf_hi(q[j].z), pg8::bf_lo(q[j].w), pg8::bf_hi(q[j].w)};
                or0[128 * j] = a0 * rs0 * g0; or0[128 * j + 1] = a1 * rs0 * g1; or1[128 * j] = b0 * rs1 * g0; or1[128 * j + 1] = b1 * rs1 * g1; }
        }
    }
#undef IN
#undef BOTH
#undef GRID_BAR
}

extern "C" void kernel_launch(void* const* d_in, const int* in_sizes, int n_in, void* d_out, int out_size, void* d_ws, size_t ws_size, hipStream_t stream) {
    static int grid = 0;
    if (grid == 0) {
        if (n_in != 14 || in_sizes[0] != M * DM || out_size != M * DM || ws_size < WS_END) {
            fprintf(stderr, "kernel_launch: built for 14 inputs, x/out of %d floats, >= %zu bytes of workspace; got n_in %d, in0 %d, out %d, ws %zu; nothing launched\n", M * DM, (size_t)WS_END, n_in, n_in > 0 ? in_sizes[0] : -1, out_size, ws_size);
            grid = -1; return; }
        int dev = 0, cus = 0, per_cu = 0;
        if (hipGetDevice(&dev) != hipSuccess || hipDeviceGetAttribute(&cus, hipDeviceAttributeMultiprocessorCount, dev) != hipSuccess) { fprintf(stderr, "kernel_launch: device query failed\n"); grid = -1; return; }
        if (hipFuncSetAttribute((const void*)hybrid_fwd, hipFuncAttributeMaxDynamicSharedMemorySize, LDS_BYTES) != hipSuccess) { fprintf(stderr, "kernel_launch: hipFuncSetAttribute failed\n"); grid = -1; return; }
        if (hipOccupancyMaxActiveBlocksPerMultiprocessor(&per_cu, (const void*)hybrid_fwd, NWAVES * 64, LDS_BYTES) != hipSuccess || per_cu < 1)
            fprintf(stderr, "kernel_launch: note: occupancy query reports %d workgroups per CU\n", per_cu);
        (void)hipGetLastError();
        grid = cus;
    }
    if (grid < 0) return;
    if (hipMemsetAsync((char*)d_ws + WS_CTL, 0, CTL_ZERO_BYTES, stream) != hipSuccess) { fprintf(stderr, "kernel_launch: hipMemsetAsync failed\n"); return; }
    Args a{};
    for (int i = 0; i < 14; ++i) a.in[i] = (const float*)d_in[i];
    a.out = (float*)d_out; a.ws = (unsigned char*)d_ws;
    for (int li = 0; li < N_LAUNCHES; ++li) {
        a.ph_lo = (N_LAUNCHES == PER_PHASE) ? li : 0; a.ph_hi = (N_LAUNCHES == PER_PHASE) ? li + 1 : PER_PHASE; a.li = li; a.pad = 0;
#ifdef PROBE_DUP
        if (N_LAUNCHES == PER_PHASE && ((PROBE_DUP >> li) & 1)) { a.pad = 1; hipLaunchKernelGGL(hybrid_fwd, dim3(grid), dim3(NWAVES * 64), LDS_BYTES, stream, a); a.pad = 0; }
#endif
        hipLaunchKernelGGL(hybrid_fwd, dim3(grid), dim3(NWAVES * 64), LDS_BYTES, stream, a);
        const hipError_t le = hipPeekAtLastError();
        if (le != hipSuccess) { fprintf(stderr, "kernel_launch: launch %d failed: %s\n", li, hipGetErrorName(le)); break; }
    }
}
```

```cpp
#include <hip/hip_runtime.h>
#include <cstdio>
#include <cstdint>

namespace pg8 {
#define PG8_LAS __attribute__((address_space(3)))
typedef unsigned short bf16_t;
typedef short bf16x8 __attribute__((ext_vector_type(8)));
typedef float f32x4 __attribute__((ext_vector_type(4)));
typedef unsigned u32x4 __attribute__((ext_vector_type(4)));
typedef int i32x4 __attribute__((ext_vector_type(4)));
constexpr int BM = 256, BK = 64, HALF = 128, HTB = HALF * BK * 2  , STAGE_BYTES = 8 * HTB, NXCD = 8, WGM = 8;

__host__ __device__ __forceinline__ int lds_byte(int r, int c) { const int st = (r >> 4) * 2 + (c >> 5), rr = r & 15, cc = c & 31, ob = rr * 64 + cc * 2; return st * 1024 + (ob ^ (((ob >> 9) & 1) << 5)); }
__host__ __device__ __forceinline__ void stage_rc(int b, int& R, int& C) { const int st = b / 1024, sb = b % 1024, swz = sb ^ (((sb >> 9) & 1) << 5); R = (st >> 1) * 16 + swz / 64; C = (st & 1) * 32 + (swz % 64) / 2; }
__host__ __device__ __forceinline__ int perm32(int rho) { const int n = rho >> 4, i = rho & 15; return 8 * (i >> 2) + 4 * n + (i & 3); }

struct Unit { int pm, pn, src; };
struct Gemm { const bf16_t* A; const bf16_t* Bt; int M, N, K; const bf16_t* A2; const bf16_t* Bt2; };

struct StaticOrder {
    int nM, nN, nwg, G, c;
    __host__ __device__ void init(int M, int N, int G_, int c_) { nM = M / BM; nN = N / BM; nwg = nM * nN; G = G_; c = c_; }
    __host__ __device__ bool next(int i, Unit& u) const {
        const long L = (long)i * G + c; if (L >= nwg) return false;
        int wgid = (int)L; { const int q = nwg / NXCD, r = nwg % NXCD, xcd = wgid % NXCD, off = wgid / NXCD; wgid = (xcd < r ? xcd * (q + 1) : r * (q + 1) + (xcd - r) * q) + off; }
        const int nig = WGM * nN, gid = wgid / nig, fm = gid * WGM, gsz = (nM - fm) < WGM ? (nM - fm) : WGM;
        u.pm = fm + ((wgid % nig) % gsz); u.pn = (wgid % nig) / gsz; u.src = 0; return true;
    }
    __device__ __forceinline__ void a_ready(const Unit&) const {}
    __device__ __forceinline__ void done(const Unit&) const {}
};
struct TailOrder : StaticOrder {
    int nfull, c0;
    __host__ __device__ bool next(int i, Unit& u) const {
        long L;
        if (i < nfull) L = (long)i * G + c; else { if (c < c0) return false; L = (long)nfull * G + (long)(i - nfull) * (G - c0) + (c - c0); }
        if (L >= nwg) return false;
        int wgid = (int)L; { const int q = nwg / NXCD, r = nwg % NXCD, xcd = wgid % NXCD, off = wgid / NXCD; wgid = (xcd < r ? xcd * (q + 1) : r * (q + 1) + (xcd - r) * q) + off; }
        const int nig = WGM * nN, gid = wgid / nig, fm = gid * WGM, gsz = (nM - fm) < WGM ? (nM - fm) : WGM;
        u.pm = fm + ((wgid % nig) % gsz); u.pn = (wgid % nig) / gsz; u.src = 0; return true;
    }
};
struct SquareOrder : StaticOrder {
    __host__ __device__ bool next(int i, Unit& u) const {
        if (G != 256 || nM != 64 || nN != 16) return StaticOrder::next(i, u);
        if (i >= 4) return false;
        const int k = c & 7, s = c >> 3; u.pm = 16 * i + 8 * (k & 1) + (s & 7); u.pn = 4 * (k >> 1) + (s >> 3); u.src = 0; return true;
    }
};
#ifndef SQ_ORDER
#define SQ_ORDER SquareOrder
#define SQ_DUAL DualSquare
#endif
struct DualSquare : SquareOrder {
    __host__ __device__ bool next(int i, Unit& u) const { const bool ok = SquareOrder::next(i >> 1, u); u.src = i & 1; return ok; }
};
template <class Base> struct RangeOrder {
    Base b; int i0, i1;
    __host__ __device__ bool next(int i, Unit& u) const { if (i0 + i >= i1) return false; return b.next(i0 + i, u); }
    __device__ __forceinline__ void a_ready(const Unit&) const {}
    __device__ __forceinline__ void done(const Unit&) const {}
};
struct DualOrder : StaticOrder {
    __host__ __device__ bool next(int i, Unit& u) const { const bool ok = StaticOrder::next(i >> 1, u); u.src = i & 1; return ok; }
};

struct HotOrder : StaticOrder {
    __host__ __device__ bool next(int i, Unit& u) const { const bool ok = StaticOrder::next(i, u); u.pm = c & 7; u.pn = 0; return ok; }
};
__device__ __forceinline__ f32x4 mma16(bf16x8 a, bf16x8 b, f32x4 c) { return __builtin_amdgcn_mfma_f32_16x16x32_bf16(a, b, c, 0, 0, 0); }
__device__ __forceinline__ i32x4 mma16(bf16x8 a, bf16x8 b, i32x4 c) { return __builtin_amdgcn_mfma_i32_16x16x64_i8(__builtin_bit_cast(i32x4, a), __builtin_bit_cast(i32x4, b), c, 0, 0, 0); }
typedef float f32x2_t __attribute__((ext_vector_type(2)));
typedef __bf16 bf16x2_t __attribute__((ext_vector_type(2)));
__device__ __forceinline__ unsigned cvt_pk_bf16(float lo, float hi) { const f32x2_t v = {lo, hi}; const bf16x2_t b = __builtin_convertvector(v, bf16x2_t); return __builtin_bit_cast(unsigned, b); }
__device__ __forceinline__ float bf_lo(unsigned w) { return __builtin_bit_cast(float, w << 16); }
__device__ __forceinline__ float bf_hi(unsigned w) { return __builtin_bit_cast(float, w & 0xffff0000u); }
__device__ __forceinline__ float sigmoid_f(float x) { return __builtin_amdgcn_rcpf(1.f + __builtin_amdgcn_exp2f(-1.4426950408889634f * x)); }
__device__ __forceinline__ u32x4 pack8(f32x4 v0, f32x4 v1) { u32x4 w; w.x = cvt_pk_bf16(v0[0], v0[1]); w.y = cvt_pk_bf16(v0[2], v0[3]); w.z = cvt_pk_bf16(v1[0], v1[1]); w.w = cvt_pk_bf16(v1[2], v1[3]); return w; }

#ifndef GATES_U8
#define GATES_U8 1
#endif
typedef unsigned u32x2 __attribute__((ext_vector_type(2)));
constexpr int IN_TILES = 25;
constexpr int INQ_TILES = 42;
struct EpiInProj {
    static constexpr bool PERM = true, AFTER_DRAIN = false, DUAL = false, I8 = false; typedef f32x4 acc_t;
    const float* rstd; bf16_t* q4;   float* lf; const float* bfor; unsigned* nrm;
    __device__ __forceinline__ void operator()(const f32x4 (&acc)[2][2][4][2], const Unit& u, int wr, int wc, int fr, int fq) const {
        const int row0 = u.pm * BM + wr * 64 + fr; const int pn = u.pn;
        float rs[2][4];
        if (pn == 24) {
            if (wc == 0 && fq < 2) {
#pragma unroll
                for (int ai = 0; ai < 2; ++ai)
#pragma unroll
                    for (int m = 0; m < 4; ++m) rs[ai][m] = rstd[row0 + ai * HALF + m * 16];
                const f32x4 b0 = *(const f32x4*)(bfor + 8 * fq), b1 = *(const f32x4*)(bfor + 8 * fq + 4);
#pragma unroll
                for (int ai = 0; ai < 2; ++ai)
#pragma unroll
                    for (int m = 0; m < 4; ++m) { const int row = row0 + ai * HALF + m * 16;
#pragma unroll
                        for (int n = 0; n < 2; ++n) { const f32x4 v = acc[ai][0][m][n] * rs[ai][m]; const f32x4 b = n ? b1 : b0; f32x4 o;
#pragma unroll
                            for (int j = 0; j < 4; ++j) { const float z = v[j] + b[j]; o[j] = fminf(z, 0.f) - log1pf(expf(-fabsf(z))); }
                            *(f32x4*)(lf + (size_t)row * 16 + 8 * fq + 4 * n) = o; } }
            }
            return;
        }
#pragma unroll
        for (int ai = 0; ai < 2; ++ai)
#pragma unroll
            for (int m = 0; m < 4; ++m) rs[ai][m] = rstd[row0 + ai * HALF + m * 16];
        bf16_t* base = q4 + (size_t)(pn >> 3) * ((size_t)16384 * 2048);
        const int col0 = (pn & 7) * BM + wc * 32 + 8 * fq;
        float mxh[2] = {0.f, 0.f};
#pragma unroll
        for (int ai = 0; ai < 2; ++ai)
#pragma unroll
            for (int m = 0; m < 4; ++m) { const int row = row0 + ai * HALF + m * 16; const float r = rs[ai][m]; bf16_t* rowp = base + (size_t)row * 2048 + col0;
#pragma unroll
                for (int bj = 0; bj < 2; ++bj) { const f32x4 v0 = acc[ai][bj][m][0] * r, v1 = acc[ai][bj][m][1] * r; *(u32x4*)(rowp + bj * HALF) = pack8(v0, v1);
                    if (pn < 16) { float ss = (v0[0] * v0[0] + v0[1] * v0[1]) + (v0[2] * v0[2] + v0[3] * v0[3]) + (v1[0] * v1[0] + v1[1] * v1[1]) + (v1[2] * v1[2] + v1[3] * v1[3]);
                        ss += __shfl_xor(ss, 16); ss += __shfl_xor(ss, 32); mxh[bj] = fmaxf(mxh[bj], ss); } } }
        if (pn < 16) {
#pragma unroll
            for (int bj = 0; bj < 2; ++bj) { float v = mxh[bj]; v = fmaxf(v, __shfl_xor(v, 1)); v = fmaxf(v, __shfl_xor(v, 2)); v = fmaxf(v, __shfl_xor(v, 4)); v = fmaxf(v, __shfl_xor(v, 8));
                if (fr == 0 && fq == 0) (void)__hip_atomic_fetch_max(nrm + (((pn >> 3) * 64 + (u.pm >> 4) * 16 + 2 * (pn & 7) + bj) * 4 + wc), __builtin_bit_cast(unsigned, v), __ATOMIC_RELAXED, __HIP_MEMORY_SCOPE_AGENT); }
        }
    }
};
template <size_t OQB, size_t OKB, size_t OVB>
struct EpiGates8 {
    static constexpr bool PERM = true, AFTER_DRAIN = false, DUAL = false, I8 = true; typedef i32x4 acc_t;
    const float* sx; const unsigned* cmax; unsigned char* wsb; bf16_t* gr; bf16_t* gs;
    __device__ __forceinline__ void operator()(const i32x4 (&acc)[2][2][4][2], const Unit& u, int wr, int wc, int fr, int fq) const {
        const int row0 = u.pm * BM + wr * 64 + fr, cl = wc * 32 + 8 * fq; const int pn = u.pn;
        float rs[2][4];
#pragma unroll
        for (int ai = 0; ai < 2; ++ai)
#pragma unroll
            for (int m = 0; m < 4; ++m) rs[ai][m] = sx[row0 + ai * HALF + m * 16];
        f32x4 sc[2][2];
#pragma unroll
        for (int bj = 0; bj < 2; ++bj) { const f32x4* c = (const f32x4*)(cmax + pn * BM + bj * HALF + cl); sc[bj][0] = c[0] * (1.f / 127.f); sc[bj][1] = c[1] * (1.f / 127.f); }
        if (pn >= 10) {
            const int col0 = (pn - 10) * HALF + cl; const float T = 9.094947017729282e-13f;
#pragma unroll
            for (int ai = 0; ai < 2; ++ai)
#pragma unroll
                for (int m = 0; m < 4; ++m) { const size_t off = (size_t)(row0 + ai * HALF + m * 16) * 4096 + col0; const float r = rs[ai][m];
#if GATES_U8
                    unsigned wa[2] = {0u, 0u}, wb[2] = {0u, 0u};
#pragma unroll
                    for (int n = 0; n < 2; ++n)
#pragma unroll
                        for (int j = 0; j < 4; ++j) {
                            const float a = sigmoid_f((float)acc[ai][0][m][n][j] * (r * sc[0][n][j])), b = sigmoid_f((float)acc[ai][1][m][n][j] * (r * sc[1][n][j]));
                            wa[n] |= (unsigned)__builtin_rintf(a * 255.f) << (8 * j); wb[n] |= (unsigned)fmaxf(__builtin_rintf(b * 255.f), 1.f) << (8 * j); }
                    *(u32x2*)((unsigned char*)gr + off) = (u32x2){wa[0], wa[1]}; *(u32x2*)((unsigned char*)gs + off) = (u32x2){wb[0], wb[1]};
#else
                    f32x4 r0, r1, s0, s1;
#pragma unroll
                    for (int j = 0; j < 4; ++j) {
                        const float a0 = sigmoid_f((float)acc[ai][0][m][0][j] * (r * sc[0][0][j])), a1 = sigmoid_f((float)acc[ai][0][m][1][j] * (r * sc[0][1][j]));
                        s0[j] = fmaxf(sigmoid_f((float)acc[ai][1][m][0][j] * (r * sc[1][0][j])), T); s1[j] = fmaxf(sigmoid_f((float)acc[ai][1][m][1][j] * (r * sc[1][1][j])), T);
                        r0[j] = a0 * __builtin_amdgcn_rcpf(s0[j]); r1[j] = a1 * __builtin_amdgcn_rcpf(s1[j]); }
                    *(u32x4*)(gr + off) = pack8(r0, r1); *(u32x4*)(gs + off) = pack8(s0, s1);
#endif
                    __builtin_amdgcn_sched_barrier(0); }
            return;
        }
        size_t boff = OQB; int ldc = 2048, colt = pn * BM;
        if (pn == 8) boff = OKB; if (pn == 9) boff = OVB; if (pn >= 8) { ldc = 256; colt = 0; }
        bf16_t* base = (bf16_t*)(wsb + boff);
        const int col0 = colt + cl;
#pragma unroll
        for (int ai = 0; ai < 2; ++ai)
#pragma unroll
            for (int m = 0; m < 4; ++m) { const int row = row0 + ai * HALF + m * 16; const float r = rs[ai][m]; bf16_t* rowp = base + (size_t)row * ldc + col0;
#pragma unroll
                for (int bj = 0; bj < 2; ++bj) { f32x4 v0, v1;
#pragma unroll
                    for (int j = 0; j < 4; ++j) { v0[j] = (float)acc[ai][bj][m][0][j] * (r * sc[bj][0][j]); v1[j] = (float)acc[ai][bj][m][1][j] * (r * sc[bj][1][j]); }
                    *(u32x4*)(rowp + bj * HALF) = pack8(v0, v1); } }
    }
};
struct EpiMix {
    static constexpr bool PERM = true, AFTER_DRAIN = false, DUAL = true, I8 = false; typedef f32x4 acc_t;
    const bf16_t* gr; const bf16_t* gs; bf16_t* mixed;
#if GATES_U8
    template <bool FINAL> __device__ __forceinline__ void run(f32x4 (&acc)[2][2][4][2], const Unit& u, int wr, int wc, int fr, int fq) const {
        const int row0 = u.pm * BM + wr * 64 + fr, col0 = u.pn * BM + wc * 32 + 8 * fq;
        const unsigned char* ga8 = (const unsigned char*)gr; const unsigned char* gb8 = (const unsigned char*)gs;
        u32x2 pa[2] = {}, pb[2], na[2] = {}, nb[2];
        { const size_t off = (size_t)row0 * 4096 + col0; pb[0] = *(const u32x2*)(gb8 + off); pb[1] = *(const u32x2*)(gb8 + off + HALF);
          if (!FINAL) { pa[0] = *(const u32x2*)(ga8 + off); pa[1] = *(const u32x2*)(ga8 + off + HALF); } }
#pragma unroll
        for (int it = 0; it < 8; ++it) { const int ai = it >> 2, m = it & 3; const size_t off = (size_t)(row0 + ai * HALF + m * 16) * 4096 + col0;
            if (it + 1 < 8) { const size_t offn = (size_t)(row0 + ((it + 1) >> 2) * HALF + ((it + 1) & 3) * 16) * 4096 + col0; nb[0] = *(const u32x2*)(gb8 + offn); nb[1] = *(const u32x2*)(gb8 + offn + HALF);
                if (!FINAL) { na[0] = *(const u32x2*)(ga8 + offn); na[1] = *(const u32x2*)(ga8 + offn + HALF); } }
#pragma unroll
            for (int bj = 0; bj < 2; ++bj) { f32x4 v0 = acc[ai][bj][m][0], v1 = acc[ai][bj][m][1];
#pragma unroll
                for (int j = 0; j < 4; ++j) {
                    const float b0 = (float)((pb[bj].x >> (8 * j)) & 255u), b1 = (float)((pb[bj].y >> (8 * j)) & 255u);
                    if (FINAL) { v0[j] *= b0 * (1.f / 255.f); v1[j] *= b1 * (1.f / 255.f); }
                    else { v0[j] *= (float)((pa[bj].x >> (8 * j)) & 255u) * __builtin_amdgcn_rcpf(b0); v1[j] *= (float)((pa[bj].y >> (8 * j)) & 255u) * __builtin_amdgcn_rcpf(b1); } }
                if (FINAL) *(u32x4*)(mixed + off + bj * HALF) = pack8(v0, v1); else { acc[ai][bj][m][0] = v0; acc[ai][bj][m][1] = v1; } }
            pb[0] = nb[0]; pb[1] = nb[1]; if (!FINAL) { pa[0] = na[0]; pa[1] = na[1]; } }
    }
#else
    template <bool FINAL> __device__ __forceinline__ void run(f32x4 (&acc)[2][2][4][2], const Unit& u, int wr, int wc, int fr, int fq) const {
        const int row0 = u.pm * BM + wr * 64 + fr, col0 = u.pn * BM + wc * 32 + 8 * fq; const bf16_t* g = FINAL ? gs : gr;
        u32x4 b[2], bn[2];
        { const size_t off = (size_t)row0 * 4096 + col0; b[0] = *(const u32x4*)(g + off); b[1] = *(const u32x4*)(g + off + HALF); }
#pragma unroll
        for (int it = 0; it < 8; ++it) { const int ai = it >> 2, m = it & 3; const size_t off = (size_t)(row0 + ai * HALF + m * 16) * 4096 + col0;
            if (it + 1 < 8) { const size_t offn = (size_t)(row0 + ((it + 1) >> 2) * HALF + ((it + 1) & 3) * 16) * 4096 + col0; bn[0] = *(const u32x4*)(g + offn); bn[1] = *(const u32x4*)(g + offn + HALF); }
#pragma unroll
            for (int bj = 0; bj < 2; ++bj) { const u32x4 y = b[bj]; f32x4 v0 = acc[ai][bj][m][0], v1 = acc[ai][bj][m][1];
                v0[0] *= bf_lo(y.x); v0[1] *= bf_hi(y.x); v0[2] *= bf_lo(y.y); v0[3] *= bf_hi(y.y); v1[0] *= bf_lo(y.z); v1[1] *= bf_hi(y.z); v1[2] *= bf_lo(y.w); v1[3] *= bf_hi(y.w);
                if (FINAL) *(u32x4*)(mixed + off + bj * HALF) = pack8(v0, v1); else { acc[ai][bj][m][0] = v0; acc[ai][bj][m][1] = v1; } }
            b[0] = bn[0]; b[1] = bn[1]; }
    }
#endif
    __device__ __forceinline__ void mid(f32x4 (&acc)[2][2][4][2], const Unit& u, int wr, int wc, int fr, int fq) const { run<false>(acc, u, wr, wc, fr, fq); }
    __device__ __forceinline__ void operator()(f32x4 (&acc)[2][2][4][2], const Unit& u, int wr, int wc, int fr, int fq) const { run<true>(acc, u, wr, wc, fr, fq); }
};
struct EpiOutX1 {
    static constexpr bool PERM = true, AFTER_DRAIN = false, DUAL = false, I8 = false; typedef f32x4 acc_t;
    const bf16_t* res; bf16_t* cp;
    __device__ __forceinline__ void operator()(const f32x4 (&acc)[2][2][4][2], const Unit& u, int wr, int wc, int fr, int fq) const {
        const int row0 = u.pm * BM + wr * 64 + fr, col0 = u.pn * BM + wc * 32 + 8 * fq;
        u32x4 p[2], pn[2];
        { const size_t off = (size_t)row0 * 4096 + col0; p[0] = *(const u32x4*)(res + off); p[1] = *(const u32x4*)(res + off + HALF); }
#pragma unroll
        for (int it = 0; it < 8; ++it) { const int ai = it >> 2, m = it & 3; const size_t off = (size_t)(row0 + ai * HALF + m * 16) * 4096 + col0;
            if (it + 1 < 8) { const size_t offn = (size_t)(row0 + ((it + 1) >> 2) * HALF + ((it + 1) & 3) * 16) * 4096 + col0; pn[0] = *(const u32x4*)(res + offn); pn[1] = *(const u32x4*)(res + offn + HALF); }
#pragma unroll
            for (int bj = 0; bj < 2; ++bj) { const u32x4 q = p[bj]; f32x4 v0 = acc[ai][bj][m][0], v1 = acc[ai][bj][m][1];
                v0[0] += bf_lo(q.x); v0[1] += bf_hi(q.x); v0[2] += bf_lo(q.y); v0[3] += bf_hi(q.y); v1[0] += bf_lo(q.z); v1[1] += bf_hi(q.z); v1[2] += bf_lo(q.w); v1[3] += bf_hi(q.w);
                *(u32x4*)(cp + off + bj * HALF) = pack8(v0, v1); }
            p[0] = pn[0]; p[1] = pn[1]; }
    }
};
struct EpiDownX2 {
    static constexpr bool PERM = true, AFTER_DRAIN = false, DUAL = false, I8 = false; typedef f32x4 acc_t;
    const bf16_t* xb; bf16_t* xo;
    __device__ __forceinline__ void operator()(const f32x4 (&acc)[2][2][4][2], const Unit& u, int wr, int wc, int fr, int fq) const {
        const int row0 = u.pm * BM + wr * 64 + fr, col0 = u.pn * BM + wc * 32 + 8 * fq;
        u32x4 p[2], pn[2];
        { const size_t off = (size_t)row0 * 4096 + col0; p[0] = *(const u32x4*)(xb + off); p[1] = *(const u32x4*)(xb + off + HALF); }
#pragma unroll
        for (int it = 0; it < 8; ++it) { const int ai = it >> 2, m = it & 3; const size_t off = (size_t)(row0 + ai * HALF + m * 16) * 4096 + col0;
            if (it + 1 < 8) { const size_t offn = (size_t)(row0 + ((it + 1) >> 2) * HALF + ((it + 1) & 3) * 16) * 4096 + col0; pn[0] = *(const u32x4*)(xb + offn); pn[1] = *(const u32x4*)(xb + offn + HALF); }
#pragma unroll
            for (int bj = 0; bj < 2; ++bj) { const u32x4 q = p[bj]; f32x4 v0 = acc[ai][bj][m][0], v1 = acc[ai][bj][m][1];
                v0[0] += bf_lo(q.x); v0[1] += bf_hi(q.x); v0[2] += bf_lo(q.y); v0[3] += bf_hi(q.y); v1[0] += bf_lo(q.z); v1[1] += bf_hi(q.z); v1[2] += bf_lo(q.w); v1[3] += bf_hi(q.w);
                *(u32x4*)(xo + off + bj * HALF) = pack8(v0, v1); }
            p[0] = pn[0]; p[1] = pn[1]; }
    }
};
struct EpiSwiGLU {
    static constexpr bool PERM = true, AFTER_DRAIN = false, DUAL = false, I8 = false; typedef f32x4 acc_t;
    const float* rstd; bf16_t* hid; int pn0;
    __device__ __forceinline__ void operator()(const f32x4 (&acc)[2][2][4][2], const Unit& u, int wr, int wc, int fr, int fq) const {
        const int row0 = u.pm * BM + wr * 64 + fr, col0 = (u.pn + pn0) * HALF + wc * 32 + 8 * fq;
        float rs[2][4];
#pragma unroll
        for (int ai = 0; ai < 2; ++ai)
#pragma unroll
            for (int m = 0; m < 4; ++m) rs[ai][m] = rstd[row0 + ai * HALF + m * 16];
#pragma unroll
        for (int ai = 0; ai < 2; ++ai)
#pragma unroll
            for (int m = 0; m < 4; ++m) { const int row = row0 + ai * HALF + m * 16; const float r = rs[ai][m];
                f32x4 h0, h1;
#pragma unroll
                for (int j = 0; j < 4; ++j) { const float g0 = acc[ai][0][m][0][j] * r, g1 = acc[ai][0][m][1][j] * r;
                    h0[j] = g0 * sigmoid_f(g0) * (acc[ai][1][m][0][j] * r); h1[j] = g1 * sigmoid_f(g1) * (acc[ai][1][m][1][j] * r); }
                *(u32x4*)(hid + (size_t)row * 11008 + col0) = pack8(h0, h1); }
    }
};

struct EpiSwiGLU8 {
    static constexpr bool PERM = true, AFTER_DRAIN = false, DUAL = false, I8 = true; typedef i32x4 acc_t;
    const float* sa; const unsigned* cmax; bf16_t* hid;
    __device__ __forceinline__ void operator()(const i32x4 (&acc)[2][2][4][2], const Unit& u, int wr, int wc, int fr, int fq) const {
        const int row0 = u.pm * BM + wr * 64 + fr, cl = wc * 32 + 8 * fq, col0 = u.pn * HALF + cl;
        float rs[2][4];
#pragma unroll
        for (int ai = 0; ai < 2; ++ai)
#pragma unroll
            for (int m = 0; m < 4; ++m) rs[ai][m] = sa[row0 + ai * HALF + m * 16];
        const f32x4* cg = (const f32x4*)(cmax + u.pn * BM + cl); const f32x4* cu = (const f32x4*)(cmax + u.pn * BM + HALF + cl);
        const f32x4 sg0 = cg[0] * (1.f / 127.f), sg1 = cg[1] * (1.f / 127.f), su0 = cu[0] * (1.f / 127.f), su1 = cu[1] * (1.f / 127.f);
#pragma unroll
        for (int ai = 0; ai < 2; ++ai)
#pragma unroll
            for (int m = 0; m < 4; ++m) { const int row = row0 + ai * HALF + m * 16; const float r = rs[ai][m];
                f32x4 h0, h1;
#pragma unroll
                for (int j = 0; j < 4; ++j) { const float g0 = (float)acc[ai][0][m][0][j] * (r * sg0[j]), g1 = (float)acc[ai][0][m][1][j] * (r * sg1[j]);
                    h0[j] = g0 * sigmoid_f(g0) * ((float)acc[ai][1][m][0][j] * (r * su0[j])); h1[j] = g1 * sigmoid_f(g1) * ((float)acc[ai][1][m][1][j] * (r * su1[j])); }
                *(u32x4*)(hid + (size_t)row * 11008 + col0) = pack8(h0, h1); }
    }
};

struct EpiNull8 {
    static constexpr bool PERM = true, AFTER_DRAIN = false, DUAL = false, I8 = true; typedef i32x4 acc_t;
    bf16_t* sink;
    __device__ __forceinline__ void operator()(const i32x4 (&acc)[2][2][4][2], const Unit& u, int wr, int wc, int fr, int fq) const {
        if (sink == nullptr) {
#pragma unroll
            for (int ai = 0; ai < 2; ++ai)
#pragma unroll
                for (int m = 0; m < 4; ++m)
#pragma unroll
                    for (int bj = 0; bj < 2; ++bj) *(i32x4*)((int*)nullptr + (size_t)(ai * 4 + m) * 4096 + bj * HALF + fr * 8 + fq * 1024 + u.pm) = acc[ai][bj][m][0] + acc[ai][bj][m][1]; }
    }
};

struct EpiNull {
    static constexpr bool PERM = true, AFTER_DRAIN = false, DUAL = false, I8 = false; typedef f32x4 acc_t;
    bf16_t* sink;
    __device__ __forceinline__ void operator()(const f32x4 (&acc)[2][2][4][2], const Unit& u, int wr, int wc, int fr, int fq) const {
        if (sink == nullptr) {
#pragma unroll
            for (int ai = 0; ai < 2; ++ai)
#pragma unroll
                for (int m = 0; m < 4; ++m)
#pragma unroll
                    for (int bj = 0; bj < 2; ++bj) *(u32x4*)((bf16_t*)nullptr + (size_t)(ai * 4 + m) * 4096 + bj * HALF + fr * 8 + fq * 1024 + u.pm) = pack8(acc[ai][bj][m][0], acc[ai][bj][m][1]); }
    }
};


template <class Epi, class Sched, bool ALIGN_EPI = false, bool SP2 = false>
__device__ __forceinline__ void gemm_phase(PG8_LAS unsigned char* lds, const Gemm g, const Sched& S, const Epi& E) {
    const int tid = threadIdx.x, wid = __builtin_amdgcn_readfirstlane(tid >> 6), lane = tid & 63, wr = wid >> 2, wc = wid & 3, fr = lane & 15, fq = lane >> 4;
    constexpr bool I8 = Epi::I8;
    typedef typename Epi::acc_t acc_t;
    const int pitchB = g.K * (I8 ? 1 : 2), nt = pitchB / (BK * 2);
    unsigned voffA[2], voffB[2];
#pragma unroll
    for (int i = 0; i < 2; ++i) { int R, C; stage_rc(tid * 16 + i * 8192, R, C); const int Rb = Epi::PERM ? ((R & ~31) + perm32(R & 31)) : R;
        voffA[i] = (unsigned)(R * pitchB + C * 2); voffB[i] = (unsigned)(Rb * pitchB + C * 2); }
    const size_t kstep = (size_t)(BK * 2);
    const size_t hstep = (size_t)HALF * pitchB;
    const size_t tstep = 2 * hstep;
    const unsigned ldsw = (unsigned)wid * 1024u;
    const int aoff = lds_byte(wr * 64 + fr, fq * 8), boff = lds_byte(wc * 32 + fr, fq * 8);
#define PG8_SA(b, h) (((b) * 2 + (h)) * HTB)
#define PG8_SB(b, h) ((4 + (b) * 2 + (h)) * HTB)
#define PG8_STAGE(bufoff, gbase, voff) do { _Pragma("unroll") for (int _i = 0; _i < 2; ++_i) \
        __builtin_amdgcn_global_load_lds((const unsigned*)((const char*)(gbase) + (voff)[_i]), (PG8_LAS unsigned*)(lds + (bufoff) + ldsw + _i * 8192), 16, 0, 0); } while (0)
#define PG8_LDA(dst, b, h) do { _Pragma("unroll") for (int m = 0; m < 4; ++m) _Pragma("unroll") for (int k = 0; k < 2; ++k) dst[m][k] = *(const PG8_LAS bf16x8*)(lds + PG8_SA(b, h) + aoff + m * 2048 + k * 1024); } while (0)
#define PG8_LDB(dst, b, h) do { _Pragma("unroll") for (int n = 0; n < 2; ++n) _Pragma("unroll") for (int k = 0; k < 2; ++k) dst[n][k] = *(const PG8_LAS bf16x8*)(lds + PG8_SB(b, h) + boff + n * 2048 + k * 1024); } while (0)
#define PG8_MMA(ai, bj, At, Bt) do { __builtin_amdgcn_s_setprio(1); _Pragma("unroll") for (int m = 0; m < 4; ++m) _Pragma("unroll") for (int n = 0; n < 2; ++n) _Pragma("unroll") for (int k = 0; k < 2; ++k) \
        acc[ai][bj][m][n] = mma16(Bt[n][k], At[m][k], acc[ai][bj][m][n]); __builtin_amdgcn_s_setprio(0); } while (0)
#define PG8_WAIT_V(n) asm volatile("s_waitcnt vmcnt(" #n ")" ::: "memory")
#define PG8_WAIT_L(n) asm volatile("s_waitcnt lgkmcnt(" #n ")" ::: "memory")
#define PG8_BAR __builtin_amdgcn_s_barrier()
#define PG8_SCHED __builtin_amdgcn_sched_barrier(0)
    Unit cur, nxt; int ui = 0;
    if (!S.next(0, cur)) return;
    acc_t acc[2][2][4][2];
#pragma unroll
    for (int a = 0; a < 2; ++a)
#pragma unroll
        for (int b = 0; b < 2; ++b)
#pragma unroll
            for (int m = 0; m < 4; ++m)
#pragma unroll
                for (int n = 0; n < 2; ++n) acc[a][b][m][n] = acc_t{};
    bf16x8 At[4][2], B0[2][2], B1[2][2];
    const char* cA = (const char*)(cur.src ? g.A2 : g.A) + (size_t)cur.pm * tstep; const char* cB = (const char*)(cur.src ? g.Bt2 : g.Bt) + (size_t)cur.pn * tstep;
    S.a_ready(cur);
    if constexpr (SP2) {
        PG8_STAGE(PG8_SB(0, 0), cB, voffB); PG8_STAGE(PG8_SB(0, 1), cB + hstep, voffB); PG8_STAGE(PG8_SA(0, 0), cA, voffA); PG8_STAGE(PG8_SA(0, 1), cA + hstep, voffA);
        if (wr == 1) PG8_BAR;
        PG8_WAIT_V(2); PG8_BAR;
        PG8_STAGE(PG8_SB(1, 0), cB + kstep, voffB); PG8_STAGE(PG8_SA(1, 0), cA + kstep, voffA); PG8_STAGE(PG8_SB(1, 1), cB + hstep + kstep, voffB);
        PG8_WAIT_V(6); PG8_BAR;
    } else {
        PG8_STAGE(PG8_SB(0, 0), cB, voffB); PG8_STAGE(PG8_SA(0, 0), cA, voffA); PG8_STAGE(PG8_SB(0, 1), cB + hstep, voffB); PG8_STAGE(PG8_SA(0, 1), cA + hstep, voffA);
        if (wr == 1) PG8_BAR;
        PG8_WAIT_V(4); PG8_BAR;
        PG8_STAGE(PG8_SB(1, 0), cB + kstep, voffB); PG8_STAGE(PG8_SA(1, 0), cA + kstep, voffA); PG8_STAGE(PG8_SB(1, 1), cB + hstep + kstep, voffB);
        PG8_WAIT_V(6); PG8_BAR;
    }
    for (;;) {
        const bool has_next = S.next(ui + 1, nxt);
        const char* nA = has_next ? (const char*)(nxt.src ? g.A2 : g.A) + (size_t)nxt.pm * tstep : cA; const char* nB = has_next ? (const char*)(nxt.src ? g.Bt2 : g.Bt) + (size_t)nxt.pn * tstep : cB;
        for (int t = 0; t < nt; t += 2) {
            const bool last = (t == nt - 2);
            const char* a1 = cA + (size_t)(t + 1) * kstep;
            const char* a2 = last ? nA : cA + (size_t)(t + 2) * kstep; const char* b2 = last ? nB : cB + (size_t)(t + 2) * kstep;
            const char* a3 = a2 + kstep; const char* b3 = b2 + kstep;
            if (last && has_next) S.a_ready(nxt);
            if constexpr (SP2) {
            PG8_LDB(B0, 0, 0); PG8_LDB(B1, 0, 1); PG8_SCHED; PG8_LDA(At, 0, 0); PG8_STAGE(PG8_SA(1, 1), a1 + hstep, voffA);
            PG8_WAIT_V(8); PG8_WAIT_L(0); PG8_BAR; PG8_MMA(0, 0, At, B0); PG8_MMA(0, 1, At, B1); PG8_BAR; PG8_SCHED;
            PG8_LDA(At, 0, 1); PG8_STAGE(PG8_SB(0, 0), b2, voffB); PG8_STAGE(PG8_SB(0, 1), b2 + hstep, voffB); PG8_STAGE(PG8_SA(0, 0), a2, voffA);
            PG8_WAIT_V(8); PG8_WAIT_L(0); PG8_BAR; PG8_MMA(1, 0, At, B0); PG8_MMA(1, 1, At, B1); PG8_BAR; PG8_SCHED;
            PG8_LDB(B0, 1, 0); PG8_LDB(B1, 1, 1); PG8_SCHED; PG8_LDA(At, 1, 0); PG8_STAGE(PG8_SA(0, 1), a2 + hstep, voffA);
            PG8_WAIT_V(8); PG8_WAIT_L(0); PG8_BAR; PG8_MMA(0, 0, At, B0); PG8_MMA(0, 1, At, B1); PG8_BAR; PG8_SCHED;
            PG8_LDA(At, 1, 1); PG8_STAGE(PG8_SB(1, 0), b3, voffB); PG8_STAGE(PG8_SB(1, 1), b3 + hstep, voffB); PG8_STAGE(PG8_SA(1, 0), a3, voffA);
            PG8_WAIT_V(8); PG8_WAIT_L(0); PG8_BAR; PG8_MMA(1, 0, At, B0); PG8_MMA(1, 1, At, B1); PG8_BAR; PG8_SCHED;
            } else {
            PG8_LDB(B0, 0, 0); PG8_SCHED; PG8_LDA(At, 0, 0); PG8_STAGE(PG8_SA(1, 1), a1 + hstep, voffA);
            PG8_WAIT_L(8); PG8_BAR; PG8_WAIT_L(0); PG8_MMA(0, 0, At, B0); PG8_BAR; PG8_SCHED;
            PG8_LDB(B1, 0, 1); PG8_STAGE(PG8_SB(0, 0), b2, voffB);
            PG8_BAR; PG8_WAIT_L(0); PG8_MMA(0, 1, At, B1); PG8_BAR;
            PG8_LDA(At, 0, 1); PG8_STAGE(PG8_SA(0, 0), a2, voffA);
            PG8_BAR; PG8_WAIT_L(0); PG8_MMA(1, 0, At, B0); PG8_BAR; PG8_SCHED;
            PG8_STAGE(PG8_SB(0, 1), b2 + hstep, voffB);
            PG8_WAIT_V(6); PG8_BAR; PG8_MMA(1, 1, At, B1); PG8_BAR;
            PG8_LDB(B0, 1, 0); PG8_SCHED; PG8_LDA(At, 1, 0); PG8_STAGE(PG8_SA(0, 1), a2 + hstep, voffA);
            PG8_WAIT_L(8); PG8_BAR; PG8_WAIT_L(0); PG8_MMA(0, 0, At, B0); PG8_BAR; PG8_SCHED;
            PG8_LDB(B1, 1, 1); PG8_STAGE(PG8_SB(1, 0), b3, voffB);
            PG8_BAR; PG8_WAIT_L(0); PG8_MMA(0, 1, At, B1); PG8_BAR;
            PG8_LDA(At, 1, 1); PG8_STAGE(PG8_SA(1, 0), a3, voffA);
            PG8_BAR; PG8_WAIT_L(0); PG8_MMA(1, 0, At, B0); PG8_BAR; PG8_SCHED;
            PG8_STAGE(PG8_SB(1, 1), b3 + hstep, voffB);
            PG8_WAIT_V(6); PG8_BAR; PG8_MMA(1, 1, At, B1); PG8_BAR;
            }
        }
        if constexpr (ALIGN_EPI) { if (wr == 0) PG8_BAR; }
        bool keep_acc = false;
        if constexpr (Epi::DUAL) { if (cur.src == 0) { E.mid(acc, cur, wr, wc, fr, fq); keep_acc = true; } }
        if (!keep_acc) { E(acc, cur, wr, wc, fr, fq); S.done(cur); }
        if (!has_next) break;
        if (!keep_acc) {
#pragma unroll
        for (int a = 0; a < 2; ++a)
#pragma unroll
            for (int b = 0; b < 2; ++b)
#pragma unroll
                for (int m = 0; m < 4; ++m)
#pragma unroll
                    for (int n = 0; n < 2; ++n) acc[a][b][m][n] = acc_t{};
        }
        cur = nxt; cA = nA; cB = nB; ++ui;
        if constexpr (ALIGN_EPI) { if (wr == 1) PG8_BAR; }
    }
    PG8_WAIT_V(0);
    if constexpr (!ALIGN_EPI) { if (wr == 0) PG8_BAR; }
    PG8_BAR;
#undef PG8_SA
#undef PG8_SB
#undef PG8_STAGE
#undef PG8_LDA
#undef PG8_LDB
#undef PG8_MMA
#undef PG8_WAIT_V
#undef PG8_WAIT_L
#undef PG8_BAR
#undef PG8_SCHED
}
}
namespace fox {
using bf16 = unsigned short;
typedef short bf16x8 __attribute__((ext_vector_type(8)));
typedef short s16x4 __attribute__((ext_vector_type(4)));
typedef float f32x16 __attribute__((ext_vector_type(16)));
typedef float f32x4 __attribute__((ext_vector_type(4)));
typedef unsigned u32x4 __attribute__((ext_vector_type(4)));
template <class A, class Bt> struct same_t { static constexpr bool v = false; };
template <class A> struct same_t<A, A> { static constexpr bool v = true; };
constexpr int D = 128, PITCH = 2048;
constexpr float SCALE = 0.08838834764831845f;
constexpr float THR = 8.f;
constexpr bool WSKIP = true;
constexpr int NW = 8, QBLK = 32, KVBLK = 64, QB = NW * QBLK;
constexpr int SHM_V = KVBLK * D * 2, SHM_K = KVBLK * D * 2;
constexpr int LDS_BIAS = 2 * SHM_V + 2 * SHM_K + NW * 64 * 4;
constexpr int LDS_BYTES = LDS_BIAS + 2 * 4096 * 4;
#define KSWZ(row, colB) ((row) * 256 + ((colB) ^ (((row) & 7) << 4)))
#define SBAR() __builtin_amdgcn_sched_barrier(0)
__device__ __forceinline__ int v_st(int k, int c) { const int kk = (k & ~0xC) | ((k & 4) << 1) | ((k & 8) >> 1); return ((kk >> 3) * 4 + (c >> 5)) * 512 + ((kk & 7) * 32 + (c & 31)) * 2; }
__device__ __forceinline__ int v_rd_base(int lane) { return ((lane & 3) << 3) | (((lane >> 2) & 3) << 6) | (((lane >> 4) & 1) << 5) | (((lane >> 5) & 1) << 8); }
constexpr int v_rd_off(int d0, int ks, int half) { return d0 * 512 + ks * 4096 + half * 2048; }
__device__ __forceinline__ int crow(int r, int hi) { return (r & 3) + 8 * (r >> 2) + 4 * hi; }
__device__ __forceinline__ unsigned cvtpk(float lo, float hi) { return pg8::cvt_pk_bf16(lo, hi); }
__device__ __forceinline__ bf16x8 pack8(f32x4 a, f32x4 b) {
    u32x4 w = {cvtpk(a[0], a[1]), cvtpk(a[2], a[3]), cvtpk(b[0], b[1]), cvtpk(b[2], b[3])};
    return *reinterpret_cast<bf16x8*>(&w);
}
template <class T> __device__ __forceinline__ bf16x8 load8(const T* p) {
    if constexpr (same_t<T, float>::v) { return pack8(*(const f32x4*)p, *(const f32x4*)(p + 4)); }
    else { return *reinterpret_cast<const bf16x8*>(p); }
}
__device__ __forceinline__ void mask_tile(f32x16& p0, f32x16& p1, int dq, unsigned W) {
    const float NEG = -__builtin_inff();
#pragma unroll
    for (int r = 0; r < 16; ++r) {
        const int c = (r & 3) + 8 * (r >> 2);
        if ((unsigned)(dq - c) >= W) p0[r] = NEG;
        if ((unsigned)(dq - c - 32) >= W) p1[r] = NEG;
    }
}
__device__ __forceinline__ void partialSM(f32x16& p0, f32x16& p1, float& m_reg, float& mn, float& alpha) {
    float pmax = p0[0]; for (int r = 1; r < 16; ++r) pmax = fmaxf(pmax, p0[r]); for (int r = 0; r < 16; ++r) pmax = fmaxf(pmax, p1[r]);
    { auto rr = __builtin_amdgcn_permlane32_swap(__float_as_uint(pmax), __float_as_uint(pmax), false, false);
      pmax = fmaxf(__uint_as_float(rr[0]), __uint_as_float(rr[1])); }
    constexpr float C2 = 1.4426950408889634f * SCALE;
    if (__builtin_expect(__all((pmax - m_reg) * SCALE <= THR), 1)) { mn = m_reg; alpha = 1.f; }
    else { mn = fmaxf(m_reg, pmax); alpha = __builtin_amdgcn_exp2f((m_reg - mn) * C2); m_reg = mn; }
    const float mnL = -mn * C2;
    for (int r = 0; r < 16; ++r) p0[r] = fmaf(p0[r], C2, mnL); for (int r = 0; r < 16; ++r) p1[r] = fmaf(p1[r], C2, mnL);
    for (int r = 0; r < 16; ++r) p0[r] = __builtin_amdgcn_exp2f(p0[r]);
}
__device__ __forceinline__ void finishSM(f32x16& p0, f32x16& p1, float alpha, float& l_reg, bf16x8& pa0, bf16x8& pa1, bf16x8& pa2, bf16x8& pa3) {
    for (int r = 0; r < 16; ++r) p1[r] = __builtin_amdgcn_exp2f(p1[r]);
    float ps = 0; for (int r = 0; r < 16; ++r) ps += p0[r]; for (int r = 0; r < 16; ++r) ps += p1[r];
    { auto rr = __builtin_amdgcn_permlane32_swap(__float_as_uint(ps), __float_as_uint(ps), false, false);
      ps = __uint_as_float(rr[0]) + __uint_as_float(rr[1]); }
    l_reg = l_reg * alpha + ps;
#define PK4(P, B_, OUT) do { unsigned a0 = cvtpk(P[B_+0], P[B_+1]), a1 = cvtpk(P[B_+2], P[B_+3]);                          \
        unsigned b0 = cvtpk(P[B_+4], P[B_+5]), b1 = cvtpk(P[B_+6], P[B_+7]);                                             \
        auto r0 = __builtin_amdgcn_permlane32_swap(a0, b0, false, false); auto r1 = __builtin_amdgcn_permlane32_swap(a1, b1, false, false); \
        u32x4 w = {r0[0], r1[0], r0[1], r1[1]}; OUT = *reinterpret_cast<bf16x8*>(&w); } while (0)
    PK4(p0, 0, pa0); PK4(p0, 8, pa1); PK4(p1, 0, pa2); PK4(p1, 8, pa3);
#undef PK4
}
template <int KB, bool SK>
__device__ __forceinline__ void qkt(f32x16& p0, f32x16& p1, const char* K_lds, int r32, int hi, const bf16x8* qr, bool act, const char* bias_t) {
    if (SK && !act) { const float NEG = -__builtin_inff();
#pragma unroll
        for (int r = 0; r < 16; ++r) { p0[r] = NEG; p1[r] = NEG; } return; }
#ifdef FOX_NOBIAS
    p0 = f32x16{}; p1 = f32x16{};
#else
#pragma unroll
    for (int g = 0; g < 4; ++g) { const f32x4 b0 = *reinterpret_cast<const f32x4*>(bias_t + g * 32), b1 = *reinterpret_cast<const f32x4*>(bias_t + 128 + g * 32);
        p0[4 * g] = b0[0]; p0[4 * g + 1] = b0[1]; p0[4 * g + 2] = b0[2]; p0[4 * g + 3] = b0[3]; p1[4 * g] = b1[0]; p1[4 * g + 1] = b1[1]; p1[4 * g + 2] = b1[2]; p1[4 * g + 3] = b1[3]; }
#endif
    const char* kb[4];
#pragma unroll
    for (int dd = 0; dd < 4; ++dd) kb[dd] = K_lds + KB * SHM_K + KSWZ(r32, (dd * 16 + hi * 8) * 2);
#pragma unroll
    for (int d0 = 0; d0 < 8; ++d0) { const char* a = kb[d0 & 3] + (d0 >> 2) * 128;
        bf16x8 b0 = *reinterpret_cast<const bf16x8*>(a);
        bf16x8 b1 = *reinterpret_cast<const bf16x8*>(a + 32 * 256);
        p0 = __builtin_amdgcn_mfma_f32_32x32x16_bf16(b0, qr[d0], p0, 0, 0, 0);
        p1 = __builtin_amdgcn_mfma_f32_32x32x16_bf16(b1, qr[d0], p1, 0, 0, 0); }
}
template <int VB, bool SK>
__device__ __forceinline__ void pv_tile(f32x16* o, int vb0, bf16x8 pa0, bf16x8 pa1, bf16x8 pa2, bf16x8 pa3, bool act) {
    if (SK && !act) return;
#define TRRD(dst, off) asm volatile("ds_read_b64_tr_b16 %0, %1 offset:%2" : "=&v"(dst) : "v"(vb0), "i"(off) : "memory")
#define PV_D0(d0) do { s16x4 l0, l1, l2, l3, h0, h1, h2, h3; constexpr int b_ = VB * SHM_V + v_rd_off(d0, 0, 0);     \
        TRRD(l0, b_); TRRD(h0, b_ + 2048); TRRD(l1, b_ + 4096); TRRD(h1, b_ + 6144); TRRD(l2, b_ + 8192); TRRD(h2, b_ + 10240); TRRD(l3, b_ + 12288); TRRD(h3, b_ + 14336); \
        asm volatile("s_waitcnt lgkmcnt(0)" ::: "memory"); SBAR();                 \
        o[d0] = __builtin_amdgcn_mfma_f32_32x32x16_bf16(pa0, (bf16x8){l0[0], l0[1], l0[2], l0[3], h0[0], h0[1], h0[2], h0[3]}, o[d0], 0, 0, 0);   \
        o[d0] = __builtin_amdgcn_mfma_f32_32x32x16_bf16(pa1, (bf16x8){l1[0], l1[1], l1[2], l1[3], h1[0], h1[1], h1[2], h1[3]}, o[d0], 0, 0, 0);   \
        o[d0] = __builtin_amdgcn_mfma_f32_32x32x16_bf16(pa2, (bf16x8){l2[0], l2[1], l2[2], l2[3], h2[0], h2[1], h2[2], h2[3]}, o[d0], 0, 0, 0);   \
        o[d0] = __builtin_amdgcn_mfma_f32_32x32x16_bf16(pa3, (bf16x8){l3[0], l3[1], l3[2], l3[3], h3[0], h3[1], h3[2], h3[3]}, o[d0], 0, 0, 0); } while (0)
    PV_D0(0); PV_D0(1); PV_D0(2); PV_D0(3);
#undef PV_D0
#undef TRRD
}
template <class TIn, class TOut> struct BlockRef { const TIn* Q; const TIn* K; const TIn* V; TOut* O; int P0; int jlo; int boff; };
template <class TIn> struct Seam {
    bf16x8 qr[8];
    bf16x8 st_v0, st_v1, st_k0, st_k1; f32x4 sf0, sf1, sf2, sf3;
    f32x4 tq[16];
};
__device__ __forceinline__ int swa_jlo(int P0, int W) { const int lowk = P0 - W + 1; return lowk > 0 ? lowk / KVBLK : 0; }
#define ROW(p, k0, rr) ((p) + ((size_t)(k0) + ((rr) - sr)) * PITCH + soff)
#define VMW() asm volatile("s_waitcnt vmcnt(0)" ::: "memory")
#define VMWN(n) asm volatile("s_waitcnt vmcnt(%0)" :: "i"(n) : "memory")
#define SLOAD_H(Kp, Vp, k0) do { S.st_v0 = load8<TIn>(ROW(Vp, k0, sr)); S.st_v1 = load8<TIn>(ROW(Vp, k0, 32 + sr));              \
                         S.st_k0 = load8<TIn>(ROW(Kp, k0, sr)); S.st_k1 = load8<TIn>(ROW(Kp, k0, 32 + sr)); } while (0)
#define SWRITE_HK(bf) do { *(bf16x8*)(K_lds + (bf) * SHM_K + kws) = S.st_k0; *(bf16x8*)(K_lds + (bf) * SHM_K + kws + 32 * 256) = S.st_k1; } while (0)
#define SWRITE_HV(bf) do { *(bf16x8*)(V_lds + (bf) * SHM_V + vst0) = S.st_v0; *(bf16x8*)(V_lds + (bf) * SHM_V + vst1) = S.st_v1; } while (0)
#define SWRITE_H(bf) do { SWRITE_HV(bf); SWRITE_HK(bf); } while (0)
#define SLOAD_F(p, k0) do { S.sf0 = *(const f32x4*)ROW(p, k0, sr); S.sf1 = *(const f32x4*)(ROW(p, k0, sr) + 4);                \
                            S.sf2 = *(const f32x4*)ROW(p, k0, 32 + sr); S.sf3 = *(const f32x4*)(ROW(p, k0, 32 + sr) + 4); } while (0)
#define SWRITE_KF(bf) do { *(bf16x8*)(K_lds + (bf) * SHM_K + kws) = pack8(S.sf0, S.sf1); *(bf16x8*)(K_lds + (bf) * SHM_K + kws + 32 * 256) = pack8(S.sf2, S.sf3); } while (0)
#define SWRITE_VF(bf) do { *(bf16x8*)(V_lds + (bf) * SHM_V + vst0) = pack8(S.sf0, S.sf1); *(bf16x8*)(V_lds + (bf) * SHM_V + vst1) = pack8(S.sf2, S.sf3); } while (0)
template <class TIn, class TOut>
__device__ __forceinline__ void causal_swa_prime(const BlockRef<TIn, TOut>& cur, int W, char* lds, Seam<TIn>& S) {
    constexpr bool F32 = same_t<TIn, float>::v;
    const int tid = threadIdx.x, wid = __builtin_amdgcn_readfirstlane(tid >> 6), lane = tid & 63, r32 = lane & 31, hi = lane >> 5;
    const int sr = tid >> 4, sc = (tid & 15) * 8, kws = KSWZ(sr, sc * 2); char* K_lds = lds + 2 * SHM_V; const unsigned soff = (unsigned)(sr * PITCH + sc), qoff = (unsigned)(r32 * PITCH + hi * 8);
    const int kb0 = cur.jlo * KVBLK;
    for (int d0 = 0; d0 < 8; ++d0) S.qr[d0] = load8<TIn>(cur.Q + (size_t)(wid * QBLK) * PITCH + qoff + d0 * 16);
    if constexpr (F32) { SLOAD_F((const float*)cur.K, kb0); VMW(); SWRITE_KF(0); SBAR(); SLOAD_F((const float*)cur.V, kb0); }
    else { SLOAD_H(cur.K, cur.V, kb0); VMW(); SWRITE_HK(0); }
    __syncthreads();
}
template <class TIn, class TOut>
__device__ __forceinline__ void causal_swa_block(const BlockRef<TIn, TOut>& cur, const BlockRef<TIn, TOut>& nxt, int skv, int W, char* lds, Seam<TIn>& S) {
    constexpr bool F32 = same_t<TIn, float>::v;
    const int tid = threadIdx.x, wid = __builtin_amdgcn_readfirstlane(tid >> 6), lane = tid & 63, r32 = lane & 31, hi = lane >> 5;
    const int j_lo = cur.jlo;
    int j_hi = (cur.P0 + QB - 1) / KVBLK + 1; if (j_hi > skv / KVBLK) j_hi = skv / KVBLK;
    const int NT = j_hi - j_lo;
    const int kbn = nxt.jlo * KVBLK;
    const int qlo = cur.P0 + wid * QBLK, qm = qlo + r32 - 4 * hi;
    char* V_lds = lds; char* K_lds = lds + 2 * SHM_V; const char* bias_h = lds + cur.boff + hi * 16;
    float* ws = (float*)(lds + 2 * SHM_V + 2 * SHM_K) + wid * 64; float* li_l = ws, * al_l = ws + 32;
    float m_reg = -1e30f, l_reg = 0; f32x16 o[4] = {};
    const int sr = tid >> 4, sc = (tid & 15) * 8, vst0 = v_st(sr, sc), vst1 = v_st(32 + sr, sc), kws = KSWZ(sr, sc * 2); const unsigned soff = (unsigned)(sr * PITCH + sc), qoff = (unsigned)(r32 * PITCH + hi * 8), ooff = (unsigned)(4 * hi * PITCH + r32);
    const int vb0 = (int)(uintptr_t)V_lds + v_rd_base(lane);
    const TIn* Kh = cur.K; const TIn* Vh = cur.V;
#define RESC(a) do { if (__any((a) < 1.f)) { if (hi == 0) al_l[r32] = (a); asm volatile("s_waitcnt lgkmcnt(0)" ::: "memory");              \
                     for (int d_ = 0; d_ < 4; ++d_) for (int r = 0; r < 16; ++r) o[d_][r] *= al_l[crow(r, hi)]; } } while (0)
#define KBASE(t) ((j_lo + (t)) * KVBLK)
#define BIAS_T(t) (bias_h + KBASE(t) * 4)
#define ACT(t) (KBASE(t) <= qlo + QBLK - 1 && KBASE(t) + KVBLK - 1 >= qlo - W + 1)
#define MASKT(P0_, P1_, t) do { const int kb_ = KBASE(t); if ((!SK || ACT(t)) && (kb_ + KVBLK - 1 > qlo || kb_ <= qlo + QBLK - 1 - W)) mask_tile(P0_, P1_, qm - kb_, (unsigned)W); } while (0)
    constexpr int NQL = F32 ? 16 : 8;
    constexpr bool SK = WSKIP && !F32;
#define SEAM_K0() do { VMWN(NQL); if constexpr (F32) { SWRITE_KF(0); SBAR(); SLOAD_F((const float*)nxt.V, kbn); } else { SWRITE_HK(0); } SBAR(); } while (0)
    f32x16 pA0, pA1, pB0, pB1; float mnA, mnB, alA, alB; bf16x8 pa0, pa1, pa2, pa3;
    if constexpr (F32) { VMW(); SWRITE_VF(0); SBAR(); } else { SWRITE_HV(0); SBAR(); }
    if (NT > 1) { if constexpr (F32) SLOAD_F((const float*)Kh, KBASE(1)); else SLOAD_H(Kh, Vh, KBASE(1)); }
    SBAR(); qkt<0, SK>(pA0, pA1, K_lds, r32, hi, S.qr, ACT(0), BIAS_T(0));
    if constexpr (F32) { if (NT > 1) { VMW(); SWRITE_KF(1); SBAR(); SLOAD_F((const float*)Vh, KBASE(1)); } }
    MASKT(pA0, pA1, 0); partialSM(pA0, pA1, m_reg, mnA, alA);
    if (NT > 1) { VMW(); if constexpr (F32) { SWRITE_VF(1); SBAR(); if (NT > 2) SLOAD_F((const float*)Kh, KBASE(2)); } else SWRITE_H(1); }
    __syncthreads();
#define HALF_STEP(PX0, PX1, mnX, alX, PY0, PY1, alY, t, KB, VB, SB) do {                                                      \
        SBAR(); qkt<KB, SK>(PX0, PX1, K_lds, r32, hi, S.qr, ACT(t), BIAS_T(t));                                             \
        if (!SK || ACT((t) - 1)) finishSM(PY0, PY1, alY, l_reg, pa0, pa1, pa2, pa3); SBAR();     \
        if ((t) + 1 < NT) { if constexpr (F32) { VMW(); SWRITE_KF(SB); SBAR(); SLOAD_F((const float*)Vh, KBASE((t) + 1)); }  \
                            else { SLOAD_H(Kh, Vh, KBASE((t) + 1)); } SBAR(); }                                               \
        pv_tile<VB, SK>(o, vb0, pa0, pa1, pa2, pa3, ACT((t) - 1)); if (!SK || ACT(t)) { MASKT(PX0, PX1, (t)); partialSM(PX0, PX1, m_reg, mnX, alX); } else { mnX = m_reg; alX = 1.f; } \
        __syncthreads();                                                                                                      \
        if ((t) + 1 < NT) { VMW(); if constexpr (F32) { SWRITE_VF(SB); SBAR(); if ((t) + 2 < NT) SLOAD_F((const float*)Kh, KBASE((t) + 2)); } \
                            else { SWRITE_H(SB); } }                                                                          \
        RESC(alX); __syncthreads(); } while (0)
    for (int t = 1; t + 1 < NT; t += 2) {
        HALF_STEP(pB0, pB1, mnB, alB, pA0, pA1, alA, t, 1, 0, 0);
        HALF_STEP(pA0, pA1, mnA, alA, pB0, pB1, alB, t + 1, 0, 1, 1);
    }
    const bool even = (NT & 1) == 0;
    if (even) { SBAR(); qkt<1, SK>(pB0, pB1, K_lds, r32, hi, S.qr, ACT(NT - 1), BIAS_T(NT - 1)); SBAR(); }
#define QROW(e) (nxt.Q + (size_t)(wid * QBLK) * PITCH + qoff + ((e) >> 1) * 16 + ((e) & 1) * 4)
    if constexpr (F32) { SLOAD_F((const float*)nxt.K, kbn); SBAR();
#pragma unroll
        for (int e = 0; e < 8; ++e) S.tq[e] = *(const f32x4*)QROW(e); }
    else { SLOAD_H(nxt.K, nxt.V, kbn); SBAR();
#pragma unroll
        for (int d0 = 0; d0 < 8; ++d0) S.qr[d0] = load8<TIn>(nxt.Q + (size_t)(wid * QBLK) * PITCH + qoff + d0 * 16); }
    SBAR();
    if (!SK || ACT(even ? NT - 2 : NT - 1)) finishSM(pA0, pA1, alA, l_reg, pa0, pa1, pa2, pa3); SBAR();
    if constexpr (F32) {
#pragma unroll
        for (int e = 8; e < 16; ++e) S.tq[e] = *(const f32x4*)QROW(e); SBAR(); }
#undef QROW
    pv_tile<0, SK>(o, vb0, pa0, pa1, pa2, pa3, ACT(even ? NT - 2 : NT - 1));
    if (even) { const bool aL = !SK || ACT(NT - 1); if (aL) { MASKT(pB0, pB1, NT - 1); partialSM(pB0, pB1, m_reg, mnB, alB); } else { mnB = m_reg; alB = 1.f; } __syncthreads(); RESC(alB);
        if (aL) finishSM(pB0, pB1, alB, l_reg, pa0, pa1, pa2, pa3); SBAR(); pv_tile<1, SK>(o, vb0, pa0, pa1, pa2, pa3, ACT(NT - 1)); }
    SBAR(); SEAM_K0();
    if (hi == 0) li_l[r32] = l_reg; asm volatile("s_waitcnt lgkmcnt(0)" ::: "memory");
    float rli[16];
#pragma unroll
    for (int r = 0; r < 16; ++r) rli[r] = __builtin_amdgcn_rcpf(li_l[crow(r, hi)]);
    TOut* Ow = cur.O + (size_t)(wid * QBLK) * PITCH;
#pragma unroll
    for (int r = 0; r < 16; ++r) { const int orow = (r & 3) + 8 * (r >> 2);
#pragma unroll
        for (int d0 = 0; d0 < 4; ++d0) { const float v = o[d0][r] * rli[r];
            if constexpr (same_t<TOut, float>::v) { Ow[(size_t)orow * PITCH + d0 * 32 + ooff] = v; }
            else { const float vn = __shfl_xor(v, 1);
                   if ((r32 & 1) == 0) *(unsigned*)(Ow + (size_t)orow * PITCH + d0 * 32 + ooff) = cvtpk(v, vn); } } }
    if constexpr (F32) {
#pragma unroll
        for (int d0 = 0; d0 < 8; ++d0) S.qr[d0] = pack8(S.tq[2 * d0], S.tq[2 * d0 + 1]); }
    __syncthreads();
#undef RESC
#undef KBASE
#undef BIAS_T
#undef ACT
#undef MASKT
#undef SEAM_K0
#undef HALF_STEP
}
#undef ROW
#undef VMW
#undef VMWN
#undef SLOAD_H
#undef SWRITE_HK
#undef SWRITE_HV
#undef SWRITE_H
#undef SLOAD_F
#undef SWRITE_KF
#undef SWRITE_VF

}
namespace swa {
using bf16 = unsigned short;
typedef short bf16x8 __attribute__((ext_vector_type(8)));
typedef short s16x4 __attribute__((ext_vector_type(4)));
typedef float f32x16 __attribute__((ext_vector_type(16)));
typedef unsigned u32x4 __attribute__((ext_vector_type(4)));
constexpr int KP = 144, VP = 520;
constexpr int LDS_K = 0, LDS_V = 256 * KP, LDS_TBL = LDS_V + 64 * VP, LDS_BYTES = LDS_TBL + 8 * 192 * 4;
constexpr float LOG2E = 1.4426950408889634f;
struct Tensors { const bf16* Q; const bf16* K; const bf16* V; bf16* O; const float* sinks; const float* relb; };
__device__ __forceinline__ int t5_bucket(int d) {
    if (d < 16) return d;
    return 16 + (d >= 19) + (d >= 21) + (d >= 24) + (d >= 27) + (d >= 31) + (d >= 35) + (d >= 40) + (d >= 46) + (d >= 52) + (d >= 59) + (d >= 67) + (d >= 77) + (d >= 87) + (d >= 99) + (d >= 113);
}
__device__ __forceinline__ unsigned cvtpk(float lo, float hi) { return pg8::cvt_pk_bf16(lo, hi); }

__device__ __forceinline__ void swa_unit(char* lds, const Tensors& T, int b, int kvh, int blk) {
    const int tid = threadIdx.x, wid = __builtin_amdgcn_readfirstlane(tid >> 6), lane = tid & 63, c32 = lane & 31, hi = lane >> 5;
    const int hq = kvh * 8 + wid;
    const float NEG = -__builtin_inff();
    const long tok0 = (long)b * 4096 + 128 * (blk - 1);
#pragma unroll
    for (int i = 0; i < 4; ++i) {
        const int id = tid + 512 * i, key = id >> 3, ch = id & 7;
        bf16x8 kv = {0, 0, 0, 0, 0, 0, 0, 0}, vv = {0, 0, 0, 0, 0, 0, 0, 0};
        if (blk > 0 || key >= 128) { const size_t off = (size_t)(tok0 + key) * 256 + kvh * 64 + ch * 8; kv = *(const bf16x8*)(T.K + off); vv = *(const bf16x8*)(T.V + off); }
        *(bf16x8*)(lds + LDS_K + key * KP + ch * 16) = kv;
#pragma unroll
        for (int j = 0; j < 8; ++j) *(short*)(lds + LDS_V + (ch * 8 + j) * VP + key * 2) = vv[j];
    }
    float* tbl = (float*)(lds + LDS_TBL) + wid * 192;
    for (int j = lane; j < 192; j += 64) { const int dist = j - 32; float v = NEG; if (dist >= 0 && dist < 128) v = T.relb[t5_bucket(dist) * 32 + hq] * LOG2E; tbl[j] = v; }
    const float sink2 = T.sinks[hq] * LOG2E;
    __syncthreads();
    const float* tb = tbl + (c32 - 4 * hi + 160);
    for (int a = 0; a < 4; ++a) {
        const size_t qrow = (size_t)b * 4096 + blk * 128 + a * 32 + c32;
        bf16x8 qf[4];
#pragma unroll
        for (int ks = 0; ks < 4; ++ks) qf[ks] = *(const bf16x8*)(T.Q + qrow * 2048 + hq * 64 + ks * 16 + hi * 8);
        f32x16 S[5];
#pragma unroll
        for (int t = 0; t < 5; ++t) {
            S[t] = f32x16{};
            const char* kp = lds + LDS_K + (32 * (a + t) + c32) * KP + hi * 16;
#pragma unroll
            for (int ks = 0; ks < 4; ++ks) { const bf16x8 kf = *(const bf16x8*)(kp + ks * 32); S[t] = __builtin_amdgcn_mfma_f32_32x32x16_bf16(kf, qf[ks], S[t], 0, 0, 0); }
        }
        float mx = sink2;
#pragma unroll
        for (int t = 0; t < 5; ++t) {
            const bool dead = (blk == 0) && (a + t < 4);
#pragma unroll
            for (int r = 0; r < 16; ++r) {
                float s = fmaf(S[t][r], 0.125f * LOG2E, tb[-((r & 3) + 8 * (r >> 2)) - 32 * t]);
                if (dead) s = NEG;
                S[t][r] = s; mx = fmaxf(mx, s);
            }
        }
        mx = fmaxf(mx, __shfl_xor(mx, 32));
        float sum = 0.f;
#pragma unroll
        for (int t = 0; t < 5; ++t)
#pragma unroll
            for (int r = 0; r < 16; ++r) { const float p = __builtin_amdgcn_exp2f(S[t][r] - mx); S[t][r] = p; sum += p; }
        sum += __shfl_xor(sum, 32);
        const float inv = 1.f / (sum + __builtin_amdgcn_exp2f(sink2 - mx));
        f32x16 O0 = f32x16{}, O1 = f32x16{};
#pragma unroll
        for (int t = 0; t < 5; ++t)
#pragma unroll
            for (int s = 0; s < 2; ++s) {
                u32x4 aw; aw.x = cvtpk(S[t][8 * s] * inv, S[t][8 * s + 1] * inv); aw.y = cvtpk(S[t][8 * s + 2] * inv, S[t][8 * s + 3] * inv);
                aw.z = cvtpk(S[t][8 * s + 4] * inv, S[t][8 * s + 5] * inv); aw.w = cvtpk(S[t][8 * s + 6] * inv, S[t][8 * s + 7] * inv);
                const bf16x8 af = __builtin_bit_cast(bf16x8, aw);
                const char* vp = lds + LDS_V + c32 * VP + (32 * (a + t) + 16 * s + 4 * hi) * 2;
                const s16x4 l0 = *(const s16x4*)(vp), h0 = *(const s16x4*)(vp + 16), l1 = *(const s16x4*)(vp + 32 * VP), h1 = *(const s16x4*)(vp + 32 * VP + 16);
                O0 = __builtin_amdgcn_mfma_f32_32x32x16_bf16(af, (bf16x8){l0[0], l0[1], l0[2], l0[3], h0[0], h0[1], h0[2], h0[3]}, O0, 0, 0, 0);
                O1 = __builtin_amdgcn_mfma_f32_32x32x16_bf16(af, (bf16x8){l1[0], l1[1], l1[2], l1[3], h1[0], h1[1], h1[2], h1[3]}, O1, 0, 0, 0);
            }
        bf16* Ob = T.O + ((size_t)b * 4096 + blk * 128 + a * 32) * 2048 + hq * 64;
#pragma unroll
        for (int r = 0; r < 16; ++r) { const int q = (r & 3) + 8 * (r >> 2) + 4 * hi;
            const float v0 = O0[r], v1 = O1[r]; const float n0 = __shfl_xor(v0, 1), n1 = __shfl_xor(v1, 1);
            if ((c32 & 1) == 0) { *(unsigned*)(Ob + (size_t)q * 2048 + c32) = cvtpk(v0, n0); *(unsigned*)(Ob + (size_t)q * 2048 + 32 + c32) = cvtpk(v1, n1); } }
    }
    __syncthreads();
}
}

constexpr int NWAVES = 8;
#ifndef FFN_I8
#define FFN_I8 1
#endif
#ifndef PG_ALIGN
#define PG_ALIGN true
#endif
#ifndef PG_SP2
#define PG_SP2 true
#endif
#ifndef PROBE8_SKIP_BF16
#define PROBE8_SKIP_BF16 0
#endif
#ifndef DEFER_ALL
#define DEFER_ALL 1
#endif
#ifndef DEFER_WD
#define DEFER_WD 1
#endif
#ifndef FFN_I8_TILES
#define FFN_I8_TILES 82
#endif
#ifndef MK_N_LAUNCHES
#define MK_N_LAUNCHES 1
#endif
constexpr int PER_PHASE = 11;
constexpr int N_LAUNCHES = MK_N_LAUNCHES;
static_assert(N_LAUNCHES == 1 || N_LAUNCHES == PER_PHASE, "MK_N_LAUNCHES is 1 or 11");

constexpr int BATCH = 4, SEQ = 4096, DM = 4096, M = BATCH * SEQ;
constexpr int H_A = 16, H_B = 32, HKV_B = 4;
constexpr int W_IN = 16912, D_FF = 11008;
constexpr int N_IN = pg8::IN_TILES * 256;
constexpr int N_INQ = pg8::INQ_TILES * 256;
constexpr int N_WIN = N_IN + N_INQ;
constexpr float EPS = 1e-6f;

constexpr size_t MiB = 1u << 20;
constexpr size_t WS_CTL = 0, CTL_ZERO_BYTES = 512 * 1024;
constexpr size_t WS_RSTD1 = 1 * MiB;
constexpr size_t WS_SX = 1 * MiB + 256 * 1024;
constexpr size_t WS_SA = 1 * MiB + 512 * 1024;
constexpr size_t WS_WIN = 2 * MiB;
constexpr size_t WS_WA = 136 * MiB, WS_WB = 152 * MiB, WS_WO = 168 * MiB;
constexpr size_t WS_Q4 = 200 * MiB;
constexpr size_t WS_KB = 456 * MiB, WS_VB = 464 * MiB;
constexpr size_t WS_LF = 472 * MiB, WS_CC = 473 * MiB;
constexpr size_t WS_SGA = 474 * MiB, WS_SGB = 602 * MiB;
constexpr size_t WS_WGU = 730 * MiB;
constexpr size_t WS_WD = 902 * MiB;
constexpr size_t WS_WGQ = 988 * MiB;
constexpr size_t WS_END = 1074 * MiB;
constexpr size_t WS_MIXED = WS_WIN;
constexpr size_t WS_X1B = WS_Q4;
constexpr size_t WS_HID = WS_Q4 + 128 * MiB;
static_assert(WS_WIN + (size_t)N_WIN * DM * 2 <= WS_WA && WS_HID + (size_t)M * D_FF * 2 <= WS_WGU && WS_WGU + (size_t)2 * D_FF * DM * 2 <= WS_WD && WS_WD + (size_t)DM * D_FF * 2 <= WS_WGQ && WS_WGQ + (size_t)2 * D_FF * DM <= WS_END, "d_ws map");
constexpr size_t DO_XB = 0, DO_OA = 128 * MiB, DO_OB = 192 * MiB;
constexpr size_t DO_XQ = 128 * MiB, DO_WINQ = 192 * MiB;
constexpr size_t DO_X1Q = 128 * MiB;
constexpr int CW_BAR = 4096;
constexpr int CW_RSQ2 = 16384, CW_RSQ3 = 32768;
constexpr int CW_NORM = 49152;
constexpr int CW_CMAX = 65536;
constexpr int CW_AMAX = 98304;
constexpr int CW_CMAXG = 114688;
static_assert(CW_CMAX + 2 * D_FF <= CW_AMAX && CW_AMAX + M <= CW_CMAXG && (CW_CMAXG + N_INQ) * 4 <= (int)CTL_ZERO_BYTES, "CTL words inside the memset region");

constexpr int RING_OFF = 0, RING_BYTES = 133120;
constexpr int MISC_OFF = 135168;
constexpr int LDS_BYTES = 147456;
static_assert(MISC_OFF + 128 <= LDS_BYTES && fox::LDS_BYTES <= RING_BYTES && swa::LDS_BYTES <= RING_BYTES && pg8::STAGE_BYTES <= RING_BYTES, "LDS map");

#define GAS __attribute__((address_space(1)))
#define LAS __attribute__((address_space(3)))
typedef unsigned short bf16;
typedef unsigned v4u __attribute__((ext_vector_type(4)));
typedef float f32x4 __attribute__((ext_vector_type(4)));
typedef GAS unsigned gu32;
#define RLX_AGENT __ATOMIC_RELAXED, __HIP_MEMORY_SCOPE_AGENT
#define LDS_WAIT() asm volatile("s_waitcnt lgkmcnt(0)" ::: "memory")
#define VM_WAIT() asm volatile("s_waitcnt vmcnt(0)" ::: "memory")

#define XB_TMO      128
#define XB_XCNT(j)  (256  + 64 * (j))
#define XB_XSUB(j)  (1280 + 64 * (j))
#define XB_XGEN(j)  (2304 + 64 * (j))
#define XB_TOP      3328
#define XB_TOPGEN   3392
#define XCD_BAR_WORDS 3456
#define XB_SPIN_CAP (1u << 18)

__device__ __forceinline__ unsigned xb_ld(unsigned* p)              { return __hip_atomic_load(p, __ATOMIC_RELAXED, __HIP_MEMORY_SCOPE_AGENT); }
__device__ __forceinline__ unsigned xb_add(unsigned* p, unsigned v) { return __hip_atomic_fetch_add(p, v, __ATOMIC_RELAXED, __HIP_MEMORY_SCOPE_AGENT); }
__device__ __forceinline__ unsigned xb_xcc_id() { return (unsigned)__builtin_amdgcn_s_getreg((3 << 11) | 20) & 0xFu; }
#define XB_SPIN(cond, bar) do { unsigned _sp = 0; while (cond) { __builtin_amdgcn_s_sleep(1); \
    if ((++_sp & 255u) == 0u) { if (xb_ld(&(bar)[XB_TMO])) break; if (_sp > XB_SPIN_CAP) { atomicAdd(&(bar)[XB_TMO], 1u); break; } } } } while (0)

struct XcdBarrier {
    unsigned* bar; unsigned x;
    volatile LAS unsigned* st;
};
__device__ __forceinline__ XcdBarrier xcd_barrier_post(unsigned* bar, volatile LAS unsigned* st) {
    XcdBarrier b; b.bar = bar; b.x = xb_xcc_id(); b.st = st;
    if (threadIdx.x == 0) (void)xb_add(&bar[XB_XCNT(b.x)], 1u);
    return b;
}
__device__ __forceinline__ void xcd_barrier_complete(unsigned* bar, unsigned x, unsigned& nloc, unsigned& nx) {
    const unsigned G = gridDim.x * gridDim.y * gridDim.z;
    unsigned sum, cnt, mine, sp = 0u;
    for (;;) {
        sum = 0u; cnt = 0u; mine = 0u;
#pragma unroll
        for (unsigned j = 0; j < 16; ++j) { const unsigned c = xb_ld(&bar[XB_XCNT(j)]); sum += c; cnt += (c > 0u) ? 1u : 0u; mine = (j == x) ? c : mine; }
        if (sum == G) break;
        __builtin_amdgcn_s_sleep(1);
        if ((++sp & 255u) == 0u) { if (xb_ld(&bar[XB_TMO])) break; if (sp > XB_SPIN_CAP) { atomicAdd(&bar[XB_TMO], 1u); break; } }
    }
    nloc = mine > 0u ? mine : 1u; nx = cnt > 0u ? cnt : 1u;
}
__device__ __forceinline__ void xcd_barrier(const XcdBarrier& b) {
    asm volatile("s_waitcnt vmcnt(0)" ::: "memory");
    __syncthreads();
    if (threadIdx.x == 0) {
        unsigned* bar = b.bar;
        __builtin_amdgcn_s_waitcnt(0);
        unsigned nloc = b.st[0], nx = b.st[1];
        if (nloc == 0u) { xcd_barrier_complete(bar, b.x, nloc, nx); b.st[0] = nloc; b.st[1] = nx; }
        const unsigned old = xb_add(&bar[XB_XSUB(b.x)], 1u);
        const unsigned gen = old / nloc;
        if (old + 1u == (gen + 1u) * nloc) {
            __builtin_amdgcn_fence(__ATOMIC_RELEASE, "agent");
            asm volatile("s_waitcnt vmcnt(0)" ::: "memory");
            const unsigned og = xb_add(&bar[XB_TOP], 1u);
            const unsigned tg = og / nx;
            if (og + 1u == (tg + 1u) * nx) xb_add(&bar[XB_TOPGEN], 1u);
            else XB_SPIN(xb_ld(&bar[XB_TOPGEN]) == tg, bar);
            __builtin_amdgcn_fence(__ATOMIC_ACQUIRE, "agent");
            xb_add(&bar[XB_XGEN(b.x)], 1u);
            asm volatile("s_waitcnt vmcnt(0)" ::: "memory");
        } else {
            XB_SPIN(xb_ld(&bar[XB_XGEN(b.x)]) == gen, bar);
            __builtin_amdgcn_fence(__ATOMIC_ACQUIRE, "agent");
            asm volatile("s_waitcnt vmcnt(0)" ::: "memory");
        }
    }
    __syncthreads();
}

__device__ __forceinline__ unsigned f2bf(float f) { unsigned u = __builtin_bit_cast(unsigned, f); return (u + 0x7fffu + ((u >> 16) & 1u)) >> 16; }
__device__ __forceinline__ unsigned pk2(float lo, float hi) { return f2bf(lo) | (f2bf(hi) << 16); }
__device__ __forceinline__ float wave_sum(float v) {
#pragma unroll
    for (int o = 1; o < 64; o <<= 1) v += __shfl_xor(v, o);
    return v;
}
#ifndef P0_NT
#define P0_NT 1
#endif
#if P0_NT
#define P0_LD(p) __builtin_nontemporal_load(p)
#else
#define P0_LD(p) (*(p))
#endif
__device__ __forceinline__ void p0_item(const float* W, int ldw, int srccol, int nvalid, const float* g, bf16* WT, int K, int dstrow, int k0, LAS float* scr, int lane, unsigned* cmax = nullptr, int wr0 = -1, int wc0 = 0) {
    const int rk = lane >> 4, c4 = (lane & 15) * 4;
    f32x4 v[16];
    if (wr0 >= 0) {
#pragma unroll
        for (int i = 0; i < 16; ++i) v[i] = *(const GAS f32x4*)(W + (size_t)(wr0 + i) * ldw + wc0 + 4 * lane);
    } else if (c4 < nvalid) {
#pragma unroll
        for (int i = 0; i < 16; ++i) v[i] = P0_LD((const GAS f32x4*)(W + (size_t)(k0 + 4 * i + rk) * ldw + srccol + c4));
    } else {
#pragma unroll
        for (int i = 0; i < 16; ++i) v[i] = (f32x4){0.f, 0.f, 0.f, 0.f};
    }
    if (g) {
#pragma unroll
        for (int i = 0; i < 16; ++i) v[i] = v[i] * g[k0 + 4 * i + rk];
    }
    if (cmax) {
        f32x4 mx = {0.f, 0.f, 0.f, 0.f};
#pragma unroll
        for (int i = 0; i < 16; ++i) { mx[0] = fmaxf(mx[0], fabsf(v[i][0])); mx[1] = fmaxf(mx[1], fabsf(v[i][1])); mx[2] = fmaxf(mx[2], fabsf(v[i][2])); mx[3] = fmaxf(mx[3], fabsf(v[i][3])); }
#pragma unroll
        for (int e = 0; e < 4; ++e) { mx[e] = fmaxf(mx[e], __shfl_xor(mx[e], 16)); mx[e] = fmaxf(mx[e], __shfl_xor(mx[e], 32)); }
        if (lane < 16) {
#pragma unroll
            for (int e = 0; e < 4; ++e) (void)__hip_atomic_fetch_max(cmax + dstrow + c4 + e, __builtin_bit_cast(unsigned, mx[e]), __ATOMIC_RELAXED, __HIP_MEMORY_SCOPE_AGENT); }
    }
#pragma unroll
    for (int i = 0; i < 16; ++i) { LAS float* s = scr + (4 * i + rk) * 65 + c4; s[0] = v[i][0]; s[1] = v[i][1]; s[2] = v[i][2]; s[3] = v[i][3]; }
    LDS_WAIT(); asm volatile("" ::: "memory");
    const int nl = lane & 7, kc = lane >> 3;
#pragma unroll
    for (int j = 0; j < 8; ++j) { const int n = nl + 8 * j; const LAS float* s = scr + (8 * kc) * 65 + n;
        v4u o; o.x = pk2(s[0 * 65], s[1 * 65]); o.y = pk2(s[2 * 65], s[3 * 65]); o.z = pk2(s[4 * 65], s[5 * 65]); o.w = pk2(s[6 * 65], s[7 * 65]);
#ifdef PROBE_NOWR
        if (wr0 != -2 || (o.x == 0x12345678u && j == 7))
#endif
        *(GAS v4u*)(WT + (size_t)(dstrow + n) * K + k0 + 8 * kc) = o; }
    LDS_WAIT(); asm volatile("" ::: "memory");
}

__device__ __forceinline__ unsigned q4(float a, float b, float c, float d, float sc) {
    const int ia = (int)fminf(fmaxf(__builtin_rintf(a * sc), -127.f), 127.f), ib = (int)fminf(fmaxf(__builtin_rintf(b * sc), -127.f), 127.f);
    const int ic = (int)fminf(fmaxf(__builtin_rintf(c * sc), -127.f), 127.f), id = (int)fminf(fmaxf(__builtin_rintf(d * sc), -127.f), 127.f);
    return (unsigned)(ia & 255) | ((unsigned)(ib & 255) << 8) | ((unsigned)(ic & 255) << 16) | ((unsigned)(id & 255) << 24);
}
__device__ __forceinline__ v4u q16(v4u p0, v4u p1, float sc) {
    v4u o; o.x = q4(pg8::bf_lo(p0.x), pg8::bf_hi(p0.x), pg8::bf_lo(p0.y), pg8::bf_hi(p0.y), sc); o.y = q4(pg8::bf_lo(p0.z), pg8::bf_hi(p0.z), pg8::bf_lo(p0.w), pg8::bf_hi(p0.w), sc);
    o.z = q4(pg8::bf_lo(p1.x), pg8::bf_hi(p1.x), pg8::bf_lo(p1.y), pg8::bf_hi(p1.y), sc); o.w = q4(pg8::bf_lo(p1.z), pg8::bf_hi(p1.z), pg8::bf_lo(p1.w), pg8::bf_hi(p1.w), sc); return o;
}
struct Args { const float* in[14]; float* out; unsigned char* ws; int ph_lo, ph_hi, li, pad; };

__global__ void __launch_bounds__(NWAVES * 64, 2) hybrid_fwd(Args args) {
    extern __shared__ __attribute__((aligned(16))) unsigned char lds[];
    LAS unsigned char* const L = (LAS unsigned char*)lds;
    volatile LAS unsigned* const MISC = (volatile LAS unsigned*)(L + MISC_OFF);
    const int tid = threadIdx.x, lane = tid & 63, wave = __builtin_amdgcn_readfirstlane(tid >> 6);
    const int G = gridDim.x; const int bx = blockIdx.x; const int vcu = (G % 8 == 0) ? (bx % 8) * (G / 8) + bx / 8 : bx;
    unsigned char* const ws = args.ws;
    gu32* const ctl = (gu32*)(ws + WS_CTL);
    for (int u = tid; u < (LDS_BYTES - MISC_OFF) / 4; u += NWAVES * 64) ((LAS unsigned*)(L + MISC_OFF))[u] = 0u;
    __syncthreads();
    XcdBarrier bar; bar.bar = (unsigned*)(ctl + CW_BAR); bar.x = 0; bar.st = nullptr;
    if (N_LAUNCHES != PER_PHASE) bar = xcd_barrier_post((unsigned*)(ctl + CW_BAR), MISC + 8);
#define GRID_BAR() do { if (N_LAUNCHES != PER_PHASE) xcd_barrier(bar); } while (0)
    const int lo = args.ph_lo, hi = args.ph_hi;
#ifndef PH_MASK
#define PH_MASK 0x7ff
#endif
#define IN(k) ((((PH_MASK) >> (k)) & 1) && lo <= (k) && (k) < hi)
#define BOTH(k) (IN(k) && IN((k) + 1))
    const int gw = vcu * NWAVES + wave, NGW = G * NWAVES;

    const float* x = args.in[0]; float* out = args.out;
#ifdef PROBE_DUP
    const bool dummy = args.pad != 0;
#else
    constexpr bool dummy = false;
#endif
    float* rstd1 = (float*)(ws + WS_RSTD1);
    float* rsq2 = (float*)(ws + WS_CTL) + CW_RSQ2; float* rsq3 = (float*)(ws + WS_CTL) + CW_RSQ3;
    bf16* WIN = (bf16*)(ws + WS_WIN); bf16* WA = (bf16*)(ws + WS_WA); bf16* WB = (bf16*)(ws + WS_WB); bf16* WO = (bf16*)(ws + WS_WO);
    bf16* WGU = (bf16*)(ws + WS_WGU); bf16* WD = (bf16*)(ws + WS_WD);
    bf16* Q4 = (bf16*)(ws + WS_Q4); bf16* KBt = (bf16*)(ws + WS_KB); bf16* VBt = (bf16*)(ws + WS_VB);
    float* LF = (float*)(ws + WS_LF); float* CC = (float*)(ws + WS_CC);
    bf16* SGA = (bf16*)(ws + WS_SGA); bf16* SGB = (bf16*)(ws + WS_SGB);
    bf16* MIXED = (bf16*)(ws + WS_MIXED); bf16* X1B = (bf16*)(ws + WS_X1B); bf16* HID = (bf16*)(ws + WS_HID);
    signed char* WGQ = (signed char*)(ws + WS_WGQ); signed char* XQ = (signed char*)out + DO_XQ; signed char* WINQ = (signed char*)out + DO_WINQ; float* SX = (float*)(ws + WS_SX); float* RSTD2 = (float*)(ws + WS_SX + 65536); signed char* X1Q = (signed char*)out + DO_X1Q; float* SA = (float*)(ws + WS_SA);
    bf16* XB = (bf16*)((unsigned char*)out + DO_XB); bf16* OA = (bf16*)((unsigned char*)out + DO_OA); bf16* OB = (bf16*)((unsigned char*)out + DO_OB);

    if (IN(0)) {
        LAS float* scr = (LAS float*)(L + RING_OFF + wave * 16640);
        const float* g1 = args.in[1]; const float* g2 = args.in[9];
        constexpr int I_IN = 64 * 96, I_FA = 64 * 4, I_GT = 64 * 168, I_A = 32 * 64, I_O = 64 * 64, I_G = 64 * 172, I_D = 172 * 64;
        static_assert(!DEFER_ALL || DEFER_WD, "DEFER_ALL needs DEFER_WD");
        constexpr int NITEMS = I_IN + I_FA + I_GT + (DEFER_ALL ? 0 : 2 * I_A + I_O + 2 * I_G) + (DEFER_WD ? 0 : I_D), P0_SHIFT = DEFER_ALL ? 0 : I_IN + I_FA + I_GT;
#ifdef PROBE_P0
#define PCM(x) (args.pad ? nullptr : (x))
#define PWT(x) (args.pad ? HID : (x))
#else
#define PCM(x) (x)
#define PWT(x) (x)
#endif
#ifdef PROBE_WIDE
#define WIDE_ARGS(NB, C0) , (args.pad ? 16 * (r / ((NB) / 4)) : -1), (C0) + 256 * (r % ((NB) / 4))
#elif defined(PROBE_NOWR)
#define WIDE_ARGS(NB, C0) , (args.pad ? -2 : -1), 0
#else
#define WIDE_ARGS(NB, C0)
#endif
        for (int it = gw; it < NITEMS; it += NGW) {
            int r = it + P0_SHIFT; if (r >= NITEMS) r -= NITEMS;

            if (r < I_IN) { const int kb = r / 96, nb = r % 96, n0 = 64 * nb; p0_item(args.in[2], W_IN, n0, 64, g1, PWT(WIN), DM, n0, 64 * kb, scr, lane, nullptr WIDE_ARGS(96, 0)); continue; } r -= I_IN;
            if (r < I_FA) { const int kb = r / 4, nb = r % 4; p0_item(args.in[2], W_IN, 6144, nb == 0 ? 16 : 0, g1, PWT(WIN), DM, 6144 + 64 * nb, 64 * kb, scr, lane); continue; } r -= I_FA;
            if (r < I_GT) { const int kb = r / 168, nb = r % 168, n0 = 64 * nb;
                int d0 = n0; if (n0 >= 2560) { const int c = n0 - 2560, isb = c >= 4096, cc = c - 4096 * isb; d0 = 2560 + 256 * (cc >> 7) + 128 * isb + (cc & 127); }
                p0_item(args.in[2], W_IN, 6160 + n0, 64, g1, PWT(WIN), DM, N_IN + d0, 64 * kb, scr, lane, PCM((unsigned*)(ctl + CW_CMAXG) - N_IN) WIDE_ARGS(168, 6160)); continue; } r -= I_GT;
            if (r < I_A) { const int kb = r / 64, nb = r % 64; p0_item(args.in[6], DM, 64 * nb, 64, nullptr, PWT(WA), 2048, 64 * nb, 64 * kb, scr, lane, nullptr WIDE_ARGS(64, 0)); continue; } r -= I_A;
            if (r < I_A) { const int kb = r / 64, nb = r % 64; p0_item(args.in[7], DM, 64 * nb, 64, nullptr, PWT(WB), 2048, 64 * nb, 64 * kb, scr, lane, nullptr WIDE_ARGS(64, 0)); continue; } r -= I_A;
            if (r < I_O) { const int kb = r / 64, nb = r % 64; p0_item(args.in[8], DM, 64 * nb, 64, nullptr, PWT(WO), DM, 64 * nb, 64 * kb, scr, lane, nullptr WIDE_ARGS(64, 0)); continue; } r -= I_O;
            if (r < I_G) { const int kb = r / 172, nb = r % 172, n0 = 64 * nb; p0_item(args.in[10], D_FF, n0, 64, g2, PWT(WGU), DM, 256 * (n0 >> 7) + (n0 & 127), 64 * kb, scr, lane, PCM((unsigned*)(ctl + CW_CMAX)) WIDE_ARGS(172, 0)); continue; } r -= I_G;
            if (r < I_G) { const int kb = r / 172, nb = r % 172, n0 = 64 * nb; p0_item(args.in[11], D_FF, n0, 64, g2, PWT(WGU), DM, 256 * (n0 >> 7) + 128 + (n0 & 127), 64 * kb, scr, lane, PCM((unsigned*)(ctl + CW_CMAX)) WIDE_ARGS(172, 0)); continue; } r -= I_G;
            { const int kb = r / 64, nb = r % 64; p0_item(args.in[12], DM, 64 * nb, 64, nullptr, PWT(WD), D_FF, 64 * nb, 64 * kb, scr, lane, nullptr WIDE_ARGS(64, 0)); }
        }
        for (int m = gw; m < M; m += NGW) {
            const GAS f32x4* xr = (const GAS f32x4*)(x + (size_t)m * DM) + lane;
            f32x4 v[16]; float s = 0.f;
#pragma unroll
            for (int j = 0; j < 16; ++j) { v[j] = P0_LD(xr + 64 * j); s += (v[j].x * v[j].x + v[j].y * v[j].y) + (v[j].z * v[j].z + v[j].w * v[j].w); }
            s = wave_sum(s);
            float amx = 0.f;
#pragma unroll
            for (int j = 0; j < 16; ++j) amx = fmaxf(amx, fmaxf(fmaxf(fabsf(v[j].x), fabsf(v[j].y)), fmaxf(fabsf(v[j].z), fabsf(v[j].w))));
#pragma unroll
            for (int o = 1; o < 64; o <<= 1) amx = fmaxf(amx, __shfl_xor(amx, o));
            const float rs1 = 1.f / sqrtf(s * (1.f / DM) + EPS), qs = amx > 0.f ? 127.f / amx : 0.f;
            if (lane == 0) { rstd1[m] = rs1; SX[m] = rs1 * amx * (1.f / 127.f); }
            GAS unsigned* q4p = (GAS unsigned*)(XQ + (size_t)m * DM) + lane;
#pragma unroll
            for (int j = 0; j < 16; ++j) q4p[64 * j] = q4(v[j].x, v[j].y, v[j].z, v[j].w, qs);
            GAS unsigned long long* o8 = (GAS unsigned long long*)(XB + (size_t)m * DM) + lane;
#pragma unroll
            for (int j = 0; j < 16; ++j) o8[64 * j] = (unsigned long long)pk2(v[j].x, v[j].y) | ((unsigned long long)pk2(v[j].z, v[j].w) << 32);
        }
        if (BOTH(0)) GRID_BAR();
    }

    if (IN(1)) {
        {   const unsigned* cm = (const unsigned*)(ctl + CW_CMAXG);
            v4u p[8];
            if (gw < N_INQ) { const GAS v4u* src = (const GAS v4u*)(WIN + (size_t)(N_IN + gw) * DM) + 2 * lane;
#pragma unroll
                for (int j = 0; j < 4; ++j) { p[2 * j] = __builtin_nontemporal_load(src + 128 * j); p[2 * j + 1] = __builtin_nontemporal_load(src + 128 * j + 1); } }
            for (int n = gw; n < N_INQ; n += NGW) {
                v4u pn[8];
                if (n + NGW < N_INQ) { const GAS v4u* src = (const GAS v4u*)(WIN + (size_t)(N_IN + n + NGW) * DM) + 2 * lane;
#pragma unroll
                    for (int j = 0; j < 4; ++j) { pn[2 * j] = __builtin_nontemporal_load(src + 128 * j); pn[2 * j + 1] = __builtin_nontemporal_load(src + 128 * j + 1); } }
                const float mxv = __builtin_bit_cast(float, __hip_atomic_load(cm + n, RLX_AGENT)); const float sc = mxv > 0.f ? 127.f / mxv : 0.f;
                GAS v4u* dst = (GAS v4u*)(WINQ + (size_t)n * DM) + lane;
#pragma unroll
                for (int j = 0; j < 4; ++j) dst[64 * j] = q16(p[2 * j], p[2 * j + 1], sc);
#pragma unroll
                for (int j = 0; j < 8; ++j) p[j] = pn[j];
            }
        }
        if (BOTH(1)) GRID_BAR();
    }

    if (IN(2)) {
        { pg8::Gemm g{XB, WIN, M, N_IN, DM, nullptr, nullptr}; pg8::StaticOrder S; S.init(M, N_IN, G, bx);
          pg8::EpiInProj E{rstd1, Q4, LF, args.in[3], (unsigned*)(ctl + CW_NORM)};
          pg8::gemm_phase<pg8::EpiInProj, pg8::StaticOrder, PG_ALIGN, PG_SP2>(L + RING_OFF, g, S, E); }
        VM_WAIT(); __syncthreads();
        { pg8::Gemm g{(const bf16*)XQ, (const bf16*)WINQ, M, N_INQ, DM, nullptr, nullptr};
          pg8::TailOrder S; S.init(M, N_INQ, G, bx); S.nfull = (G == 256) ? 9 : (1 << 30); S.c0 = 64;
          typedef pg8::EpiGates8<WS_Q4 + (size_t)3 * M * 2048 * 2, WS_KB, WS_VB> EpiG;
          EpiG E{SX, (const unsigned*)(ctl + CW_CMAXG), ws, SGA, SGB};
#if DEFER_ALL
          const int scut = 1 + (bx & 7);
          { pg8::RangeOrder<pg8::TailOrder> R1{S, 0, scut}; pg8::gemm_phase<EpiG, pg8::RangeOrder<pg8::TailOrder>, PG_ALIGN, PG_SP2>(L + RING_OFF, g, R1, E); }
          VM_WAIT(); __syncthreads();
          if (!dummy) {
              LAS float* scr = (LAS float*)(L + RING_OFF + wave * 16640);
              const float* g2 = args.in[9];
              constexpr int I_A = 32 * 64, I_O = 64 * 64, I_G = 64 * 172, NDEF = 2 * I_A + I_O + 2 * I_G;
              for (int it = gw; it < NDEF; it += NGW) {
                  int r = it;
                  if (r < I_A) { const int kb = r / 64, nb = r % 64; p0_item(args.in[6], DM, 64 * nb, 64, nullptr, WA, 2048, 64 * nb, 64 * kb, scr, lane); continue; } r -= I_A;
                  if (r < I_A) { const int kb = r / 64, nb = r % 64; p0_item(args.in[7], DM, 64 * nb, 64, nullptr, WB, 2048, 64 * nb, 64 * kb, scr, lane); continue; } r -= I_A;
                  if (r < I_O) { const int kb = r / 64, nb = r % 64; p0_item(args.in[8], DM, 64 * nb, 64, nullptr, WO, DM, 64 * nb, 64 * kb, scr, lane); continue; } r -= I_O;
                  if (r < I_G) { const int kb = r / 172, nb = r % 172, n0 = 64 * nb; p0_item(args.in[10], D_FF, n0, 64, g2, WGU, DM, 256 * (n0 >> 7) + (n0 & 127), 64 * kb, scr, lane, (unsigned*)(ctl + CW_CMAX)); continue; } r -= I_G;
                  { const int kb = r / 172, nb = r % 172, n0 = 64 * nb; p0_item(args.in[11], D_FF, n0, 64, g2, WGU, DM, 256 * (n0 >> 7) + 128 + (n0 & 127), 64 * kb, scr, lane, (unsigned*)(ctl + CW_CMAX)); }
              }
              LDS_WAIT();
          }
          VM_WAIT(); __syncthreads();
          { pg8::RangeOrder<pg8::TailOrder> R2{S, scut, 1 << 30}; pg8::gemm_phase<EpiG, pg8::RangeOrder<pg8::TailOrder>, PG_ALIGN, PG_SP2>(L + RING_OFF, g, R2, E); }
#else
          pg8::gemm_phase<EpiG, pg8::TailOrder, PG_ALIGN, PG_SP2>(L + RING_OFF, g, S, E);
#endif
        }
        if (BOTH(2)) GRID_BAR();
    }


    if (IN(4)) {
#ifndef NO_FOX
        {
            using namespace fox;
            constexpr int NX = 8, TOTAL = NX * BATCH * H_A;
            char* fl = (char*)lds + RING_OFF;
            const bf16* Qa = Q4; const bf16* Ka = Q4 + (size_t)M * 2048; const bf16* Va = Q4 + (size_t)2 * M * 2048;
            int Lc = vcu;
            if (Lc < TOTAL) {
                const int W = 1 << 20;
                constexpr float RS = 11.313708498984761f;
                float* wtot = (float*)(fl + 2 * SHM_V + 2 * SHM_K);
#define FOX_TABLE(slot_, L_) do { if ((L_) < TOTAL) { int tq_ = tid; asm volatile("" : "+v"(tq_));     \
                    const int bh_ = (L_) / NX, x_ = (L_) % NX, nk_ = (16 - x_) * QB, s0_ = 8 * tq_; float* tb_ = (float*)(fl + LDS_BIAS + (slot_) * 16384); \
                    float v_[8]; const float* lp_ = LF + ((size_t)(bh_ >> 4) * SEQ + s0_) * 16 + (bh_ & 15); \
                    _Pragma("unroll") for (int i_ = 0; i_ < 8; ++i_) v_[i_] = (s0_ < nk_) ? lp_[(size_t)i_ * 16] : 0.f; \
                    _Pragma("unroll") for (int i_ = 1; i_ < 8; ++i_) v_[i_] += v_[i_ - 1]; \
                    float incl_ = v_[7]; const int ln_ = tq_ & 63; _Pragma("unroll") for (int o_ = 1; o_ < 64; o_ <<= 1) { const float t_ = __builtin_bit_cast(float, __builtin_amdgcn_ds_bpermute(((ln_ - o_) & 63) << 2, __builtin_bit_cast(int, incl_))); if (ln_ >= o_) incl_ += t_; }     \
                    if (lane == 63) wtot[wave] = incl_; __syncthreads(); \
                    float off_ = incl_ - v_[7]; for (int w_ = 0; w_ < wave; ++w_) off_ += wtot[w_]; \
                    if (s0_ < nk_) { _Pragma("unroll") for (int i_ = 0; i_ < 8; ++i_) tb_[s0_ + i_] = off_ + v_[i_]; } __syncthreads(); \
                    const float cref_ = tb_[x_ * QB]; __syncthreads(); \
                    if (s0_ < nk_) { _Pragma("unroll") for (int i_ = 0; i_ < 8; ++i_) tb_[s0_ + i_] = (cref_ - tb_[s0_ + i_]) * RS; } __syncthreads(); } } while (0)
#define FOX_NSUM(t_, bh_) (__builtin_bit_cast(float, __hip_atomic_load((unsigned*)(ctl + CW_NORM) + ((t_) * 64 + (bh_)) * 4 + 0, RLX_AGENT)) + __builtin_bit_cast(float, __hip_atomic_load((unsigned*)(ctl + CW_NORM) + ((t_) * 64 + (bh_)) * 4 + 1, RLX_AGENT)) + \
                           __builtin_bit_cast(float, __hip_atomic_load((unsigned*)(ctl + CW_NORM) + ((t_) * 64 + (bh_)) * 4 + 2, RLX_AGENT)) + __builtin_bit_cast(float, __hip_atomic_load((unsigned*)(ctl + CW_NORM) + ((t_) * 64 + (bh_)) * 4 + 3, RLX_AGENT)))
#define FOX_U2(bh_) (2.02f * SCALE * sqrtf(FOX_NSUM(0, bh_) * FOX_NSUM(1, bh_)))
#define FOX_JLO(slot_, qb_, u2_) ([&]() { const float* tb_ = (const float*)(fl + LDS_BIAS + (slot_) * 16384); const int p0_ = (qb_) * QB, nd_ = p0_ / KVBLK; const float bq_ = tb_[p0_]; bool keep_ = true; \
                if (lane < nd_) keep_ = ((tb_[KVBLK * lane + KVBLK - 1] - bq_) * (1.f / RS) + (u2_) > -104.f); return (int)__builtin_amdgcn_readfirstlane((int)__builtin_ctzll(__ballot(keep_))); }())
#define FOX_REF(bh_, qb_, slot_) BlockRef<bf16, bf16>{ Qa + ((size_t)((bh_) >> 4) * SEQ + (size_t)(qb_) * QB) * PITCH + ((bh_) & 15) * D, Ka + ((size_t)((bh_) >> 4) * SEQ) * PITCH + ((bh_) & 15) * D, \
                                               Va + ((size_t)((bh_) >> 4) * SEQ) * PITCH + ((bh_) & 15) * D, OA + ((size_t)((bh_) >> 4) * SEQ + (size_t)(qb_) * QB) * PITCH + ((bh_) & 15) * D, (qb_) * QB, \
                                               FOX_JLO(slot_, qb_, FOX_U2(bh_)), LDS_BIAS + (slot_) * 16384 }
                int bh = Lc / NX, xx = Lc % NX, pass = 0, slot = 0;
                FOX_TABLE(0, Lc); FOX_TABLE(1, Lc + G);
                BlockRef<bf16, bf16> cur = FOX_REF(bh, xx, 0);
                Seam<bf16> S;
                causal_swa_prime<bf16, bf16>(cur, W, fl, S);
                for (;;) {
                    const bool more_pass = pass == 0, more_item = Lc + G < TOTAL, last = !more_pass && !more_item;
                    int bhn = bh, xxn = xx, passn = pass + 1, Ln = Lc, slotn = slot;
                    if (!more_pass) { passn = 0; Ln = more_item ? Lc + G : Lc; bhn = Ln / NX; xxn = Ln % NX; slotn = slot ^ 1; }
                    const int qbn = passn ? 15 - xxn : xxn;
                    const BlockRef<bf16, bf16> nxt = last ? cur : FOX_REF(bhn, qbn, slotn);
                    causal_swa_block<bf16, bf16>(cur, nxt, SEQ, W, fl, S);
                    if (last) break;
                    if (passn == 0) FOX_TABLE(slot, Lc + 2 * G);
                    cur = nxt; bh = bhn; xx = xxn; pass = passn; Lc = Ln; slot = slotn;
                }
#undef FOX_REF
#undef FOX_TABLE
#undef FOX_NSUM
#undef FOX_JLO
#undef FOX_U2
            }
        }
#endif
        VM_WAIT(); __syncthreads();
#ifndef NO_SWA
        if (!dummy) {
            const swa::Tensors T{Q4 + (size_t)3 * M * 2048, KBt, VBt, OB, args.in[4], args.in[5]};
#ifdef PROBE_SWA_REP
#ifdef PROBE_SWA_MODE
            for (int u_ = vcu; u_ < BATCH * HKV_B * 32 * (PROBE_SWA_REP - 1); u_ += G) { const int u = u_ & 511; swa::swa_unit<PROBE_SWA_MODE>((char*)lds + RING_OFF, T, u >> 7, (u >> 5) & 3, u & 31); }
            for (int u = vcu; u < BATCH * HKV_B * 32; u += G) swa::swa_unit((char*)lds + RING_OFF, T, u >> 7, (u >> 5) & 3, u & 31);
#else
            for (int u_ = vcu; u_ < BATCH * HKV_B * 32 * PROBE_SWA_REP; u_ += G) { const int u = u_ & 511; swa::swa_unit((char*)lds + RING_OFF, T, u >> 7, (u >> 5) & 3, u & 31); }
#endif
#else
            for (int u = vcu; u < BATCH * HKV_B * 32; u += G) swa::swa_unit((char*)lds + RING_OFF, T, u >> 7, (u >> 5) & 3, u & 31);
#endif
        }
#endif
        if (BOTH(4)) GRID_BAR();
    }

    if (IN(5)) {
        pg8::Gemm g{OA, WA, M, DM, 2048, OB, WB}; pg8::SQ_DUAL S; S.init(M, DM, G, bx); pg8::EpiMix E{SGA, SGB, MIXED};
        pg8::gemm_phase<pg8::EpiMix, pg8::SQ_DUAL, PG_ALIGN, PG_SP2>(L + RING_OFF, g, S, E);
        if (BOTH(5)) GRID_BAR();
    }

    if (IN(6)) {
#if defined(PROBE_DUP) && defined(PROBE_P5_NULL)
        if (dummy) { pg8::Gemm g{MIXED, WO, M, DM, DM, nullptr, nullptr}; pg8::EpiNull E{HID};
#if defined(PROBE_P5_HOT)
            pg8::HotOrder S; S.init(M, DM, G, bx); pg8::gemm_phase<pg8::EpiNull, pg8::HotOrder, PG_ALIGN, PG_SP2>(L + RING_OFF, g, S, E);
#else
            pg8::StaticOrder S; S.init(M, DM, G, bx); pg8::gemm_phase<pg8::EpiNull, pg8::StaticOrder, PG_ALIGN, PG_SP2>(L + RING_OFF, g, S, E);
#endif
        } else {
#endif
        pg8::Gemm g{MIXED, WO, M, DM, DM, nullptr, nullptr}; pg8::SQ_ORDER S; S.init(M, DM, G, bx); pg8::EpiOutX1 E{XB, dummy ? HID : X1B};
        pg8::gemm_phase<pg8::EpiOutX1, pg8::SQ_ORDER, PG_ALIGN, PG_SP2>(L + RING_OFF, g, S, E);
#if defined(PROBE_DUP) && defined(PROBE_P5_NULL)
        }
#endif
        if (BOTH(6)) GRID_BAR();
    }

    if (IN(7)) {
#if defined(PROBE_DUP) && defined(PROBE_MFMA_CLOCK)
        if (dummy) {
            typedef short b8 __attribute__((ext_vector_type(8)));
            b8 a = {(short)(0x3f80 + lane), 0x3f80, 0x3f81, 0x3f82, 0x3f83, 0x3f84, 0x3f85, 0x3f86}, b = {0x3f80, (short)(0x3f80 + wave), 0x3f81, 0x3f82, 0x3f83, 0x3f84, 0x3f85, 0x3f86};
            f32x4 c[16];
#pragma unroll
            for (int i = 0; i < 16; ++i) c[i] = (f32x4){0.f, 0.f, 0.f, 0.f};
            for (int it = 0; it < PROBE_MFMA_CLOCK; ++it) {
#pragma unroll
                for (int i = 0; i < 16; ++i) c[i] = __builtin_amdgcn_mfma_f32_16x16x32_bf16(a, b, c[i], 0, 0, 0);
            }
            f32x4 s = c[0];
#pragma unroll
            for (int i = 1; i < 16; ++i) s = s + c[i];
            if (s[0] == 12345.678f) ((float*)HID)[tid] = s[1] + s[2] + s[3];
        } else
#endif
        for (int pass7 = 0; pass7 < 2; ++pass7) {
        if ((pass7 == 0) == ((wave & 1) == 0))
        {
            v4u p[8];
            if (gw < M) { const GAS v4u* src = (const GAS v4u*)(X1B + (size_t)gw * DM) + 2 * lane;
#pragma unroll
                for (int j = 0; j < 4; ++j) { p[2 * j] = src[128 * j]; p[2 * j + 1] = src[128 * j + 1]; } }
            for (int m = gw; m < M; m += NGW) {
                v4u pn[8];
                if (m + NGW < M) { const GAS v4u* src = (const GAS v4u*)(X1B + (size_t)(m + NGW) * DM) + 2 * lane;
#pragma unroll
                    for (int j = 0; j < 4; ++j) { pn[2 * j] = src[128 * j]; pn[2 * j + 1] = src[128 * j + 1]; } }
                float s = 0.f, amx = 0.f;
#pragma unroll
                for (int j = 0; j < 8; ++j) {
#pragma unroll
                    for (int e = 0; e < 4; ++e) { const float a = pg8::bf_lo(p[j][e]), b = pg8::bf_hi(p[j][e]); s += a * a + b * b; amx = fmaxf(amx, fmaxf(fabsf(a), fabsf(b))); } }
                s = wave_sum(s);
#pragma unroll
                for (int o = 1; o < 64; o <<= 1) amx = fmaxf(amx, __shfl_xor(amx, o));
                const float rs2 = 1.f / sqrtf(s * (1.f / DM) + EPS), sc = amx > 0.f ? 127.f / amx : 0.f;
                if (lane == 0) { RSTD2[m] = rs2; SA[m] = rs2 * amx * (1.f / 127.f); }
                GAS v4u* dst = (GAS v4u*)(X1Q + (size_t)m * DM) + lane;
#pragma unroll
                for (int j = 0; j < 4; ++j) dst[64 * j] = q16(p[2 * j], p[2 * j + 1], sc);
#pragma unroll
                for (int j = 0; j < 8; ++j) p[j] = pn[j];
            }
        }
        else
        {
            const unsigned* cm = (const unsigned*)(ctl + CW_CMAX);
            constexpr int NQ = FFN_I8 ? FFN_I8_TILES * 256 : 0;
            v4u p[8];
            if (gw < NQ) { const GAS v4u* src = (const GAS v4u*)(WGU + (size_t)gw * DM) + 2 * lane;
#pragma unroll
                for (int j = 0; j < 4; ++j) { p[2 * j] = __builtin_nontemporal_load(src + 128 * j); p[2 * j + 1] = __builtin_nontemporal_load(src + 128 * j + 1); } }
            for (int n = gw; n < NQ; n += NGW) {
                v4u pn[8];
                if (n + NGW < NQ) { const GAS v4u* src = (const GAS v4u*)(WGU + (size_t)(n + NGW) * DM) + 2 * lane;
#pragma unroll
                    for (int j = 0; j < 4; ++j) { pn[2 * j] = __builtin_nontemporal_load(src + 128 * j); pn[2 * j + 1] = __builtin_nontemporal_load(src + 128 * j + 1); } }
                const float mxv = __builtin_bit_cast(float, __hip_atomic_load(cm + n, RLX_AGENT)); const float sc = mxv > 0.f ? 127.f / mxv : 0.f;
                GAS v4u* dst = (GAS v4u*)(WGQ + (size_t)n * DM) + lane;
#pragma unroll
                for (int j = 0; j < 4; ++j) dst[64 * j] = q16(p[2 * j], p[2 * j + 1], sc);
#pragma unroll
                for (int j = 0; j < 8; ++j) p[j] = pn[j];
            }
        }
        }
        if (BOTH(7)) GRID_BAR();
    }

    if (IN(8)) {
#if FFN_I8
        {
            pg8::Gemm g8{(const bf16*)X1Q, (const bf16*)WGQ, M, FFN_I8_TILES * 256, DM, nullptr, nullptr}; pg8::StaticOrder S; S.init(M, FFN_I8_TILES * 256, G, bx);
#if defined(PROBE_DUP) && defined(PROBE_NULL8)
            if (dummy) { pg8::EpiNull8 E{HID}; pg8::gemm_phase<pg8::EpiNull8, pg8::StaticOrder, PG_ALIGN, PG_SP2>(L + RING_OFF, g8, S, E); } else
#endif
            { pg8::EpiSwiGLU8 E{SA, (const unsigned*)(ctl + CW_CMAX), HID};
            pg8::gemm_phase<pg8::EpiSwiGLU8, pg8::StaticOrder, PG_ALIGN, PG_SP2>(L + RING_OFF, g8, S, E); } }
#if DEFER_WD
        if (!dummy) {
            const int rem = (FFN_I8_TILES * 64) % G, nl = G - rem;
            if (bx >= rem) {
                VM_WAIT(); __syncthreads();
                LAS float* scr = (LAS float*)(L + RING_OFF + wave * 16640);
                for (int r = (bx - rem) * NWAVES + wave; r < 172 * 64; r += nl * NWAVES) { const int kb = r / 64, nb = r % 64; p0_item(args.in[12], DM, 64 * nb, 64, nullptr, WD, D_FF, 64 * nb, 64 * kb, scr, lane); }
                LDS_WAIT();
            }
        }
#endif
        if (FFN_I8_TILES < 86 && !(PROBE8_SKIP_BF16 && dummy)) {
            VM_WAIT(); __syncthreads();
            pg8::Gemm g{X1B, WGU + (size_t)FFN_I8_TILES * 256 * DM, M, (86 - FFN_I8_TILES) * 256, DM, nullptr, nullptr}; pg8::StaticOrder S; S.init(M, (86 - FFN_I8_TILES) * 256, G, bx);
            pg8::EpiSwiGLU E{RSTD2, HID, FFN_I8_TILES};
            pg8::gemm_phase<pg8::EpiSwiGLU, pg8::StaticOrder, PG_ALIGN, PG_SP2>(L + RING_OFF, g, S, E); }
#else
        { pg8::Gemm g{X1B, WGU, M, 2 * D_FF, DM, nullptr, nullptr}; pg8::StaticOrder S; S.init(M, 2 * D_FF, G, bx); pg8::EpiSwiGLU E{RSTD2, HID, 0};
          pg8::gemm_phase<pg8::EpiSwiGLU, pg8::StaticOrder, PG_ALIGN, PG_SP2>(L + RING_OFF, g, S, E); }
#endif
        if (BOTH(8)) GRID_BAR();
    }

    if (IN(9)) {
#if defined(PROBE_DUP) && defined(PROBE_P8_HOT)
        if (dummy) { pg8::Gemm g{HID, WD, M, DM, D_FF, nullptr, nullptr}; pg8::HotOrder S; S.init(M, DM, G, bx); pg8::EpiDownX2 E{X1B, MIXED};
            pg8::gemm_phase<pg8::EpiDownX2, pg8::HotOrder, PG_ALIGN, PG_SP2>(L + RING_OFF, g, S, E); } else
#endif
        { pg8::Gemm g{HID, WD, M, DM, D_FF, nullptr, nullptr}; pg8::SQ_ORDER S; S.init(M, DM, G, bx); pg8::EpiDownX2 E{X1B, dummy ? MIXED : X1B};
        pg8::gemm_phase<pg8::EpiDownX2, pg8::SQ_ORDER, PG_ALIGN, PG_SP2>(L + RING_OFF, g, S, E); }
        if (BOTH(9)) GRID_BAR();
    }

    if (IN(10)) {
        const float* fg = args.in[13];
        for (int m = gw; m < M; m += 2 * NGW) {
            const GAS v4u* xr0 = (const GAS v4u*)(X1B + (size_t)m * DM) + lane; const GAS v4u* xr1 = xr0 + (size_t)NGW * (DM / 8);
            float* ob = dummy ? (float*)HID : out;
            GAS f32x4* or0 = (GAS f32x4*)(ob + (size_t)m * DM) + 2 * lane; GAS f32x4* or1 = or0 + (size_t)NGW * (DM / 4); const GAS f32x4* gr = (const GAS f32x4*)fg + 2 * lane;
            v4u p[8], q[8]; float s0 = 0.f, s1 = 0.f;
#pragma unroll
            for (int j = 0; j < 8; ++j) { p[j] = __builtin_nontemporal_load(xr0 + 64 * j); q[j] = __builtin_nontemporal_load(xr1 + 64 * j); }
#pragma unroll
            for (int j = 0; j < 8; ++j) {
#pragma unroll
                for (int e = 0; e < 4; ++e) { const float a = pg8::bf_lo(p[j][e]), b = pg8::bf_hi(p[j][e]), c = pg8::bf_lo(q[j][e]), d = pg8::bf_hi(q[j][e]); s0 += a * a + b * b; s1 += c * c + d * d; } }
            s0 = wave_sum(s0); s1 = wave_sum(s1);
            const float rs0 = 1.f / sqrtf(s0 * (1.f / DM) + EPS), rs1 = 1.f / sqrtf(s1 * (1.f / DM) + EPS);
#pragma unroll
            for (int j = 0; j < 8; ++j) { const f32x4 g0 = gr[128 * j], g1 = gr[128 * j + 1];
                const f32x4 a0 = {pg8::bf_lo(p[j].x), pg8::bf_hi(p[j].x), pg8::bf_lo(p[j].y), pg8::bf_hi(p[j].y)}, a1 = {pg8::bf_lo(p[j].z), pg8::bf_hi(p[j].z), pg8::bf_lo(p[j].w), pg8::bf_hi(p[j].w)};
                const f32x4 b0 = {pg8::bf_lo(q[j].x), pg8::bf_hi(q[j].x), pg8::bf_lo(q[j].y), pg8::bf_hi(q[j].y)}, b1 = {pg8::bf_lo(q[j].z), pg8::bf_hi(q[j].z), pg8::bf_lo(q[j].w), pg8::bf_hi(q[j].w)};
                __builtin_nontemporal_store(a0 * rs0 * g0, or0 + 128 * j); __builtin_nontemporal_store(a1 * rs0 * g1, or0 + 128 * j + 1); __builtin_nontemporal_store(b0 * rs1 * g0, or1 + 128 * j); __builtin_nontemporal_store(b1 * rs1 * g1, or1 + 128 * j + 1); }
        }
    }
#undef IN
#undef BOTH
#undef GRID_BAR
}

extern "C" void kernel_launch(void* const* d_in, const int* in_sizes, int n_in, void* d_out, int out_size, void* d_ws, size_t ws_size, hipStream_t stream) {
    static int grid = 0;
    if (grid == 0) {
        if (n_in != 14 || in_sizes[0] != M * DM || out_size != M * DM || ws_size < WS_END) {
            fprintf(stderr, "kernel_launch: built for 14 inputs, x/out of %d floats, >= %zu bytes of workspace; got n_in %d, in0 %d, out %d, ws %zu; nothing launched\n", M * DM, (size_t)WS_END, n_in, n_in > 0 ? in_sizes[0] : -1, out_size, ws_size);
            grid = -1; return; }
        int dev = 0, cus = 0, per_cu = 0;
        if (hipGetDevice(&dev) != hipSuccess || hipDeviceGetAttribute(&cus, hipDeviceAttributeMultiprocessorCount, dev) != hipSuccess) { fprintf(stderr, "kernel_launch: device query failed\n"); grid = -1; return; }
        if (hipFuncSetAttribute((const void*)hybrid_fwd, hipFuncAttributeMaxDynamicSharedMemorySize, LDS_BYTES) != hipSuccess) { fprintf(stderr, "kernel_launch: hipFuncSetAttribute failed\n"); grid = -1; return; }
        if (hipOccupancyMaxActiveBlocksPerMultiprocessor(&per_cu, (const void*)hybrid_fwd, NWAVES * 64, LDS_BYTES) != hipSuccess || per_cu < 1)
            fprintf(stderr, "kernel_launch: note: occupancy query reports %d workgroups per CU\n", per_cu);
        (void)hipGetLastError();
        grid = cus;
    }
    if (grid < 0) return;
    if (hipMemsetAsync((char*)d_ws + WS_CTL, 0, CTL_ZERO_BYTES, stream) != hipSuccess) { fprintf(stderr, "kernel_launch: hipMemsetAsync failed\n"); return; }
    Args a{};
    for (int i = 0; i < 14; ++i) a.in[i] = (const float*)d_in[i];
    a.out = (float*)d_out; a.ws = (unsigned char*)d_ws;
    for (int li = 0; li < N_LAUNCHES; ++li) {
        a.ph_lo = (N_LAUNCHES == PER_PHASE) ? li : 0; a.ph_hi = (N_LAUNCHES == PER_PHASE) ? li + 1 : PER_PHASE; a.li = li; a.pad = 0;
#ifdef PROBE_DUP
        if (N_LAUNCHES == PER_PHASE && ((PROBE_DUP >> li) & 1)) { a.pad = 1; hipLaunchKernelGGL(hybrid_fwd, dim3(grid), dim3(NWAVES * 64), LDS_BYTES, stream, a); a.pad = 0; }
#endif
        hipLaunchKernelGGL(hybrid_fwd, dim3(grid), dim3(NWAVES * 64), LDS_BYTES, stream, a);
        const hipError_t le = hipPeekAtLastError();
        if (le != hipSuccess) { fprintf(stderr, "kernel_launch: launch %d failed: %s\n", li, hipGetErrorName(le)); break; }
    }
}
```
